# Optimizing an MI355X kernel written in HIP

```python
import jax, jax.numpy as jnp
from jax import lax
import numpy as np

D_MODEL = 1024
BATCH = 2
SEQ = 8192
DEPTH = 1

CHUNK = 64

D_MIX = D_MODEL
D_POOL = D_MIX // 2
D_RWKV = D_MIX - D_POOL
POOL_WINDOWS = (2, 4, 8, 16)
N_POOL_GROUPS = len(POOL_WINDOWS)
POOL_GROUP = D_POOL // N_POOL_GROUPS
HEAD_SIZE = 64
N_RWKV_HEADS = D_RWKV // HEAD_SIZE
DECAY_LORA = 64
ICLR_LORA = 64
RWKV_SPLITS = (D_RWKV, DECAY_LORA, D_RWKV, D_RWKV, ICLR_LORA, D_RWKV)
D_RWKV_SEG = sum(RWKV_SPLITS)
N_IN = 2 * D_POOL + D_RWKV_SEG
NORM_EPS = 1e-6
GN_EPS = 64e-5
L2_EPS = 1e-12

kernel_name = "hybrid_pool_rwkv7_adaln_block"


def _rmsnorm(x, g):
    xf = x.astype(jnp.float32)
    y = xf * lax.rsqrt(jnp.mean(xf * xf, axis=-1, keepdims=True) + NORM_EPS)
    return (y * g.astype(jnp.float32)).astype(x.dtype)


def _multiscale_pool_diff(u):
    T = u.shape[1]
    cs = jnp.cumsum(u, axis=1)
    pos = jnp.arange(1, T + 1)
    outs = []
    for g, win in enumerate(POOL_WINDOWS):
        sl = slice(g * POOL_GROUP, (g + 1) * POOL_GROUP)
        csg = cs[..., sl]
        lagged = jnp.pad(csg, ((0, 0), (win, 0), (0, 0)))[:, :T]
        count = jnp.minimum(pos, win).astype(u.dtype)
        mean = (csg - lagged) / count[None, :, None]
        outs.append(mean - u[..., sl])
    return jnp.stack(outs, axis=2)


def _rwkv7_scan(r, decay, k, v, kk, a):
    B, T, H, N = r.shape
    xs = tuple(jnp.moveaxis(t, 1, 0) for t in (r, decay, k, v, -kk, kk * a))

    def step(S, inp):
        r_t, w_t, k_t, v_t, am_t, b_t = inp
        sa = jnp.einsum('bhij,bhj->bhi', S, am_t)
        S = (S * w_t[:, :, None, :]
             + sa[..., None] * b_t[:, :, None, :]
             + v_t[..., None] * k_t[:, :, None, :])
        y = jnp.einsum('bhij,bhj->bhi', S, r_t)
        return S, y

    S0 = jnp.zeros((B, H, N, N), jnp.float32)
    _, ys = lax.scan(step, S0, xs)
    return jnp.moveaxis(ys, 0, 1)


def setup_inputs(seed: int = 0) -> dict:
    key = jax.random.key(seed)
    ks = jax.random.split(key, 24)
    f32 = jnp.float32
    L = DEPTH
    nrm = lambda k, s: jax.random.normal(k, s, f32)
    return {
        "x": nrm(ks[0], (BATCH, SEQ, D_MODEL)),
        "c": nrm(ks[1], (BATCH, D_MODEL)),
        "w_ada": nrm(ks[2], (L, D_MODEL, 3 * D_MODEL)) * (0.5 * D_MODEL ** -0.5),
        "b_ada": nrm(ks[3], (L, 3 * D_MODEL)) * 0.01,
        "norm_g": 1.0 + 0.01 * nrm(ks[4], (L, D_MODEL)),
        "w_in": nrm(ks[5], (L, D_MODEL, N_IN)) * D_MODEL ** -0.5,
        "pool_w": nrm(ks[6], (L, N_POOL_GROUPS, POOL_GROUP, POOL_GROUP)) * POOL_GROUP ** -0.5,
        "pool_scale": 1.0 + 0.02 * nrm(ks[7], (L, D_POOL)),
        "mu_shift": jax.random.uniform(ks[8], (L, D_RWKV_SEG), f32),
        "w0": jax.random.uniform(ks[9], (L, D_RWKV), f32, minval=-6.0, maxval=0.0),
        "w_up": nrm(ks[10], (L, DECAY_LORA, D_RWKV)) * 0.1,
        "a0": nrm(ks[11], (L, D_RWKV)) * 0.1,
        "a_up": nrm(ks[12], (L, ICLR_LORA, D_RWKV)) * (0.5 * ICLR_LORA ** -0.5),
        "k_k": 0.85 + 0.02 * nrm(ks[13], (L, D_RWKV)),
        "k_a": 1.0 + 0.02 * nrm(ks[14], (L, D_RWKV)),
        "r_k": nrm(ks[15], (L, D_RWKV)) * 0.1,
        "ln_w": 1.0 + 0.02 * nrm(ks[16], (L, D_RWKV)),
        "ln_b": nrm(ks[17], (L, D_RWKV)) * 0.01,
        "w_out": nrm(ks[18], (L, D_MIX, D_MODEL)) * D_MIX ** -0.5,
        "final_g": 1.0 + 0.01 * nrm(ks[19], (D_MODEL,)),
    }


def reference(x, c, w_ada, b_ada, norm_g, w_in, pool_w, pool_scale, mu_shift, w0,
              w_up, a0, a_up, k_k, k_a, r_k, ln_w, ln_b, w_out, final_g):
    B, T, _ = x.shape
    H, N = N_RWKV_HEADS, HEAD_SIZE
    f32 = jnp.float32
    split_idx = list(np.cumsum(RWKV_SPLITS)[:-1])
    for l in range(DEPTH):
        mod = c @ w_ada[l] + b_ada[l]
        shift, scale, gate = jnp.split(mod, 3, axis=-1)
        h = _rmsnorm(x, norm_g[l]) * (1.0 + scale[:, None, :]) + shift[:, None, :]

        p = h @ w_in[l]
        pool_u = p[..., :D_POOL]
        pool_z = p[..., D_POOL:2 * D_POOL]
        seg = p[..., 2 * D_POOL:]

        diff = _multiscale_pool_diff(pool_u.astype(f32))
        y_pool = jnp.einsum('btgc,gcd->btgd', diff, pool_w[l].astype(f32))
        y_pool = y_pool.reshape(B, T, D_POOL) * pool_scale[l].astype(f32)
        y_pool = y_pool * jax.nn.silu(pool_z.astype(f32))

        seg = seg.astype(f32)
        prev = jnp.pad(seg, ((0, 0), (1, 0), (0, 0)))[:, :T]
        seg = seg + (prev - seg) * mu_shift[l].astype(f32)
        r, w_lo, k, v, a_lo, z = jnp.split(seg, split_idx, axis=-1)
        w_raw = w0[l] + jnp.tanh(w_lo) @ w_up[l].astype(f32)
        w_raw = -jax.nn.softplus(-w_raw) - 0.5
        decay = jnp.exp(-jnp.exp(w_raw))
        a = jax.nn.sigmoid(a0[l] + a_lo @ a_up[l].astype(f32))
        kk = (k * k_k[l]).reshape(B, T, H, N)
        kk = kk / jnp.maximum(jnp.linalg.norm(kk, axis=-1, keepdims=True), L2_EPS)
        k = k * (1.0 + (a - 1.0) * k_a[l])
        rh, kh, vh = (t.reshape(B, T, H, N) for t in (r, k, v))
        yh = _rwkv7_scan(rh, decay.reshape(B, T, H, N), kh, vh, kk,
                         a.reshape(B, T, H, N))
        mu = jnp.mean(yh, axis=-1, keepdims=True)
        var = jnp.mean(jnp.square(yh - mu), axis=-1, keepdims=True)
        yh = (yh - mu) * lax.rsqrt(var + GN_EPS)
        yh = yh * ln_w[l].reshape(H, N) + ln_b[l].reshape(H, N)
        bonus = jnp.sum(rh * kh * r_k[l].reshape(H, N), axis=-1, keepdims=True) * vh
        y_rwkv = (yh + bonus).reshape(B, T, D_RWKV) * jax.nn.silu(z)

        mix = jnp.concatenate([y_pool, y_rwkv], axis=-1).astype(x.dtype)
        out = mix @ w_out[l]
        x = x + gate[:, None, :] * out
    return _rmsnorm(x, final_g)
```

```cpp
#include <hip/hip_runtime.h>
#include <cstdio>
#include <cstdint>
namespace pg8 {
#define PG8_LAS __attribute__((address_space(3)))
typedef unsigned short bf16_t;
typedef short bf16x8 __attribute__((ext_vector_type(8)));
typedef float f32x4 __attribute__((ext_vector_type(4)));
typedef unsigned u32x4 __attribute__((ext_vector_type(4)));
constexpr int BM = 256, BK = 64, HALF = 128, HTB = HALF * BK * 2  , STAGE_BYTES = 8 * HTB, NXCD = 8, WGM = 8;

__host__ __device__ __forceinline__ int lds_byte(int r, int c) { const int st = (r >> 4) * 2 + (c >> 5), rr = r & 15, cc = c & 31, ob = rr * 64 + cc * 2; return st * 1024 + (ob ^ (((ob >> 9) & 1) << 5)); }
__host__ __device__ __forceinline__ void stage_rc(int b, int& R, int& C) { const int st = b / 1024, sb = b % 1024, swz = sb ^ (((sb >> 9) & 1) << 5); R = (st >> 1) * 16 + swz / 64; C = (st & 1) * 32 + (swz % 64) / 2; }
__host__ __device__ __forceinline__ int perm32(int rho) { const int n = rho >> 4, i = rho & 15; return 8 * (i >> 2) + 4 * n + (i & 3); }

struct Unit { int pm, pn; };
struct Gemm { const bf16_t* A; const bf16_t* Bt; int M, N, K; };

struct StaticOrder {
    int nM, nN, nwg, G, c;
    __host__ __device__ void init(int M, int N, int G_, int c_) { nM = M / BM; nN = N / BM; nwg = nM * nN; G = G_; c = c_; }
    __host__ __device__ bool next(int i, Unit& u) const {
        const long L = (long)i * G + c; if (L >= nwg) return false;
        int wgid = (int)L; { const int q = nwg / NXCD, r = nwg % NXCD, xcd = wgid % NXCD, off = wgid / NXCD; wgid = (xcd < r ? xcd * (q + 1) : r * (q + 1) + (xcd - r) * q) + off; }
        const int nig = WGM * nN, gid = wgid / nig, fm = gid * WGM, gsz = (nM - fm) < WGM ? (nM - fm) : WGM;
        u.pm = fm + ((wgid % nig) % gsz); u.pn = (wgid % nig) / gsz; return true;
    }
    __device__ __forceinline__ void a_ready(const Unit&) const {}
    __device__ __forceinline__ void done(const Unit&) const {}
};

__device__ __forceinline__ unsigned cvt_pk_bf16(float lo, float hi) { unsigned r; asm volatile("v_cvt_pk_bf16_f32 %0, %1, %2" : "=v"(r) : "v"(lo), "v"(hi)); return r; }
typedef float f32x2 __attribute__((ext_vector_type(2)));
__device__ __forceinline__ f32x2 gelu_pk(f32x2 v) {
    const f32x2 av = __builtin_elementwise_abs(v), d = av * 0.2316418882f + 1.0f;
    f32x2 t; t.x = __builtin_amdgcn_rcpf(d.x); t.y = __builtin_amdgcn_rcpf(d.y);
    f32x2 q = t * 0.5307027145f + (-0.7265760135f); q = q * t + 0.7107068705f; q = q * t + (-0.142248368f); q = q * t + 0.127414796f; q = q * t;
    const f32x2 s = (v * v) * (-0.72134752044f);
    f32x2 e; e.x = __builtin_amdgcn_exp2f(s.x); e.y = __builtin_amdgcn_exp2f(s.y);
    const f32x2 m = v * (q * e), r = v - m;
    f32x2 o; o.x = v.x < 0.f ? m.x : r.x; o.y = v.y < 0.f ? m.y : r.y; return o;
}

template <int ACT  > struct EpiBf16 {
    static constexpr bool PERM = true, AFTER_DRAIN = false; static_assert(ACT == 0 || ACT == 1, "EpiBf16: ACT is 0 (none) or 1 (gelu_pk)");
    bf16_t* O; int ldc; const float* bias; int split_cols; size_t split_stride; float scale0;
    __device__ __forceinline__ void operator()(const f32x4 (&acc)[2][2][4][2], const Unit& u, int wr, int wc, int fr, int fq) const {
        const int row0 = u.pm * BM + wr * 64 + fr; int colt = u.pn * BM; bf16_t* base = O;
        float sc = 1.f; if (split_cols) { const int t = colt / split_cols; base += (size_t)t * split_stride; colt -= t * split_cols; if (t == 0) sc = scale0; }
        const int col0 = colt + wc * 32 + 8 * fq, bcol0 = u.pn * BM + wc * 32 + 8 * fq;
        f32x4 bv[2][2];
#pragma unroll
        for (int bj = 0; bj < 2; ++bj)
#pragma unroll
            for (int n = 0; n < 2; ++n) bv[bj][n] = bias ? *(const f32x4*)(bias + bcol0 + bj * HALF + 4 * n) : (f32x4){0.f, 0.f, 0.f, 0.f};
#pragma unroll
        for (int ai = 0; ai < 2; ++ai)
#pragma unroll
            for (int m = 0; m < 4; ++m) { bf16_t* rowp = base + (size_t)(row0 + ai * HALF + m * 16) * ldc + col0;
#pragma unroll
                for (int bj = 0; bj < 2; ++bj) { f32x4 v0 = acc[ai][bj][m][0] + bv[bj][0], v1 = acc[ai][bj][m][1] + bv[bj][1];
                    if (ACT == 1) { f32x2 a = gelu_pk((f32x2){v0[0], v0[1]}), b = gelu_pk((f32x2){v0[2], v0[3]}), c = gelu_pk((f32x2){v1[0], v1[1]}), d = gelu_pk((f32x2){v1[2], v1[3]});
                        v0 = (f32x4){a.x, a.y, b.x, b.y}; v1 = (f32x4){c.x, c.y, d.x, d.y}; }
                    v0 = v0 * sc; v1 = v1 * sc; u32x4 w; w.x = cvt_pk_bf16(v0[0], v0[1]); w.y = cvt_pk_bf16(v0[2], v0[3]); w.z = cvt_pk_bf16(v1[0], v1[1]); w.w = cvt_pk_bf16(v1[2], v1[3]);
                    *(u32x4*)(rowp + bj * HALF) = w; } }
    }
};

struct PanelStats {
    unsigned* xbuf;
    unsigned* cnt;
    unsigned* tmo;
    int ntn; float eps;
    unsigned code;
    __device__ __forceinline__ bool run(const f32x4 (&v)[2][2][4][2], const Unit& u, int wr, int wc, int fr, int fq, PG8_LAS unsigned char* lds, int wid, int lane) const {
        typedef float f32x2v __attribute__((ext_vector_type(2)));
        PG8_LAS f32x2v* P = (PG8_LAS f32x2v*)lds;
        PG8_LAS f32x2v* S = (PG8_LAS f32x2v*)(lds + 8192);
        PG8_LAS unsigned* flag = (PG8_LAS unsigned*)(lds + 8192 + 2048);
#pragma unroll
        for (int ai = 0; ai < 2; ++ai)
#pragma unroll
            for (int m = 0; m < 4; ++m) {
                float s = 0.f;
#pragma unroll
                for (int bj = 0; bj < 2; ++bj)
#pragma unroll
                    for (int n = 0; n < 2; ++n) { const f32x4 x = v[ai][bj][m][n]; s += (x[0] + x[1]) + (x[2] + x[3]); }
                s += __shfl_xor(s, 16); s += __shfl_xor(s, 32);
                const float mw = s * (1.0f / 64.0f); float q = 0.f;
#pragma unroll
                for (int bj = 0; bj < 2; ++bj)
#pragma unroll
                    for (int n = 0; n < 2; ++n) { const f32x4 d = v[ai][bj][m][n] - mw; q += (d[0] * d[0] + d[1] * d[1]) + (d[2] * d[2] + d[3] * d[3]); }
                q += __shfl_xor(q, 16); q += __shfl_xor(q, 32);
                if (fq == 0) P[(ai * HALF + wr * 64 + m * 16 + fr) * 4 + wc] = (f32x2v){mw, q};
            }
        asm volatile("s_waitcnt lgkmcnt(0)" ::: "memory"); __builtin_amdgcn_s_barrier(); asm volatile("" ::: "memory");
#if defined(BROKEN_EXCHANGE_NO_WAIT)
#warning BROKEN CONTROL BUILD: the row-statistics exchange does not wait; results are wrong by design
        if (blockIdx.x >= 64) { const long long t0_ = clock64(); while (clock64() - t0_ < 60000) __builtin_amdgcn_s_sleep(8); }
#endif
        const int row = wid * 32 + (lane & 31);
        if (lane < 32) {
            const f32x2v a = P[row * 4 + 0], b = P[row * 4 + 1], c = P[row * 4 + 2], d = P[row * 4 + 3];
            const float mt = (a.x + b.x + c.x + d.x) * 0.25f;
            const float da = a.x - mt, db = b.x - mt, dc = c.x - mt, dd = d.x - mt;
            const float m2 = (a.y + b.y) + (c.y + d.y) + 64.0f * ((da * da + db * db) + (dc * dc + dd * dd));
            unsigned long long* slot = (unsigned long long*)xbuf + ((size_t)(u.pm * BM + row) * 4 + u.pn);
            __hip_atomic_store(slot, ((unsigned long long)__float_as_uint(m2) << 32) | __float_as_uint(mt), __ATOMIC_RELAXED, __HIP_MEMORY_SCOPE_AGENT);
        }
        asm volatile("s_waitcnt vmcnt(0)" ::: "memory");
        if (lane == 0) __hip_atomic_fetch_add(cnt + 64 * u.pm, 1u, __ATOMIC_RELAXED, __HIP_MEMORY_SCOPE_AGENT);
        if (wid == 0) {
            bool dead = false; const unsigned long long t0 = __builtin_amdgcn_s_memrealtime(); const unsigned want = 8u * (unsigned)ntn;
            for (;;) {
#if defined(BROKEN_EXCHANGE_NO_WAIT)
                break;
#endif
                if ((unsigned)__builtin_amdgcn_readfirstlane(__hip_atomic_load(cnt + 64 * u.pm, __ATOMIC_RELAXED, __HIP_MEMORY_SCOPE_AGENT)) >= want) break;
                if (__builtin_amdgcn_s_memrealtime() - t0 > 2000000ull) {
                    if (lane == 0) { unsigned expect = 0u; __hip_atomic_compare_exchange_strong(tmo + 1, &expect, code | (unsigned)(u.pm & 0xff), __ATOMIC_RELAXED, __ATOMIC_RELAXED, __HIP_MEMORY_SCOPE_AGENT);
                                     __hip_atomic_store(tmo, 1u, __ATOMIC_RELAXED, __HIP_MEMORY_SCOPE_AGENT); }
                    dead = true; break; }
                __builtin_amdgcn_s_sleep(2);
            }
            __builtin_amdgcn_fence(__ATOMIC_ACQUIRE, "agent");
            if (lane == 0) flag[0] = dead ? 1u : 0u;
        }
        asm volatile("s_waitcnt vmcnt(0) lgkmcnt(0)" ::: "memory"); __builtin_amdgcn_s_barrier(); asm volatile("" ::: "memory");
        const bool bad = flag[0] != 0u;
        if (lane < 32) {
            const unsigned long long* slot = (const unsigned long long*)xbuf + (size_t)(u.pm * BM + row) * 4; float mt[4], m2[4]; float ms = 0.f;
#pragma unroll
            for (int t = 0; t < 4; ++t) { if (t < ntn) { const unsigned long long w = __hip_atomic_load(slot + t, __ATOMIC_RELAXED, __HIP_MEMORY_SCOPE_AGENT); mt[t] = __uint_as_float((unsigned)w); m2[t] = __uint_as_float((unsigned)(w >> 32)); } else { mt[t] = 0.f; m2[t] = 0.f; } ms += mt[t]; }
            const float mean = ms / (float)ntn; float q = 0.f;
#pragma unroll
            for (int t = 0; t < 4; ++t) if (t < ntn) { const float dm = mt[t] - mean; q += m2[t] + 256.0f * dm * dm; }
            S[row] = (f32x2v){mean, 1.0f / sqrtf(q / (256.0f * (float)ntn) + eps)};
        }
        asm volatile("s_waitcnt lgkmcnt(0)" ::: "memory"); __builtin_amdgcn_s_barrier(); asm volatile("" ::: "memory");
        return bad;
    }
};
struct EpiLnRes {
    static constexpr bool PERM = false, AFTER_DRAIN = true;
    const float* base; float* out; int ldc; const float* bias; PanelStats st; unsigned poison;
    __device__ __forceinline__ void fused(f32x4 (&acc)[2][2][4][2], const Unit& u, int wr, int wc, int fr, int fq, PG8_LAS unsigned char* lds, int wid, int lane) const {
        typedef float f32x2v __attribute__((ext_vector_type(2)));
        const PG8_LAS f32x2v* S = (const PG8_LAS f32x2v*)(lds + 8192);
        const int col0 = u.pn * BM + wc * 32 + 4 * fq;
#pragma unroll
        for (int bj = 0; bj < 2; ++bj)
#pragma unroll
            for (int n = 0; n < 2; ++n) { const f32x4 bv = bias ? *(const f32x4*)(bias + col0 + bj * HALF + n * 16) : (f32x4){0.f, 0.f, 0.f, 0.f};
#pragma unroll
                for (int ai = 0; ai < 2; ++ai)
#pragma unroll
                    for (int m = 0; m < 4; ++m) acc[ai][bj][m][n] += bv; }
        f32x4 pre[4][2][2];
#pragma unroll
        for (int m = 0; m < 4; ++m) { const size_t off = (size_t)(u.pm * BM + wr * 64 + m * 16 + fr) * ldc + col0;
#pragma unroll
            for (int bj = 0; bj < 2; ++bj)
#pragma unroll
                for (int n = 0; n < 2; ++n) pre[m][bj][n] = *(const f32x4*)(base + off + bj * HALF + n * 16); }
        const bool bad = st.run(acc, u, wr, wc, fr, fq, lds, wid, lane) || poison != 0u;
        const float qnan = __builtin_nanf("");
#pragma unroll
        for (int ai = 0; ai < 2; ++ai)
#pragma unroll
            for (int m = 0; m < 4; ++m) { const int r = ai * HALF + wr * 64 + m * 16 + fr; const f32x2v sr = S[r]; const size_t off = (size_t)(u.pm * BM + r) * ldc + col0;
#pragma unroll
                for (int bj = 0; bj < 2; ++bj)
#pragma unroll
                    for (int n = 0; n < 2; ++n) { const f32x4 bs = ai == 0 ? pre[m][bj][n] : *(const f32x4*)(base + off + bj * HALF + n * 16); f32x4 o = bs + (acc[ai][bj][m][n] - sr.x) * sr.y;
                        if (bad) o = (f32x4){qnan, qnan, qnan, qnan}; *(f32x4*)(out + off + bj * HALF + n * 16) = o; }
                if (m & 1) asm volatile("" ::: "memory"); }
    }
};
struct EpiLnResLn {
    static constexpr bool PERM = false, AFTER_DRAIN = true;
    const float* base; float* out; bf16_t* xn; int ldc; const float* bias; PanelStats st1, st2; unsigned poison;
    __device__ __forceinline__ void fused(f32x4 (&acc)[2][2][4][2], const Unit& u, int wr, int wc, int fr, int fq, PG8_LAS unsigned char* lds, int wid, int lane) const {
        typedef float f32x2v __attribute__((ext_vector_type(2))); typedef unsigned u32x2v __attribute__((ext_vector_type(2)));
        const PG8_LAS f32x2v* S = (const PG8_LAS f32x2v*)(lds + 8192);
        const int col0 = u.pn * BM + wc * 32 + 4 * fq;
#pragma unroll
        for (int bj = 0; bj < 2; ++bj)
#pragma unroll
            for (int n = 0; n < 2; ++n) { const f32x4 bv = bias ? *(const f32x4*)(bias + col0 + bj * HALF + n * 16) : (f32x4){0.f, 0.f, 0.f, 0.f};
#pragma unroll
                for (int ai = 0; ai < 2; ++ai)
#pragma unroll
                    for (int m = 0; m < 4; ++m) acc[ai][bj][m][n] += bv; }
        bool bad = st1.run(acc, u, wr, wc, fr, fq, lds, wid, lane) || poison != 0u;
        const float qnan = __builtin_nanf("");
#pragma unroll
        for (int ai = 0; ai < 2; ++ai)
#pragma unroll
            for (int m = 0; m < 4; ++m) { const int r = ai * HALF + wr * 64 + m * 16 + fr; const f32x2v sr = S[r]; const size_t off = (size_t)(u.pm * BM + r) * ldc + col0;
#pragma unroll
                for (int bj = 0; bj < 2; ++bj)
#pragma unroll
                    for (int n = 0; n < 2; ++n) { const f32x4 bs = *(const f32x4*)(base + off + bj * HALF + n * 16); acc[ai][bj][m][n] = bs + (acc[ai][bj][m][n] - sr.x) * sr.y; }
                asm volatile("" : "+v"(acc[ai][0][m][0]), "+v"(acc[ai][0][m][1]), "+v"(acc[ai][1][m][0]), "+v"(acc[ai][1][m][1]));
                if (m & 1) asm volatile("" ::: "memory"); }
        const bool bad1 = bad;
        bad = st2.run(acc, u, wr, wc, fr, fq, lds, wid, lane) || bad;
#pragma unroll
        for (int ai = 0; ai < 2; ++ai)
#pragma unroll
            for (int m = 0; m < 4; ++m) { const int r = ai * HALF + wr * 64 + m * 16 + fr; const f32x2v sr = S[r]; const size_t off = (size_t)(u.pm * BM + r) * ldc + col0;
#pragma unroll
                for (int bj = 0; bj < 2; ++bj)
#pragma unroll
                    for (int n = 0; n < 2; ++n) { const f32x4 x1 = acc[ai][bj][m][n]; *(f32x4*)(out + off + bj * HALF + n * 16) = bad1 ? (f32x4){qnan, qnan, qnan, qnan} : x1;
                        const f32x4 o = (x1 - sr.x) * sr.y; u32x2v w; w.x = cvt_pk_bf16(o[0], o[1]); w.y = cvt_pk_bf16(o[2], o[3]);
                        if (bad) { w.x = 0x7fc07fc0u; w.y = 0x7fc07fc0u; } *(u32x2v*)(xn + off + bj * HALF + n * 16) = w; }
                asm volatile("" ::: "memory"); }
    }
};

template <class Epi, class Sched, bool ALIGN_EPI = false, bool SP2 = false>
__device__ __forceinline__ void gemm_phase(PG8_LAS unsigned char* lds, const Gemm g, const Sched& S, const Epi& E) {
    const int tid = threadIdx.x, wid = __builtin_amdgcn_readfirstlane(tid >> 6), lane = tid & 63, wr = wid >> 2, wc = wid & 3, fr = lane & 15, fq = lane >> 4;
    const int K = g.K, nt = K / BK;
    unsigned voffA[2], voffB[2];
#pragma unroll
    for (int i = 0; i < 2; ++i) { int R, C; stage_rc(tid * 16 + i * 8192, R, C); const int Rb = Epi::PERM ? ((R & ~31) + perm32(R & 31)) : R;
        voffA[i] = (unsigned)(R * K + C) * 2u; voffB[i] = (unsigned)(Rb * K + C) * 2u; }
    const size_t kstep = (size_t)(BK * 2);
    const size_t hstep = (size_t)HALF * K * 2;
    const size_t tstep = 2 * hstep;
    const unsigned ldsw = (unsigned)wid * 1024u;
    const int aoff = lds_byte(wr * 64 + fr, fq * 8), boff = lds_byte(wc * 32 + fr, fq * 8);
#define PG8_SA(b, h) (((b) * 2 + (h)) * HTB)
#define PG8_SB(b, h) ((4 + (b) * 2 + (h)) * HTB)
#define PG8_STAGE(bufoff, gbase, voff) do { _Pragma("unroll") for (int _i = 0; _i < 2; ++_i) \
        __builtin_amdgcn_global_load_lds((const unsigned*)((const char*)(gbase) + (voff)[_i]), (PG8_LAS unsigned*)(lds + (bufoff) + ldsw + _i * 8192), 16, 0, 0); } while (0)
#define PG8_LDA(dst, b, h) do { _Pragma("unroll") for (int m = 0; m < 4; ++m) _Pragma("unroll") for (int k = 0; k < 2; ++k) dst[m][k] = *(const PG8_LAS bf16x8*)(lds + PG8_SA(b, h) + aoff + m * 2048 + k * 1024); } while (0)
#define PG8_LDB(dst, b, h) do { _Pragma("unroll") for (int n = 0; n < 2; ++n) _Pragma("unroll") for (int k = 0; k < 2; ++k) dst[n][k] = *(const PG8_LAS bf16x8*)(lds + PG8_SB(b, h) + boff + n * 2048 + k * 1024); } while (0)
#define PG8_MMA(ai, bj, At, Bt) do { __builtin_amdgcn_s_setprio(1); _Pragma("unroll") for (int m = 0; m < 4; ++m) _Pragma("unroll") for (int n = 0; n < 2; ++n) _Pragma("unroll") for (int k = 0; k < 2; ++k) \
        acc[ai][bj][m][n] = __builtin_amdgcn_mfma_f32_16x16x32_bf16(Bt[n][k], At[m][k], acc[ai][bj][m][n], 0, 0, 0); __builtin_amdgcn_s_setprio(0); } while (0)
#define PG8_WAIT_V(n) asm volatile("s_waitcnt vmcnt(" #n ")" ::: "memory")
#define PG8_WAIT_L(n) asm volatile("s_waitcnt lgkmcnt(" #n ")" ::: "memory")
#define PG8_BAR __builtin_amdgcn_s_barrier()
#define PG8_SCHED __builtin_amdgcn_sched_barrier(0)
    Unit cur, nxt; int ui = 0;
    if (!S.next(0, cur)) return;
    f32x4 acc[2][2][4][2];
#pragma unroll
    for (int a = 0; a < 2; ++a)
#pragma unroll
        for (int b = 0; b < 2; ++b)
#pragma unroll
            for (int m = 0; m < 4; ++m)
#pragma unroll
                for (int n = 0; n < 2; ++n) acc[a][b][m][n] = (f32x4){0.f, 0.f, 0.f, 0.f};
    bf16x8 At[4][2], B0[2][2], B1[2][2];
    const char* cA = (const char*)g.A + (size_t)cur.pm * tstep; const char* cB = (const char*)g.Bt + (size_t)cur.pn * tstep;
    S.a_ready(cur);
    if constexpr (SP2) {
        PG8_STAGE(PG8_SB(0, 0), cB, voffB); PG8_STAGE(PG8_SB(0, 1), cB + hstep, voffB); PG8_STAGE(PG8_SA(0, 0), cA, voffA); PG8_STAGE(PG8_SA(0, 1), cA + hstep, voffA);
        if (wr == 1) PG8_BAR;
        PG8_WAIT_V(2); PG8_BAR;
        PG8_STAGE(PG8_SB(1, 0), cB + kstep, voffB); PG8_STAGE(PG8_SA(1, 0), cA + kstep, voffA); PG8_STAGE(PG8_SB(1, 1), cB + hstep + kstep, voffB);
        PG8_WAIT_V(6); PG8_BAR;
    } else {
        PG8_STAGE(PG8_SB(0, 0), cB, voffB); PG8_STAGE(PG8_SA(0, 0), cA, voffA); PG8_STAGE(PG8_SB(0, 1), cB + hstep, voffB); PG8_STAGE(PG8_SA(0, 1), cA + hstep, voffA);
        if (wr == 1) PG8_BAR;
        PG8_WAIT_V(4); PG8_BAR;
        PG8_STAGE(PG8_SB(1, 0), cB + kstep, voffB); PG8_STAGE(PG8_SA(1, 0), cA + kstep, voffA); PG8_STAGE(PG8_SB(1, 1), cB + hstep + kstep, voffB);
        PG8_WAIT_V(6); PG8_BAR;
    }
    for (;;) {
        const bool has_next = S.next(ui + 1, nxt);
        const char* nA = has_next ? (const char*)g.A + (size_t)nxt.pm * tstep : cA; const char* nB = has_next ? (const char*)g.Bt + (size_t)nxt.pn * tstep : cB;
        for (int t = 0; t < nt; t += 2) {
            const bool last = (t == nt - 2);
            const char* a1 = cA + (size_t)(t + 1) * kstep;
            const char* a2 = last ? nA : cA + (size_t)(t + 2) * kstep; const char* b2 = last ? nB : cB + (size_t)(t + 2) * kstep;
            const char* a3 = a2 + kstep; const char* b3 = b2 + kstep;
            if (last && has_next) S.a_ready(nxt);
            if constexpr (SP2) {
            PG8_LDB(B0, 0, 0); PG8_LDB(B1, 0, 1); PG8_SCHED; PG8_LDA(At, 0, 0); PG8_STAGE(PG8_SA(1, 1), a1 + hstep, voffA);
            PG8_WAIT_V(8); PG8_WAIT_L(0); PG8_BAR; PG8_MMA(0, 0, At, B0); PG8_MMA(0, 1, At, B1); PG8_BAR; PG8_SCHED;
            PG8_LDA(At, 0, 1); PG8_STAGE(PG8_SB(0, 0), b2, voffB); PG8_STAGE(PG8_SB(0, 1), b2 + hstep, voffB); PG8_STAGE(PG8_SA(0, 0), a2, voffA);
            PG8_WAIT_V(8); PG8_WAIT_L(0); PG8_BAR; PG8_MMA(1, 0, At, B0); PG8_MMA(1, 1, At, B1); PG8_BAR; PG8_SCHED;
            PG8_LDB(B0, 1, 0); PG8_LDB(B1, 1, 1); PG8_SCHED; PG8_LDA(At, 1, 0); PG8_STAGE(PG8_SA(0, 1), a2 + hstep, voffA);
            PG8_WAIT_V(8); PG8_WAIT_L(0); PG8_BAR; PG8_MMA(0, 0, At, B0); PG8_MMA(0, 1, At, B1); PG8_BAR; PG8_SCHED;
            PG8_LDA(At, 1, 1); PG8_STAGE(PG8_SB(1, 0), b3, voffB); PG8_STAGE(PG8_SB(1, 1), b3 + hstep, voffB); PG8_STAGE(PG8_SA(1, 0), a3, voffA);
            PG8_WAIT_V(8); PG8_WAIT_L(0); PG8_BAR; PG8_MMA(1, 0, At, B0); PG8_MMA(1, 1, At, B1); PG8_BAR; PG8_SCHED;
            } else {
            PG8_LDB(B0, 0, 0); PG8_SCHED; PG8_LDA(At, 0, 0); PG8_STAGE(PG8_SA(1, 1), a1 + hstep, voffA);
            PG8_WAIT_L(8); PG8_BAR; PG8_WAIT_L(0); PG8_MMA(0, 0, At, B0); PG8_BAR; PG8_SCHED;
            PG8_LDB(B1, 0, 1); PG8_STAGE(PG8_SB(0, 0), b2, voffB);
            PG8_BAR; PG8_WAIT_L(0); PG8_MMA(0, 1, At, B1); PG8_BAR;
            PG8_LDA(At, 0, 1); PG8_STAGE(PG8_SA(0, 0), a2, voffA);
            PG8_BAR; PG8_WAIT_L(0); PG8_MMA(1, 0, At, B0); PG8_BAR; PG8_SCHED;
            PG8_STAGE(PG8_SB(0, 1), b2 + hstep, voffB);
            PG8_WAIT_V(6); PG8_BAR; PG8_MMA(1, 1, At, B1); PG8_BAR;
            PG8_LDB(B0, 1, 0); PG8_SCHED; PG8_LDA(At, 1, 0); PG8_STAGE(PG8_SA(0, 1), a2 + hstep, voffA);
            PG8_WAIT_L(8); PG8_BAR; PG8_WAIT_L(0); PG8_MMA(0, 0, At, B0); PG8_BAR; PG8_SCHED;
            PG8_LDB(B1, 1, 1); PG8_STAGE(PG8_SB(1, 0), b3, voffB);
            PG8_BAR; PG8_WAIT_L(0); PG8_MMA(0, 1, At, B1); PG8_BAR;
            PG8_LDA(At, 1, 1); PG8_STAGE(PG8_SA(1, 0), a3, voffA);
            PG8_BAR; PG8_WAIT_L(0); PG8_MMA(1, 0, At, B0); PG8_BAR; PG8_SCHED;
            PG8_STAGE(PG8_SB(1, 1), b3 + hstep, voffB);
            PG8_WAIT_V(6); PG8_BAR; PG8_MMA(1, 1, At, B1); PG8_BAR;
            }
        }
        if constexpr (ALIGN_EPI) { if (wr == 0) PG8_BAR; }
        if constexpr (!Epi::AFTER_DRAIN) { E(acc, cur, wr, wc, fr, fq); S.done(cur); }
        if (!has_next) break;
#pragma unroll
        for (int a = 0; a < 2; ++a)
#pragma unroll
            for (int b = 0; b < 2; ++b)
#pragma unroll
                for (int m = 0; m < 4; ++m)
#pragma unroll
                    for (int n = 0; n < 2; ++n) acc[a][b][m][n] = (f32x4){0.f, 0.f, 0.f, 0.f};
        cur = nxt; cA = nA; cB = nB; ++ui;
        if constexpr (ALIGN_EPI) { if (wr == 1) PG8_BAR; }
    }
    PG8_WAIT_V(0);
    if constexpr (!ALIGN_EPI) { if (wr == 0) PG8_BAR; }
    PG8_BAR;
    if constexpr (Epi::AFTER_DRAIN) { E.fused(acc, cur, wr, wc, fr, fq, lds, wid, lane); S.done(cur); }
#undef PG8_SA
#undef PG8_SB
#undef PG8_STAGE
#undef PG8_LDA
#undef PG8_LDB
#undef PG8_MMA
#undef PG8_WAIT_V
#undef PG8_WAIT_L
#undef PG8_BAR
#undef PG8_SCHED
}
}
#define GAS __attribute__((address_space(1)))
#define LAS __attribute__((address_space(3)))
typedef unsigned short bf16;
typedef unsigned v4u __attribute__((ext_vector_type(4)));
typedef float f32x4 __attribute__((ext_vector_type(4)));
typedef short bf16x8 __attribute__((ext_vector_type(8)));
typedef GAS unsigned gu32;
typedef GAS unsigned long long gu64;
#define RLX_AGENT __ATOMIC_RELAXED, __HIP_MEMORY_SCOPE_AGENT
#define LDS_WAIT() asm volatile("s_waitcnt lgkmcnt(0)" ::: "memory")
#define VM_WAIT() asm volatile("s_waitcnt vmcnt(0)" ::: "memory")
__device__ __forceinline__ unsigned long long rt() { return __builtin_amdgcn_s_memrealtime(); }
__device__ __forceinline__ unsigned f2bf(float f) { unsigned u = __builtin_bit_cast(unsigned, f); return (u + 0x7fffu + ((u >> 16) & 1u)) >> 16; }
__device__ __forceinline__ unsigned pk2(float lo, float hi) { return f2bf(lo) | (f2bf(hi) << 16); }

#define XB_TMO      128
#define XB_XCNT(j)  (256  + 64 * (j))
#define XB_XSUB(j)  (1280 + 64 * (j))
#define XB_XGEN(j)  (2304 + 64 * (j))
#define XB_TOP      3328
#define XB_TOPGEN   3392
#define XCD_BAR_WORDS 3456
#define XB_SPIN_CAP (1u << 18)

__device__ __forceinline__ unsigned xb_ld(unsigned* p)              { return __hip_atomic_load(p, __ATOMIC_RELAXED, __HIP_MEMORY_SCOPE_AGENT); }
__device__ __forceinline__ unsigned xb_add(unsigned* p, unsigned v) { return __hip_atomic_fetch_add(p, v, __ATOMIC_RELAXED, __HIP_MEMORY_SCOPE_AGENT); }
__device__ __forceinline__ unsigned xb_xcc_id() { return (unsigned)__builtin_amdgcn_s_getreg((3 << 11) | 20) & 0xFu; }
#define XB_SPIN(cond, bar) do { unsigned _sp = 0; while (cond) { __builtin_amdgcn_s_sleep(1); \
    if ((++_sp & 255u) == 0u) { if (xb_ld(&(bar)[XB_TMO])) break; if (_sp > XB_SPIN_CAP) { atomicAdd(&(bar)[XB_TMO], 1u); break; } } } } while (0)

struct XcdBarrier {
    unsigned* bar; unsigned x;
    volatile LAS unsigned* st;
};

__device__ __forceinline__ XcdBarrier xcd_barrier_post(unsigned* bar, volatile LAS unsigned* st) {
    XcdBarrier b; b.bar = bar; b.x = xb_xcc_id(); b.st = st;
    if (threadIdx.x == 0) (void)xb_add(&bar[XB_XCNT(b.x)], 1u);
    return b;
}
__device__ __forceinline__ void xcd_barrier_complete(unsigned* bar, unsigned x, unsigned& nloc, unsigned& nx) {
    const unsigned G = gridDim.x * gridDim.y * gridDim.z;
    unsigned sum, cnt, mine, sp = 0u;
    for (;;) {
        sum = 0u; cnt = 0u; mine = 0u;
#pragma unroll
        for (unsigned j = 0; j < 16; ++j) { const unsigned c = xb_ld(&bar[XB_XCNT(j)]); sum += c; cnt += (c > 0u) ? 1u : 0u; mine = (j == x) ? c : mine; }
        if (sum == G) break;
        __builtin_amdgcn_s_sleep(1);
        if ((++sp & 255u) == 0u) { if (xb_ld(&bar[XB_TMO])) break; if (sp > XB_SPIN_CAP) { atomicAdd(&bar[XB_TMO], 1u); break; } }
    }
    nloc = mine > 0u ? mine : 1u; nx = cnt > 0u ? cnt : 1u;
}

__device__ __forceinline__ void xcd_barrier(const XcdBarrier& b) {
    asm volatile("s_waitcnt vmcnt(0)" ::: "memory");
    __syncthreads();
    if (threadIdx.x == 0) {
        unsigned* bar = b.bar;
        __builtin_amdgcn_s_waitcnt(0);
        unsigned nloc = b.st[0], nx = b.st[1];
        if (nloc == 0u) { xcd_barrier_complete(bar, b.x, nloc, nx); b.st[0] = nloc; b.st[1] = nx; }
        const unsigned old = xb_add(&bar[XB_XSUB(b.x)], 1u);
        const unsigned gen = old / nloc;
        if (old + 1u == (gen + 1u) * nloc) {
            __builtin_amdgcn_fence(__ATOMIC_RELEASE, "agent");
            asm volatile("s_waitcnt vmcnt(0)" ::: "memory");
            const unsigned og = xb_add(&bar[XB_TOP], 1u);
            const unsigned tg = og / nx;
            if (og + 1u == (tg + 1u) * nx) xb_add(&bar[XB_TOPGEN], 1u);
            else XB_SPIN(xb_ld(&bar[XB_TOPGEN]) == tg, bar);
            __builtin_amdgcn_fence(__ATOMIC_ACQUIRE, "agent");
            xb_add(&bar[XB_XGEN(b.x)], 1u);
            asm volatile("s_waitcnt vmcnt(0)" ::: "memory");
        } else {
            XB_SPIN(xb_ld(&bar[XB_XGEN(b.x)]) == gen, bar);
            __builtin_amdgcn_fence(__ATOMIC_ACQUIRE, "agent");
            asm volatile("s_waitcnt vmcnt(0)" ::: "memory");
        }
    }
    __syncthreads();
}
constexpr int NWAVES = 8;
#ifndef MK_N_LAUNCHES
#define MK_N_LAUNCHES 1
#endif
constexpr int N_PHASES = 8;
constexpr int N_LAUNCHES = MK_N_LAUNCHES;

constexpr int BATCH = 2, T = 8192, D = 1024, M = BATCH * T;
constexpr int NIN = 3200, LDP = 3328;
constexpr int SEG0 = 1024;
constexpr int C_R = 0, C_WLO = 512, C_K = 576, C_V = 1088, C_ALO = 1600, C_Z = 1664;
constexpr float NORM_EPS = 1e-6f, GN_EPS = 64e-5f;

constexpr size_t MiB = 1u << 20;
constexpr size_t WS_CTL = 0, CTL_ZERO_BYTES = 1 * MiB;
constexpr size_t WS_W1T = 1 * MiB, WS_W2T = 8 * MiB, WS_XN = 10 * MiB, WS_P = 42 * MiB, WS_MIX = 146 * MiB, WS_BONUS = 178 * MiB;
constexpr size_t WS_RS = 10 * MiB, WS_KS = 26 * MiB, WS_VS = 179 * MiB, WS_AM = 195 * MiB, WS_BB = 211 * MiB, WS_ES = 227 * MiB, WS_Y = 42 * MiB;
constexpr size_t WS_END = 256 * MiB;
constexpr int CW_BAR = 4096;
constexpr size_t CTL_MOD = 65536, CTL_ROWSS = 131072;

constexpr int RING_BYTES = 131072, LDSCTL_OFF = RING_BYTES, MISC_OFF = LDSCTL_OFF + 320, LDS_BYTES = 147456;

struct Frame {
    LAS unsigned char* lds;
    volatile LAS unsigned* MISC;
    int tid, lane, wave, vcu, G;
    const float *x, *c, *w_ada, *b_ada, *norm_g, *w_in, *pool_w, *pool_scale, *mu, *w0, *w_up, *a0, *a_up, *k_k, *k_a, *r_k, *ln_w, *ln_b, *w_out, *final_g;
    float* out;
    float *mod, *rowss, *bonus, *Y;
    bf16 *W1t, *W2t, *XN, *P, *MIX, *RS, *KS, *VS, *AM, *BB, *ES;
};

__device__ __forceinline__ float bf2f(unsigned short u) { return __builtin_bit_cast(float, (unsigned)u << 16); }
__device__ __forceinline__ float bflo(unsigned u) { return __builtin_bit_cast(float, u << 16); }
__device__ __forceinline__ float bfhi(unsigned u) { return __builtin_bit_cast(float, u & 0xffff0000u); }
__device__ __forceinline__ float sigmoidf_(float v) { return 1.f / (1.f + __expf(-v)); }
__device__ __forceinline__ float siluf_(float v) { return v / (1.f + __expf(-v)); }
__device__ __forceinline__ float wave_sum(float v) {
#pragma unroll
    for (int o = 1; o < 64; o <<= 1) v += __shfl_xor(v, o);
    return v;
}

__device__ __forceinline__ void p0_transpose_item(const float* W, int K, int N, bf16* WT, LAS float* scr, int item, int lane) {
    const int nblk = N / 32, kb = item / nblk, nb = item % nblk, k0 = 64 * kb, n0 = 32 * nb;
#pragma unroll 8
    for (int i = 0; i < 32; ++i) { const int kk = 2 * i + (lane >> 5); scr[kk * 33 + (lane & 31)] = W[(size_t)(k0 + kk) * N + n0 + (lane & 31)]; }
    LDS_WAIT(); asm volatile("" ::: "memory");
    const int c = lane & 7;
#pragma unroll
    for (int j = 0; j < 4; ++j) { const int n = (lane >> 3) + 8 * j; const LAS float* s = scr + (8 * c) * 33 + n;
        v4u o; o.x = pk2(s[0 * 33], s[1 * 33]); o.y = pk2(s[2 * 33], s[3 * 33]); o.z = pk2(s[4 * 33], s[5 * 33]); o.w = pk2(s[6 * 33], s[7 * 33]);
        *(v4u*)(WT + (size_t)(n0 + n) * K + k0 + 8 * c) = o; }
    LDS_WAIT(); asm volatile("" ::: "memory");
}

__device__ __forceinline__ void p0_prologue(Frame& F) {
    LAS float* scr = (LAS float*)(F.lds + F.wave * 16384);
    const int gw = F.vcu * NWAVES + F.wave, NGW = F.G * NWAVES;
    constexpr int I_1 = (D / 64) * (NIN / 32), I_2 = (D / 64) * (D / 32), I_Z = (LDP - NIN) * D * 2 / 1024;
    for (int it = gw; it < I_1 + I_2 + I_Z; it += NGW) {
        int r = it;
        if (r < I_1) { p0_transpose_item(F.w_in, D, NIN, F.W1t, scr, r, F.lane); continue; } r -= I_1;
        if (r < I_2) { p0_transpose_item(F.w_out, D, D, F.W2t, scr, r, F.lane); continue; } r -= I_2;
        *(v4u*)((unsigned char*)(F.W1t + (size_t)NIN * D) + (size_t)r * 1024 + F.lane * 16) = (v4u){0u, 0u, 0u, 0u};
    }
    __syncthreads();
    LAS float* red = (LAS float*)F.lds;
    for (int u = blockIdx.x; u < 192; u += F.G) {
        const int cg = u % 48, ks = u / 48, n = cg * 64 + F.lane, k0 = ks * 256 + F.wave * 32;
        float s0 = 0.f, s1 = 0.f;
#pragma unroll 8
        for (int kk = 0; kk < 32; ++kk) { const float wv = F.w_ada[(size_t)(k0 + kk) * 3072 + n]; s0 += F.c[k0 + kk] * wv; s1 += F.c[D + k0 + kk] * wv; }
        red[F.wave * 128 + F.lane] = s0; red[F.wave * 128 + 64 + F.lane] = s1;
        __syncthreads();
        if (F.wave < 2) { float s = 0.f;
#pragma unroll
            for (int w = 0; w < 8; ++w) s += red[w * 128 + F.wave * 64 + F.lane];
            if (ks == 0) s += F.b_ada[n];
            __hip_atomic_fetch_add(F.mod + F.wave * 3072 + n, s, __ATOMIC_RELAXED, __HIP_MEMORY_SCOPE_AGENT); }
        __syncthreads();
    }
}

__device__ __forceinline__ void p1_hrows(Frame& F) {
    const int gw = F.vcu * NWAVES + F.wave, NGW = F.G * NWAVES;
    for (int m = gw; m < M; m += NGW) {
        const int b = m >> 13;
        const f32x4* xr = (const f32x4*)(F.x + (size_t)m * D) + F.lane;
        f32x4 v[4]; float s = 0.f;
#pragma unroll
        for (int j = 0; j < 4; ++j) { v[j] = xr[64 * j]; s += (v[j].x * v[j].x + v[j].y * v[j].y) + (v[j].z * v[j].z + v[j].w * v[j].w); }
        const float rstd = 1.f / sqrtf(wave_sum(s) * (1.f / D) + NORM_EPS);
        unsigned long long* o8 = (unsigned long long*)(F.XN + (size_t)m * D) + F.lane;
#pragma unroll
        for (int j = 0; j < 4; ++j) {
            const f32x4 g = ((const f32x4*)F.norm_g)[F.lane + 64 * j];
            const f32x4 sh = ((const f32x4*)(F.mod + b * 3072))[F.lane + 64 * j];
            const f32x4 sc = ((const f32x4*)(F.mod + b * 3072 + 1024))[F.lane + 64 * j];
            const f32x4 h = v[j] * rstd * g * (sc + 1.f) + sh;
            o8[64 * j] = (unsigned long long)pk2(h.x, h.y) | ((unsigned long long)pk2(h.z, h.w) << 32);
        }
    }
}

template <int GI> __device__ __forceinline__ void pool_item(Frame& F, int tb, LAS float* scr) {
    constexpr int WIN = 2 << GI;
    const int t0 = tb * 8, pos0 = t0 & (T - 1), lane = F.lane;
    float u0[23], u1[23];
#pragma unroll
    for (int q = 0; q < 23; ++q) { const int pos = pos0 - 15 + q; unsigned w = 0u;
        if (q >= 16 - WIN) { if (pos >= 0) w = *(const unsigned*)(F.P + (size_t)(t0 - 15 + q) * LDP + GI * 128 + 2 * lane); }
        u0[q] = bflo(w); u1[q] = bfhi(w); }
#pragma unroll
    for (int tt = 0; tt < 8; ++tt) { float s0 = 0.f, s1 = 0.f;
#pragma unroll
        for (int q = 0; q < WIN; ++q) { s0 += u0[tt + 15 - q]; s1 += u1[tt + 15 - q]; }
        const int pos = pos0 + tt; const float cnt = (float)((pos + 1 < WIN) ? (pos + 1) : WIN);
        scr[(2 * lane) * 8 + tt] = s0 / cnt - u0[tt + 15]; scr[(2 * lane + 1) * 8 + tt] = s1 / cnt - u1[tt + 15]; }
    LDS_WAIT(); asm volatile("" ::: "memory");
    float acc0[8], acc1[8];
#pragma unroll
    for (int tt = 0; tt < 8; ++tt) { acc0[tt] = 0.f; acc1[tt] = 0.f; }
    const float* pw = F.pool_w + (size_t)GI * 128 * 128 + 2 * lane;
#pragma unroll 4
    for (int c = 0; c < 128; ++c) {
        const f32x4 da = *(const LAS f32x4*)(scr + c * 8), db = *(const LAS f32x4*)(scr + c * 8 + 4);
        const float w0 = pw[c * 128], w1 = pw[c * 128 + 1];
        acc0[0] += da.x * w0; acc1[0] += da.x * w1; acc0[1] += da.y * w0; acc1[1] += da.y * w1; acc0[2] += da.z * w0; acc1[2] += da.z * w1; acc0[3] += da.w * w0; acc1[3] += da.w * w1;
        acc0[4] += db.x * w0; acc1[4] += db.x * w1; acc0[5] += db.y * w0; acc1[5] += db.y * w1; acc0[6] += db.z * w0; acc1[6] += db.z * w1; acc0[7] += db.w * w0; acc1[7] += db.w * w1;
    }
    const float ps0 = F.pool_scale[GI * 128 + 2 * lane], ps1 = F.pool_scale[GI * 128 + 2 * lane + 1];
#pragma unroll
    for (int tt = 0; tt < 8; ++tt) {
        const unsigned zw = *(const unsigned*)(F.P + (size_t)(t0 + tt) * LDP + 512 + GI * 128 + 2 * lane);
        const float y0 = acc0[tt] * ps0 * siluf_(bflo(zw)), y1 = acc1[tt] * ps1 * siluf_(bfhi(zw));
        *(unsigned*)(F.MIX + (size_t)(t0 + tt) * D + GI * 128 + 2 * lane) = pk2(y0, y1);
    }
    LDS_WAIT(); asm volatile("" ::: "memory");
}

__device__ __forceinline__ void prep_item(Frame& F, int tb, int half, LAS float* scr) {
    const int t0 = tb * 8, pos0 = t0 & (T - 1), lane = F.lane;
    const bf16* Ps = F.P + SEG0;
    {
        float pw = 0.f, pa = 0.f;
        if (pos0 > 0) { pw = bf2f(Ps[(size_t)(t0 - 1) * LDP + C_WLO + lane]); pa = bf2f(Ps[(size_t)(t0 - 1) * LDP + C_ALO + lane]); }
        const float muw = F.mu[C_WLO + lane], mua = F.mu[C_ALO + lane];
#pragma unroll
        for (int tt = 0; tt < 8; ++tt) {
            const float cw = bf2f(Ps[(size_t)(t0 + tt) * LDP + C_WLO + lane]), ca = bf2f(Ps[(size_t)(t0 + tt) * LDP + C_ALO + lane]);
            scr[lane * 8 + tt] = tanhf(cw + (pw - cw) * muw); scr[512 + lane * 8 + tt] = ca + (pa - ca) * mua; pw = cw; pa = ca; }
    }
    LDS_WAIT(); asm volatile("" ::: "memory");
    const int n0 = half * 256 + 4 * lane;
    f32x4 aw[8], aa[8];
#pragma unroll
    for (int tt = 0; tt < 8; ++tt) { aw[tt] = (f32x4){0.f, 0.f, 0.f, 0.f}; aa[tt] = (f32x4){0.f, 0.f, 0.f, 0.f}; }
#pragma unroll 2
    for (int q = 0; q < 64; ++q) {
        const f32x4 wa = *(const LAS f32x4*)(scr + q * 8), wb = *(const LAS f32x4*)(scr + q * 8 + 4);
        const f32x4 xa = *(const LAS f32x4*)(scr + 512 + q * 8), xb = *(const LAS f32x4*)(scr + 512 + q * 8 + 4);
        const f32x4 wu = *(const f32x4*)(F.w_up + q * 512 + n0), au = *(const f32x4*)(F.a_up + q * 512 + n0);
        aw[0] += wu * wa.x; aw[1] += wu * wa.y; aw[2] += wu * wa.z; aw[3] += wu * wa.w; aw[4] += wu * wb.x; aw[5] += wu * wb.y; aw[6] += wu * wb.z; aw[7] += wu * wb.w;
        aa[0] += au * xa.x; aa[1] += au * xa.y; aa[2] += au * xa.z; aa[3] += au * xa.w; aa[4] += au * xb.x; aa[5] += au * xb.y; aa[6] += au * xb.z; aa[7] += au * xb.w;
    }
    const f32x4 w0v = *(const f32x4*)(F.w0 + n0), a0v = *(const f32x4*)(F.a0 + n0), kkv = *(const f32x4*)(F.k_k + n0), kav = *(const f32x4*)(F.k_a + n0), rkv = *(const f32x4*)(F.r_k + n0);
    const f32x4 mur = *(const f32x4*)(F.mu + C_R + n0), muk = *(const f32x4*)(F.mu + C_K + n0), muv = *(const f32x4*)(F.mu + C_V + n0), muz = *(const f32x4*)(F.mu + C_Z + n0);
    f32x4 pr = (f32x4){0.f, 0.f, 0.f, 0.f}, pk = pr, pv = pr, pz = pr;
    typedef unsigned u32x2 __attribute__((ext_vector_type(2)));
#define LD4(col, row) ({ const u32x2 _w = *(const u32x2*)(Ps + (size_t)(row) * LDP + (col) + n0); (f32x4){bflo(_w.x), bfhi(_w.x), bflo(_w.y), bfhi(_w.y)}; })
#define ST4(ptr, row, ld, v) do { u32x2 _o; _o.x = pk2((v).x, (v).y); _o.y = pk2((v).z, (v).w); *(u32x2*)((ptr) + (size_t)(row) * (ld) + n0) = _o; } while (0)
    if (pos0 > 0) { pr = LD4(C_R, t0 - 1); pk = LD4(C_K, t0 - 1); pv = LD4(C_V, t0 - 1); pz = LD4(C_Z, t0 - 1); }
#pragma unroll
    for (int tt = 0; tt < 8; ++tt) {
        const int t = t0 + tt;
        const f32x4 cr = LD4(C_R, t), ck = LD4(C_K, t), cv = LD4(C_V, t), cz = LD4(C_Z, t);
        const f32x4 r = cr + (pr - cr) * mur, k = ck + (pk - ck) * muk, v = cv + (pv - cv) * muv, z = cz + (pz - cz) * muz;
        pr = cr; pk = ck; pv = cv; pz = cz;
        const f32x4 wr_ = w0v + aw[tt], ar_ = a0v + aa[tt];
        f32x4 e, a;
        e.x = 0.60653066f * sigmoidf_(wr_.x); e.y = 0.60653066f * sigmoidf_(wr_.y); e.z = 0.60653066f * sigmoidf_(wr_.z); e.w = 0.60653066f * sigmoidf_(wr_.w);
        a.x = sigmoidf_(ar_.x); a.y = sigmoidf_(ar_.y); a.z = sigmoidf_(ar_.z); a.w = sigmoidf_(ar_.w);
        f32x4 kk = k * kkv;
        float ss = (kk.x * kk.x + kk.y * kk.y) + (kk.z * kk.z + kk.w * kk.w);
        ss += __shfl_xor(ss, 1); ss += __shfl_xor(ss, 2); ss += __shfl_xor(ss, 4); ss += __shfl_xor(ss, 8);
        const float inv = 1.f / fmaxf(sqrtf(ss), 1e-12f);
        kk = kk * inv;
        const f32x4 km = k * ((a - 1.f) * kav + 1.f);
        const f32x4 bp = r * km * rkv;
        float bs = (bp.x + bp.y) + (bp.z + bp.w);
        bs += __shfl_xor(bs, 1); bs += __shfl_xor(bs, 2); bs += __shfl_xor(bs, 4); bs += __shfl_xor(bs, 8);
        if ((lane & 15) == 0) F.bonus[(size_t)t * 8 + half * 4 + (lane >> 4)] = bs;
        const f32x4 am = -kk, bb = kk * a;
        f32x4 sz; sz.x = siluf_(z.x); sz.y = siluf_(z.y); sz.z = siluf_(z.z); sz.w = siluf_(z.w);
        ST4(F.RS, t, 512, r); ST4(F.KS, t, 512, km); ST4(F.VS, t, 512, v); ST4(F.AM, t, 512, am); ST4(F.BB, t, 512, bb); ST4(F.ES, t, 512, e);
        ST4(F.MIX + 512, t, D, sz);
    }
#undef LD4
#undef ST4
    LDS_WAIT(); asm volatile("" ::: "memory");
}

__device__ __forceinline__ void p3_mixprep(Frame& F) {
    LAS float* scr = (LAS float*)(F.lds + F.wave * 16384);
    const int gw = F.vcu * NWAVES + F.wave, NGW = F.G * NWAVES;
    for (int it = gw; it < 8192; it += NGW) {
        const int g = it & 3, tb = it >> 2;
        if (g == 0) pool_item<0>(F, tb, scr); else if (g == 1) pool_item<1>(F, tb, scr); else if (g == 2) pool_item<2>(F, tb, scr); else pool_item<3>(F, tb, scr);
    }
    for (int it = gw; it < 4096; it += NGW) prep_item(F, it >> 1, it & 1, scr);
}

__device__ __forceinline__ void p4_scan(Frame& F) {
    const int gw = F.vcu * NWAVES + F.wave;
    if (gw >= 1024) return;
    const int b = gw >> 9, h = (gw >> 6) & 7, i = gw & 63, lane = F.lane;
    const size_t base = (size_t)b * T * 512 + h * 64;
    float S = 0.f;
#pragma unroll 4
    for (int t = 0; t < T; ++t) {
        const size_t o = base + (size_t)t * 512;
        const float r = bf2f(F.RS[o + lane]), e = bf2f(F.ES[o + lane]), k = bf2f(F.KS[o + lane]), am = bf2f(F.AM[o + lane]), bb = bf2f(F.BB[o + lane]), v = bf2f(F.VS[o + i]);
        const float sa = wave_sum(S * am);
        S = S * __expf(-e) + sa * bb + v * k;
        const float y = wave_sum(S * r);
        if (lane == 0) F.Y[o + i] = y;
    }
}

__device__ __forceinline__ void p5_post(Frame& F) {
    const int gw = F.vcu * NWAVES + F.wave, NGW = F.G * NWAVES, lane = F.lane, n0 = 8 * lane;
    const f32x4 lw0 = *(const f32x4*)(F.ln_w + n0), lw1 = *(const f32x4*)(F.ln_w + n0 + 4), lb0 = *(const f32x4*)(F.ln_b + n0), lb1 = *(const f32x4*)(F.ln_b + n0 + 4);
    for (int t = gw; t < M; t += NGW) {
        const f32x4 y0 = *(const f32x4*)(F.Y + (size_t)t * 512 + n0), y1 = *(const f32x4*)(F.Y + (size_t)t * 512 + n0 + 4);
        float s = ((y0.x + y0.y) + (y0.z + y0.w)) + ((y1.x + y1.y) + (y1.z + y1.w));
        s += __shfl_xor(s, 1); s += __shfl_xor(s, 2); s += __shfl_xor(s, 4);
        const float mean = s * (1.f / 64.f);
        const f32x4 d0 = y0 - mean, d1 = y1 - mean;
        float q = ((d0.x * d0.x + d0.y * d0.y) + (d0.z * d0.z + d0.w * d0.w)) + ((d1.x * d1.x + d1.y * d1.y) + (d1.z * d1.z + d1.w * d1.w));
        q += __shfl_xor(q, 1); q += __shfl_xor(q, 2); q += __shfl_xor(q, 4);
        const float rstd = 1.f / sqrtf(q * (1.f / 64.f) + GN_EPS);
        const float bo = F.bonus[(size_t)t * 8 + (lane >> 3)];
        const v4u vv = *(const v4u*)(F.VS + (size_t)t * 512 + n0);
        const v4u zz = *(const v4u*)(F.MIX + (size_t)t * D + 512 + n0);
        f32x4 o0 = d0 * rstd * lw0 + lb0, o1 = d1 * rstd * lw1 + lb1;
        o0 += bo * (f32x4){bflo(vv.x), bfhi(vv.x), bflo(vv.y), bfhi(vv.y)}; o1 += bo * (f32x4){bflo(vv.z), bfhi(vv.z), bflo(vv.w), bfhi(vv.w)};
        o0 = o0 * (f32x4){bflo(zz.x), bfhi(zz.x), bflo(zz.y), bfhi(zz.y)}; o1 = o1 * (f32x4){bflo(zz.z), bfhi(zz.z), bflo(zz.w), bfhi(zz.w)};
        v4u o; o.x = pk2(o0.x, o0.y); o.y = pk2(o0.z, o0.w); o.z = pk2(o1.x, o1.y); o.w = pk2(o1.z, o1.w);
        *(v4u*)(F.MIX + (size_t)t * D + 512 + n0) = o;
    }
}

struct EpiResGate {
    static constexpr bool PERM = false, AFTER_DRAIN = false;
    const float* x; const float* mod; float* out; float* rowss;
    __device__ __forceinline__ void operator()(const pg8::f32x4 (&acc)[2][2][4][2], const pg8::Unit& u, int wr, int wc, int fr, int fq) const {
        const int col0 = u.pn * 256 + wc * 32 + 4 * fq;
        const int b = (u.pm * 256) >> 13;
        const float* gate = mod + b * 3072 + 2048;
        f32x4 gv[2][2];
#pragma unroll
        for (int bj = 0; bj < 2; ++bj)
#pragma unroll
            for (int n = 0; n < 2; ++n) gv[bj][n] = *(const f32x4*)(gate + col0 + bj * 128 + n * 16);
#pragma unroll
        for (int ai = 0; ai < 2; ++ai)
#pragma unroll
            for (int m = 0; m < 4; ++m) { const int r = u.pm * 256 + ai * 128 + wr * 64 + m * 16 + fr; const size_t off = (size_t)r * D + col0; float ss = 0.f;
#pragma unroll
                for (int bj = 0; bj < 2; ++bj)
#pragma unroll
                    for (int n = 0; n < 2; ++n) { const f32x4 xv = *(const f32x4*)(x + off + bj * 128 + n * 16); const f32x4 o = xv + gv[bj][n] * acc[ai][bj][m][n];
                        *(f32x4*)(out + off + bj * 128 + n * 16) = o; ss += (o.x * o.x + o.y * o.y) + (o.z * o.z + o.w * o.w); }
                ss += __shfl_xor(ss, 16); ss += __shfl_xor(ss, 32);
                if (fq == 0) __hip_atomic_fetch_add(rowss + r, ss, __ATOMIC_RELAXED, __HIP_MEMORY_SCOPE_AGENT); }
    }
};

__device__ __forceinline__ void p7_final(Frame& F) {
    const int gw = F.vcu * NWAVES + F.wave, NGW = F.G * NWAVES;
    for (int m = gw; m < M; m += NGW) {
        const float rstd = 1.f / sqrtf(F.rowss[m] * (1.f / D) + NORM_EPS);
        f32x4* o = (f32x4*)(F.out + (size_t)m * D) + F.lane;
#pragma unroll
        for (int j = 0; j < 4; ++j) { const f32x4 g = ((const f32x4*)F.final_g)[F.lane + 64 * j]; o[64 * j] = o[64 * j] * rstd * g; }
    }
}

struct Args { const float* in[20]; float* out; unsigned char* ws; int ph_lo, ph_hi; };
__global__ void __launch_bounds__(NWAVES * 64, 2) fwd_kernel(Args args) {
    extern __shared__ __attribute__((aligned(16))) unsigned char lds[];
    Frame F;
    F.lds = (LAS unsigned char*)lds;
    F.MISC = (volatile LAS unsigned*)(F.lds + MISC_OFF);
    F.tid = threadIdx.x; F.lane = F.tid & 63; F.wave = __builtin_amdgcn_readfirstlane(F.tid >> 6);
    F.G = gridDim.x; { const int bx = blockIdx.x; F.vcu = (F.G % 8 == 0) ? (bx % 8) * (F.G / 8) + bx / 8 : bx; }
    unsigned char* ws = args.ws;
    F.x = args.in[0]; F.c = args.in[1]; F.w_ada = args.in[2]; F.b_ada = args.in[3]; F.norm_g = args.in[4]; F.w_in = args.in[5]; F.pool_w = args.in[6]; F.pool_scale = args.in[7];
    F.mu = args.in[8]; F.w0 = args.in[9]; F.w_up = args.in[10]; F.a0 = args.in[11]; F.a_up = args.in[12]; F.k_k = args.in[13]; F.k_a = args.in[14]; F.r_k = args.in[15];
    F.ln_w = args.in[16]; F.ln_b = args.in[17]; F.w_out = args.in[18]; F.final_g = args.in[19]; F.out = args.out;
    F.mod = (float*)(ws + WS_CTL + CTL_MOD); F.rowss = (float*)(ws + WS_CTL + CTL_ROWSS); F.bonus = (float*)(ws + WS_BONUS); F.Y = (float*)(ws + WS_Y);
    F.W1t = (bf16*)(ws + WS_W1T); F.W2t = (bf16*)(ws + WS_W2T); F.XN = (bf16*)(ws + WS_XN); F.P = (bf16*)(ws + WS_P); F.MIX = (bf16*)(ws + WS_MIX);
    F.RS = (bf16*)(ws + WS_RS); F.KS = (bf16*)(ws + WS_KS); F.VS = (bf16*)(ws + WS_VS); F.AM = (bf16*)(ws + WS_AM); F.BB = (bf16*)(ws + WS_BB); F.ES = (bf16*)(ws + WS_ES);
    for (int u = F.tid; u < (LDS_BYTES - LDSCTL_OFF) / 4; u += NWAVES * 64) ((LAS unsigned*)(F.lds + LDSCTL_OFF))[u] = 0u;
    __syncthreads();
    XcdBarrier bar; bar.bar = (unsigned*)(ws + WS_CTL) + CW_BAR; bar.x = 0; bar.st = nullptr;
    if (N_LAUNCHES == 1) bar = xcd_barrier_post((unsigned*)(ws + WS_CTL) + CW_BAR, F.MISC + 8);
    const int lo = args.ph_lo, hi = args.ph_hi;
#define IN(k) (lo <= (k) && (k) < hi)
#define SEAM(k) do { if (IN(k) && IN((k) + 1)) xcd_barrier(bar); } while (0)
    if (IN(0)) { p0_prologue(F); } SEAM(0);
    if (IN(1)) { p1_hrows(F); } SEAM(1);
    if (IN(2)) {
        pg8::Gemm g{F.XN, F.W1t, M, LDP, D}; pg8::StaticOrder S; S.init(M, LDP, F.G, (int)blockIdx.x);
        pg8::EpiBf16<0> E{F.P, LDP, nullptr, 0, 0, 1.f};
        pg8::gemm_phase<pg8::EpiBf16<0>, pg8::StaticOrder, true, true>(F.lds, g, S, E);
    } SEAM(2);
    if (IN(3)) { p3_mixprep(F); } SEAM(3);
    if (IN(4)) { p4_scan(F); } SEAM(4);
    if (IN(5)) { p5_post(F); } SEAM(5);
    if (IN(6)) {
        pg8::Gemm g{F.MIX, F.W2t, M, D, D}; pg8::StaticOrder S; S.init(M, D, F.G, (int)blockIdx.x);
        EpiResGate E{F.x, F.mod, F.out, F.rowss};
        pg8::gemm_phase<EpiResGate, pg8::StaticOrder, true, true>(F.lds, g, S, E);
    } SEAM(6);
    if (IN(7)) { p7_final(F); }
#undef IN
#undef SEAM
}

extern "C" void kernel_launch(void* const* d_in, const int* in_sizes, int n_in, void* d_out, int out_size, void* d_ws, size_t ws_size, hipStream_t stream) {
    static int grid = 0;
    if (grid == 0) {
        if (n_in != 20 || in_sizes[0] != M * D || out_size != M * D || ws_size < WS_END) { fprintf(stderr, "kernel_launch: unexpected shapes (n_in %d, in0 %d, out %d, ws %zu); nothing launched\n", n_in, n_in > 0 ? in_sizes[0] : -1, out_size, ws_size); grid = -1; return; }
        int dev = 0, cus = 0, per_cu = 0;
        if (hipGetDevice(&dev) != hipSuccess || hipDeviceGetAttribute(&cus, hipDeviceAttributeMultiprocessorCount, dev) != hipSuccess) { grid = -1; return; }
        if (hipFuncSetAttribute((const void*)fwd_kernel, hipFuncAttributeMaxDynamicSharedMemorySize, LDS_BYTES) != hipSuccess) { fprintf(stderr, "kernel_launch: hipFuncSetAttribute failed\n"); grid = -1; return; }
        if (hipOccupancyMaxActiveBlocksPerMultiprocessor(&per_cu, (const void*)fwd_kernel, NWAVES * 64, LDS_BYTES) != hipSuccess || per_cu < 1) { fprintf(stderr, "kernel_launch: occupancy query reports %d blocks per CU\n", per_cu); grid = -1; (void)hipGetLastError(); return; }
        (void)hipGetLastError();
        grid = cus;
    }
    if (grid < 0) return;
    if (hipMemsetAsync((char*)d_ws + WS_CTL, 0, CTL_ZERO_BYTES, stream) != hipSuccess) return;
    Args a{};
    for (int i = 0; i < 20; ++i) a.in[i] = (const float*)d_in[i];
    a.out = (float*)d_out; a.ws = (unsigned char*)d_ws;
    if (N_LAUNCHES == 1) { a.ph_lo = 0; a.ph_hi = N_PHASES; hipLaunchKernelGGL(fwd_kernel, dim3(grid), dim3(NWAVES * 64), LDS_BYTES, stream, a); }
    else for (int li = 0; li < N_PHASES; ++li) { a.ph_lo = li; a.ph_hi = li + 1; hipLaunchKernelGGL(fwd_kernel, dim3(grid), dim3(NWAVES * 64), LDS_BYTES, stream, a); }
}
```

```cpp
#include <hip/hip_runtime.h>
#include <cstdio>
#include <cstdint>
namespace pg8 {
#define PG8_LAS __attribute__((address_space(3)))
typedef unsigned short bf16_t;
typedef short bf16x8 __attribute__((ext_vector_type(8)));
typedef float f32x4 __attribute__((ext_vector_type(4)));
typedef unsigned u32x4 __attribute__((ext_vector_type(4)));
constexpr int BM = 256, BK = 64, HALF = 128, HTB = HALF * BK * 2  , STAGE_BYTES = 8 * HTB, NXCD = 8, WGM = 8;

__host__ __device__ __forceinline__ int lds_byte(int r, int c) { const int st = (r >> 4) * 2 + (c >> 5), rr = r & 15, cc = c & 31, ob = rr * 64 + cc * 2; return st * 1024 + (ob ^ (((ob >> 9) & 1) << 5)); }
__host__ __device__ __forceinline__ void stage_rc(int b, int& R, int& C) { const int st = b / 1024, sb = b % 1024, swz = sb ^ (((sb >> 9) & 1) << 5); R = (st >> 1) * 16 + swz / 64; C = (st & 1) * 32 + (swz % 64) / 2; }
__host__ __device__ __forceinline__ int perm32(int rho) { const int n = rho >> 4, i = rho & 15; return 8 * (i >> 2) + 4 * n + (i & 3); }

struct Unit { int pm, pn; };
struct Gemm { const bf16_t* A; const bf16_t* Bt; int M, N, K; };

struct StaticOrder {
    int nM, nN, nwg, G, c;
    __host__ __device__ void init(int M, int N, int G_, int c_) { nM = M / BM; nN = N / BM; nwg = nM * nN; G = G_; c = c_; }
    __host__ __device__ bool next(int i, Unit& u) const {
        const long L = (long)i * G + c; if (L >= nwg) return false;
        int wgid = (int)L; { const int q = nwg / NXCD, r = nwg % NXCD, xcd = wgid % NXCD, off = wgid / NXCD; wgid = (xcd < r ? xcd * (q + 1) : r * (q + 1) + (xcd - r) * q) + off; }
        const int nig = WGM * nN, gid = wgid / nig, fm = gid * WGM, gsz = (nM - fm) < WGM ? (nM - fm) : WGM;
        u.pm = fm + ((wgid % nig) % gsz); u.pn = (wgid % nig) / gsz; return true;
    }
    __device__ __forceinline__ void a_ready(const Unit&) const {}
    __device__ __forceinline__ void done(const Unit&) const {}
};

__device__ __forceinline__ unsigned cvt_pk_bf16(float lo, float hi) { unsigned r; asm volatile("v_cvt_pk_bf16_f32 %0, %1, %2" : "=v"(r) : "v"(lo), "v"(hi)); return r; }
typedef float f32x2 __attribute__((ext_vector_type(2)));
__device__ __forceinline__ f32x2 gelu_pk(f32x2 v) {
    const f32x2 av = __builtin_elementwise_abs(v), d = av * 0.2316418882f + 1.0f;
    f32x2 t; t.x = __builtin_amdgcn_rcpf(d.x); t.y = __builtin_amdgcn_rcpf(d.y);
    f32x2 q = t * 0.5307027145f + (-0.7265760135f); q = q * t + 0.7107068705f; q = q * t + (-0.142248368f); q = q * t + 0.127414796f; q = q * t;
    const f32x2 s = (v * v) * (-0.72134752044f);
    f32x2 e; e.x = __builtin_amdgcn_exp2f(s.x); e.y = __builtin_amdgcn_exp2f(s.y);
    const f32x2 m = v * (q * e), r = v - m;
    f32x2 o; o.x = v.x < 0.f ? m.x : r.x; o.y = v.y < 0.f ? m.y : r.y; return o;
}

template <int ACT  > struct EpiBf16 {
    static constexpr bool PERM = true, AFTER_DRAIN = false; static_assert(ACT == 0 || ACT == 1, "EpiBf16: ACT is 0 (none) or 1 (gelu_pk)");
    bf16_t* O; int ldc; const float* bias; int split_cols; size_t split_stride; float scale0;
    __device__ __forceinline__ void operator()(const f32x4 (&acc)[2][2][4][2], const Unit& u, int wr, int wc, int fr, int fq) const {
        const int row0 = u.pm * BM + wr * 64 + fr; int colt = u.pn * BM; bf16_t* base = O;
        float sc = 1.f; if (split_cols) { const int t = colt / split_cols; base += (size_t)t * split_stride; colt -= t * split_cols; if (t == 0) sc = scale0; }
        const int col0 = colt + wc * 32 + 8 * fq, bcol0 = u.pn * BM + wc * 32 + 8 * fq;
        f32x4 bv[2][2];
#pragma unroll
        for (int bj = 0; bj < 2; ++bj)
#pragma unroll
            for (int n = 0; n < 2; ++n) bv[bj][n] = bias ? *(const f32x4*)(bias + bcol0 + bj * HALF + 4 * n) : (f32x4){0.f, 0.f, 0.f, 0.f};
#pragma unroll
        for (int ai = 0; ai < 2; ++ai)
#pragma unroll
            for (int m = 0; m < 4; ++m) { bf16_t* rowp = base + (size_t)(row0 + ai * HALF + m * 16) * ldc + col0;
#pragma unroll
                for (int bj = 0; bj < 2; ++bj) { f32x4 v0 = acc[ai][bj][m][0] + bv[bj][0], v1 = acc[ai][bj][m][1] + bv[bj][1];
                    if (ACT == 1) { f32x2 a = gelu_pk((f32x2){v0[0], v0[1]}), b = gelu_pk((f32x2){v0[2], v0[3]}), c = gelu_pk((f32x2){v1[0], v1[1]}), d = gelu_pk((f32x2){v1[2], v1[3]});
                        v0 = (f32x4){a.x, a.y, b.x, b.y}; v1 = (f32x4){c.x, c.y, d.x, d.y}; }
                    v0 = v0 * sc; v1 = v1 * sc; u32x4 w; w.x = cvt_pk_bf16(v0[0], v0[1]); w.y = cvt_pk_bf16(v0[2], v0[3]); w.z = cvt_pk_bf16(v1[0], v1[1]); w.w = cvt_pk_bf16(v1[2], v1[3]);
                    *(u32x4*)(rowp + bj * HALF) = w; } }
    }
};

struct PanelStats {
    unsigned* xbuf;
    unsigned* cnt;
    unsigned* tmo;
    int ntn; float eps;
    unsigned code;
    __device__ __forceinline__ bool run(const f32x4 (&v)[2][2][4][2], const Unit& u, int wr, int wc, int fr, int fq, PG8_LAS unsigned char* lds, int wid, int lane) const {
        typedef float f32x2v __attribute__((ext_vector_type(2)));
        PG8_LAS f32x2v* P = (PG8_LAS f32x2v*)lds;
        PG8_LAS f32x2v* S = (PG8_LAS f32x2v*)(lds + 8192);
        PG8_LAS unsigned* flag = (PG8_LAS unsigned*)(lds + 8192 + 2048);
#pragma unroll
        for (int ai = 0; ai < 2; ++ai)
#pragma unroll
            for (int m = 0; m < 4; ++m) {
                float s = 0.f;
#pragma unroll
                for (int bj = 0; bj < 2; ++bj)
#pragma unroll
                    for (int n = 0; n < 2; ++n) { const f32x4 x = v[ai][bj][m][n]; s += (x[0] + x[1]) + (x[2] + x[3]); }
                s += __shfl_xor(s, 16); s += __shfl_xor(s, 32);
                const float mw = s * (1.0f / 64.0f); float q = 0.f;
#pragma unroll
                for (int bj = 0; bj < 2; ++bj)
#pragma unroll
                    for (int n = 0; n < 2; ++n) { const f32x4 d = v[ai][bj][m][n] - mw; q += (d[0] * d[0] + d[1] * d[1]) + (d[2] * d[2] + d[3] * d[3]); }
                q += __shfl_xor(q, 16); q += __shfl_xor(q, 32);
                if (fq == 0) P[(ai * HALF + wr * 64 + m * 16 + fr) * 4 + wc] = (f32x2v){mw, q};
            }
        asm volatile("s_waitcnt lgkmcnt(0)" ::: "memory"); __builtin_amdgcn_s_barrier(); asm volatile("" ::: "memory");
#if defined(BROKEN_EXCHANGE_NO_WAIT)
#warning BROKEN CONTROL BUILD: the row-statistics exchange does not wait; results are wrong by design
        if (blockIdx.x >= 64) { const long long t0_ = clock64(); while (clock64() - t0_ < 60000) __builtin_amdgcn_s_sleep(8); }
#endif
        const int row = wid * 32 + (lane & 31);
        if (lane < 32) {
            const f32x2v a = P[row * 4 + 0], b = P[row * 4 + 1], c = P[row * 4 + 2], d = P[row * 4 + 3];
            const float mt = (a.x + b.x + c.x + d.x) * 0.25f;
            const float da = a.x - mt, db = b.x - mt, dc = c.x - mt, dd = d.x - mt;
            const float m2 = (a.y + b.y) + (c.y + d.y) + 64.0f * ((da * da + db * db) + (dc * dc + dd * dd));
            unsigned long long* slot = (unsigned long long*)xbuf + ((size_t)(u.pm * BM + row) * 4 + u.pn);
            __hip_atomic_store(slot, ((unsigned long long)__float_as_uint(m2) << 32) | __float_as_uint(mt), __ATOMIC_RELAXED, __HIP_MEMORY_SCOPE_AGENT);
        }
        asm volatile("s_waitcnt vmcnt(0)" ::: "memory");
        if (lane == 0) __hip_atomic_fetch_add(cnt + 64 * u.pm, 1u, __ATOMIC_RELAXED, __HIP_MEMORY_SCOPE_AGENT);
        if (wid == 0) {
            bool dead = false; const unsigned long long t0 = __builtin_amdgcn_s_memrealtime(); const unsigned want = 8u * (unsigned)ntn;
            for (;;) {
#if defined(BROKEN_EXCHANGE_NO_WAIT)
                break;
#endif
                if ((unsigned)__builtin_amdgcn_readfirstlane(__hip_atomic_load(cnt + 64 * u.pm, __ATOMIC_RELAXED, __HIP_MEMORY_SCOPE_AGENT)) >= want) break;
                if (__builtin_amdgcn_s_memrealtime() - t0 > 2000000ull) {
                    if (lane == 0) { unsigned expect = 0u; __hip_atomic_compare_exchange_strong(tmo + 1, &expect, code | (unsigned)(u.pm & 0xff), __ATOMIC_RELAXED, __ATOMIC_RELAXED, __HIP_MEMORY_SCOPE_AGENT);
                                     __hip_atomic_store(tmo, 1u, __ATOMIC_RELAXED, __HIP_MEMORY_SCOPE_AGENT); }
                    dead = true; break; }
                __builtin_amdgcn_s_sleep(2);
            }
            __builtin_amdgcn_fence(__ATOMIC_ACQUIRE, "agent");
            if (lane == 0) flag[0] = dead ? 1u : 0u;
        }
        asm volatile("s_waitcnt vmcnt(0) lgkmcnt(0)" ::: "memory"); __builtin_amdgcn_s_barrier(); asm volatile("" ::: "memory");
        const bool bad = flag[0] != 0u;
        if (lane < 32) {
            const unsigned long long* slot = (const unsigned long long*)xbuf + (size_t)(u.pm * BM + row) * 4; float mt[4], m2[4]; float ms = 0.f;
#pragma unroll
            for (int t = 0; t < 4; ++t) { if (t < ntn) { const unsigned long long w = __hip_atomic_load(slot + t, __ATOMIC_RELAXED, __HIP_MEMORY_SCOPE_AGENT); mt[t] = __uint_as_float((unsigned)w); m2[t] = __uint_as_float((unsigned)(w >> 32)); } else { mt[t] = 0.f; m2[t] = 0.f; } ms += mt[t]; }
            const float mean = ms / (float)ntn; float q = 0.f;
#pragma unroll
            for (int t = 0; t < 4; ++t) if (t < ntn) { const float dm = mt[t] - mean; q += m2[t] + 256.0f * dm * dm; }
            S[row] = (f32x2v){mean, 1.0f / sqrtf(q / (256.0f * (float)ntn) + eps)};
        }
        asm volatile("s_waitcnt lgkmcnt(0)" ::: "memory"); __builtin_amdgcn_s_barrier(); asm volatile("" ::: "memory");
        return bad;
    }
};
struct EpiLnRes {
    static constexpr bool PERM = false, AFTER_DRAIN = true;
    const float* base; float* out; int ldc; const float* bias; PanelStats st; unsigned poison;
    __device__ __forceinline__ void fused(f32x4 (&acc)[2][2][4][2], const Unit& u, int wr, int wc, int fr, int fq, PG8_LAS unsigned char* lds, int wid, int lane) const {
        typedef float f32x2v __attribute__((ext_vector_type(2)));
        const PG8_LAS f32x2v* S = (const PG8_LAS f32x2v*)(lds + 8192);
        const int col0 = u.pn * BM + wc * 32 + 4 * fq;
#pragma unroll
        for (int bj = 0; bj < 2; ++bj)
#pragma unroll
            for (int n = 0; n < 2; ++n) { const f32x4 bv = bias ? *(const f32x4*)(bias + col0 + bj * HALF + n * 16) : (f32x4){0.f, 0.f, 0.f, 0.f};
#pragma unroll
                for (int ai = 0; ai < 2; ++ai)
#pragma unroll
                    for (int m = 0; m < 4; ++m) acc[ai][bj][m][n] += bv; }
        f32x4 pre[4][2][2];
#pragma unroll
        for (int m = 0; m < 4; ++m) { const size_t off = (size_t)(u.pm * BM + wr * 64 + m * 16 + fr) * ldc + col0;
#pragma unroll
            for (int bj = 0; bj < 2; ++bj)
#pragma unroll
                for (int n = 0; n < 2; ++n) pre[m][bj][n] = *(const f32x4*)(base + off + bj * HALF + n * 16); }
        const bool bad = st.run(acc, u, wr, wc, fr, fq, lds, wid, lane) || poison != 0u;
        const float qnan = __builtin_nanf("");
#pragma unroll
        for (int ai = 0; ai < 2; ++ai)
#pragma unroll
            for (int m = 0; m < 4; ++m) { const int r = ai * HALF + wr * 64 + m * 16 + fr; const f32x2v sr = S[r]; const size_t off = (size_t)(u.pm * BM + r) * ldc + col0;
#pragma unroll
                for (int bj = 0; bj < 2; ++bj)
#pragma unroll
                    for (int n = 0; n < 2; ++n) { const f32x4 bs = ai == 0 ? pre[m][bj][n] : *(const f32x4*)(base + off + bj * HALF + n * 16); f32x4 o = bs + (acc[ai][bj][m][n] - sr.x) * sr.y;
                        if (bad) o = (f32x4){qnan, qnan, qnan, qnan}; *(f32x4*)(out + off + bj * HALF + n * 16) = o; }
                if (m & 1) asm volatile("" ::: "memory"); }
    }
};
struct EpiLnResLn {
    static constexpr bool PERM = false, AFTER_DRAIN = true;
    const float* base; float* out; bf16_t* xn; int ldc; const float* bias; PanelStats st1, st2; unsigned poison;
    __device__ __forceinline__ void fused(f32x4 (&acc)[2][2][4][2], const Unit& u, int wr, int wc, int fr, int fq, PG8_LAS unsigned char* lds, int wid, int lane) const {
        typedef float f32x2v __attribute__((ext_vector_type(2))); typedef unsigned u32x2v __attribute__((ext_vector_type(2)));
        const PG8_LAS f32x2v* S = (const PG8_LAS f32x2v*)(lds + 8192);
        const int col0 = u.pn * BM + wc * 32 + 4 * fq;
#pragma unroll
        for (int bj = 0; bj < 2; ++bj)
#pragma unroll
            for (int n = 0; n < 2; ++n) { const f32x4 bv = bias ? *(const f32x4*)(bias + col0 + bj * HALF + n * 16) : (f32x4){0.f, 0.f, 0.f, 0.f};
#pragma unroll
                for (int ai = 0; ai < 2; ++ai)
#pragma unroll
                    for (int m = 0; m < 4; ++m) acc[ai][bj][m][n] += bv; }
        bool bad = st1.run(acc, u, wr, wc, fr, fq, lds, wid, lane) || poison != 0u;
        const float qnan = __builtin_nanf("");
#pragma unroll
        for (int ai = 0; ai < 2; ++ai)
#pragma unroll
            for (int m = 0; m < 4; ++m) { const int r = ai * HALF + wr * 64 + m * 16 + fr; const f32x2v sr = S[r]; const size_t off = (size_t)(u.pm * BM + r) * ldc + col0;
#pragma unroll
                for (int bj = 0; bj < 2; ++bj)
#pragma unroll
                    for (int n = 0; n < 2; ++n) { const f32x4 bs = *(const f32x4*)(base + off + bj * HALF + n * 16); acc[ai][bj][m][n] = bs + (acc[ai][bj][m][n] - sr.x) * sr.y; }
                asm volatile("" : "+v"(acc[ai][0][m][0]), "+v"(acc[ai][0][m][1]), "+v"(acc[ai][1][m][0]), "+v"(acc[ai][1][m][1]));
                if (m & 1) asm volatile("" ::: "memory"); }
        const bool bad1 = bad;
        bad = st2.run(acc, u, wr, wc, fr, fq, lds, wid, lane) || bad;
#pragma unroll
        for (int ai = 0; ai < 2; ++ai)
#pragma unroll
            for (int m = 0; m < 4; ++m) { const int r = ai * HALF + wr * 64 + m * 16 + fr; const f32x2v sr = S[r]; const size_t off = (size_t)(u.pm * BM + r) * ldc + col0;
#pragma unroll
                for (int bj = 0; bj < 2; ++bj)
#pragma unroll
                    for (int n = 0; n < 2; ++n) { const f32x4 x1 = acc[ai][bj][m][n]; *(f32x4*)(out + off + bj * HALF + n * 16) = bad1 ? (f32x4){qnan, qnan, qnan, qnan} : x1;
                        const f32x4 o = (x1 - sr.x) * sr.y; u32x2v w; w.x = cvt_pk_bf16(o[0], o[1]); w.y = cvt_pk_bf16(o[2], o[3]);
                        if (bad) { w.x = 0x7fc07fc0u; w.y = 0x7fc07fc0u; } *(u32x2v*)(xn + off + bj * HALF + n * 16) = w; }
                asm volatile("" ::: "memory"); }
    }
};

template <class Epi, class Sched, bool ALIGN_EPI = false, bool SP2 = false>
__device__ __forceinline__ void gemm_phase(PG8_LAS unsigned char* lds, const Gemm g, const Sched& S, const Epi& E) {
    const int tid = threadIdx.x, wid = __builtin_amdgcn_readfirstlane(tid >> 6), lane = tid & 63, wr = wid >> 2, wc = wid & 3, fr = lane & 15, fq = lane >> 4;
    const int K = g.K, nt = K / BK;
    unsigned voffA[2], voffB[2];
#pragma unroll
    for (int i = 0; i < 2; ++i) { int R, C; stage_rc(tid * 16 + i * 8192, R, C); const int Rb = Epi::PERM ? ((R & ~31) + perm32(R & 31)) : R;
        voffA[i] = (unsigned)(R * K + C) * 2u; voffB[i] = (unsigned)(Rb * K + C) * 2u; }
    const size_t kstep = (size_t)(BK * 2);
    const size_t hstep = (size_t)HALF * K * 2;
    const size_t tstep = 2 * hstep;
    const unsigned ldsw = (unsigned)wid * 1024u;
    const int aoff = lds_byte(wr * 64 + fr, fq * 8), boff = lds_byte(wc * 32 + fr, fq * 8);
#define PG8_SA(b, h) (((b) * 2 + (h)) * HTB)
#define PG8_SB(b, h) ((4 + (b) * 2 + (h)) * HTB)
#define PG8_STAGE(bufoff, gbase, voff) do { _Pragma("unroll") for (int _i = 0; _i < 2; ++_i) \
        __builtin_amdgcn_global_load_lds((const unsigned*)((const char*)(gbase) + (voff)[_i]), (PG8_LAS unsigned*)(lds + (bufoff) + ldsw + _i * 8192), 16, 0, 0); } while (0)
#define PG8_LDA(dst, b, h) do { _Pragma("unroll") for (int m = 0; m < 4; ++m) _Pragma("unroll") for (int k = 0; k < 2; ++k) dst[m][k] = *(const PG8_LAS bf16x8*)(lds + PG8_SA(b, h) + aoff + m * 2048 + k * 1024); } while (0)
#define PG8_LDB(dst, b, h) do { _Pragma("unroll") for (int n = 0; n < 2; ++n) _Pragma("unroll") for (int k = 0; k < 2; ++k) dst[n][k] = *(const PG8_LAS bf16x8*)(lds + PG8_SB(b, h) + boff + n * 2048 + k * 1024); } while (0)
#define PG8_MMA(ai, bj, At, Bt) do { __builtin_amdgcn_s_setprio(1); _Pragma("unroll") for (int m = 0; m < 4; ++m) _Pragma("unroll") for (int n = 0; n < 2; ++n) _Pragma("unroll") for (int k = 0; k < 2; ++k) \
        acc[ai][bj][m][n] = __builtin_amdgcn_mfma_f32_16x16x32_bf16(Bt[n][k], At[m][k], acc[ai][bj][m][n], 0, 0, 0); __builtin_amdgcn_s_setprio(0); } while (0)
#define PG8_WAIT_V(n) asm volatile("s_waitcnt vmcnt(" #n ")" ::: "memory")
#define PG8_WAIT_L(n) asm volatile("s_waitcnt lgkmcnt(" #n ")" ::: "memory")
#define PG8_BAR __builtin_amdgcn_s_barrier()
#define PG8_SCHED __builtin_amdgcn_sched_barrier(0)
    Unit cur, nxt; int ui = 0;
    if (!S.next(0, cur)) return;
    f32x4 acc[2][2][4][2];
#pragma unroll
    for (int a = 0; a < 2; ++a)
#pragma unroll
        for (int b = 0; b < 2; ++b)
#pragma unroll
            for (int m = 0; m < 4; ++m)
#pragma unroll
                for (int n = 0; n < 2; ++n) acc[a][b][m][n] = (f32x4){0.f, 0.f, 0.f, 0.f};
    bf16x8 At[4][2], B0[2][2], B1[2][2];
    const char* cA = (const char*)g.A + (size_t)cur.pm * tstep; const char* cB = (const char*)g.Bt + (size_t)cur.pn * tstep;
    S.a_ready(cur);
    if constexpr (SP2) {
        PG8_STAGE(PG8_SB(0, 0), cB, voffB); PG8_STAGE(PG8_SB(0, 1), cB + hstep, voffB); PG8_STAGE(PG8_SA(0, 0), cA, voffA); PG8_STAGE(PG8_SA(0, 1), cA + hstep, voffA);
        if (wr == 1) PG8_BAR;
        PG8_WAIT_V(2); PG8_BAR;
        PG8_STAGE(PG8_SB(1, 0), cB + kstep, voffB); PG8_STAGE(PG8_SA(1, 0), cA + kstep, voffA); PG8_STAGE(PG8_SB(1, 1), cB + hstep + kstep, voffB);
        PG8_WAIT_V(6); PG8_BAR;
    } else {
        PG8_STAGE(PG8_SB(0, 0), cB, voffB); PG8_STAGE(PG8_SA(0, 0), cA, voffA); PG8_STAGE(PG8_SB(0, 1), cB + hstep, voffB); PG8_STAGE(PG8_SA(0, 1), cA + hstep, voffA);
        if (wr == 1) PG8_BAR;
        PG8_WAIT_V(4); PG8_BAR;
        PG8_STAGE(PG8_SB(1, 0), cB + kstep, voffB); PG8_STAGE(PG8_SA(1, 0), cA + kstep, voffA); PG8_STAGE(PG8_SB(1, 1), cB + hstep + kstep, voffB);
        PG8_WAIT_V(6); PG8_BAR;
    }
    for (;;) {
        const bool has_next = S.next(ui + 1, nxt);
        const char* nA = has_next ? (const char*)g.A + (size_t)nxt.pm * tstep : cA; const char* nB = has_next ? (const char*)g.Bt + (size_t)nxt.pn * tstep : cB;
        for (int t = 0; t < nt; t += 2) {
            const bool last = (t == nt - 2);
            const char* a1 = cA + (size_t)(t + 1) * kstep;
            const char* a2 = last ? nA : cA + (size_t)(t + 2) * kstep; const char* b2 = last ? nB : cB + (size_t)(t + 2) * kstep;
            const char* a3 = a2 + kstep; const char* b3 = b2 + kstep;
            if (last && has_next) S.a_ready(nxt);
            if constexpr (SP2) {
            PG8_LDB(B0, 0, 0); PG8_LDB(B1, 0, 1); PG8_SCHED; PG8_LDA(At, 0, 0); PG8_STAGE(PG8_SA(1, 1), a1 + hstep, voffA);
            PG8_WAIT_V(8); PG8_WAIT_L(0); PG8_BAR; PG8_MMA(0, 0, At, B0); PG8_MMA(0, 1, At, B1); PG8_BAR; PG8_SCHED;
            PG8_LDA(At, 0, 1); PG8_STAGE(PG8_SB(0, 0), b2, voffB); PG8_STAGE(PG8_SB(0, 1), b2 + hstep, voffB); PG8_STAGE(PG8_SA(0, 0), a2, voffA);
            PG8_WAIT_V(8); PG8_WAIT_L(0); PG8_BAR; PG8_MMA(1, 0, At, B0); PG8_MMA(1, 1, At, B1); PG8_BAR; PG8_SCHED;
            PG8_LDB(B0, 1, 0); PG8_LDB(B1, 1, 1); PG8_SCHED; PG8_LDA(At, 1, 0); PG8_STAGE(PG8_SA(0, 1), a2 + hstep, voffA);
            PG8_WAIT_V(8); PG8_WAIT_L(0); PG8_BAR; PG8_MMA(0, 0, At, B0); PG8_MMA(0, 1, At, B1); PG8_BAR; PG8_SCHED;
            PG8_LDA(At, 1, 1); PG8_STAGE(PG8_SB(1, 0), b3, voffB); PG8_STAGE(PG8_SB(1, 1), b3 + hstep, voffB); PG8_STAGE(PG8_SA(1, 0), a3, voffA);
            PG8_WAIT_V(8); PG8_WAIT_L(0); PG8_BAR; PG8_MMA(1, 0, At, B0); PG8_MMA(1, 1, At, B1); PG8_BAR; PG8_SCHED;
            } else {
            PG8_LDB(B0, 0, 0); PG8_SCHED; PG8_LDA(At, 0, 0); PG8_STAGE(PG8_SA(1, 1), a1 + hstep, voffA);
            PG8_WAIT_L(8); PG8_BAR; PG8_WAIT_L(0); PG8_MMA(0, 0, At, B0); PG8_BAR; PG8_SCHED;
            PG8_LDB(B1, 0, 1); PG8_STAGE(PG8_SB(0, 0), b2, voffB);
            PG8_BAR; PG8_WAIT_L(0); PG8_MMA(0, 1, At, B1); PG8_BAR;
            PG8_LDA(At, 0, 1); PG8_STAGE(PG8_SA(0, 0), a2, voffA);
            PG8_BAR; PG8_WAIT_L(0); PG8_MMA(1, 0, At, B0); PG8_BAR; PG8_SCHED;
            PG8_STAGE(PG8_SB(0, 1), b2 + hstep, voffB);
            PG8_WAIT_V(6); PG8_BAR; PG8_MMA(1, 1, At, B1); PG8_BAR;
            PG8_LDB(B0, 1, 0); PG8_SCHED; PG8_LDA(At, 1, 0); PG8_STAGE(PG8_SA(0, 1), a2 + hstep, voffA);
            PG8_WAIT_L(8); PG8_BAR; PG8_WAIT_L(0); PG8_MMA(0, 0, At, B0); PG8_BAR; PG8_SCHED;
            PG8_LDB(B1, 1, 1); PG8_STAGE(PG8_SB(1, 0), b3, voffB);
            PG8_BAR; PG8_WAIT_L(0); PG8_MMA(0, 1, At, B1); PG8_BAR;
            PG8_LDA(At, 1, 1); PG8_STAGE(PG8_SA(1, 0), a3, voffA);
            PG8_BAR; PG8_WAIT_L(0); PG8_MMA(1, 0, At, B0); PG8_BAR; PG8_SCHED;
            PG8_STAGE(PG8_SB(1, 1), b3 + hstep, voffB);
            PG8_WAIT_V(6); PG8_BAR; PG8_MMA(1, 1, At, B1); PG8_BAR;
            }
        }
        if constexpr (ALIGN_EPI) { if (wr == 0) PG8_BAR; }
        if constexpr (!Epi::AFTER_DRAIN) { E(acc, cur, wr, wc, fr, fq); S.done(cur); }
        if (!has_next) break;
#pragma unroll
        for (int a = 0; a < 2; ++a)
#pragma unroll
            for (int b = 0; b < 2; ++b)
#pragma unroll
                for (int m = 0; m < 4; ++m)
#pragma unroll
                    for (int n = 0; n < 2; ++n) acc[a][b][m][n] = (f32x4){0.f, 0.f, 0.f, 0.f};
        cur = nxt; cA = nA; cB = nB; ++ui;
        if constexpr (ALIGN_EPI) { if (wr == 1) PG8_BAR; }
    }
    PG8_WAIT_V(0);
    if constexpr (!ALIGN_EPI) { if (wr == 0) PG8_BAR; }
    PG8_BAR;
    if constexpr (Epi::AFTER_DRAIN) { E.fused(acc, cur, wr, wc, fr, fq, lds, wid, lane); S.done(cur); }
#undef PG8_SA
#undef PG8_SB
#undef PG8_STAGE
#undef PG8_LDA
#undef PG8_LDB
#undef PG8_MMA
#undef PG8_WAIT_V
#undef PG8_WAIT_L
#undef PG8_BAR
#undef PG8_SCHED
}
}
#define GAS __attribute__((address_space(1)))
#define LAS __attribute__((address_space(3)))
typedef unsigned short bf16;
typedef unsigned v4u __attribute__((ext_vector_type(4)));
typedef float f32x4 __attribute__((ext_vector_type(4)));
typedef short bf16x8 __attribute__((ext_vector_type(8)));
typedef GAS unsigned gu32;
typedef GAS unsigned long long gu64;
#define RLX_AGENT __ATOMIC_RELAXED, __HIP_MEMORY_SCOPE_AGENT
#define LDS_WAIT() asm volatile("s_waitcnt lgkmcnt(0)" ::: "memory")
#define VM_WAIT() asm volatile("s_waitcnt vmcnt(0)" ::: "memory")
__device__ __forceinline__ unsigned long long rt() { return __builtin_amdgcn_s_memrealtime(); }
__device__ __forceinline__ unsigned f2bf(float f) { unsigned u = __builtin_bit_cast(unsigned, f); return (u + 0x7fffu + ((u >> 16) & 1u)) >> 16; }
__device__ __forceinline__ unsigned pk2(float lo, float hi) { return f2bf(lo) | (f2bf(hi) << 16); }

#define XB_TMO      128
#define XB_XCNT(j)  (256  + 64 * (j))
#define XB_XSUB(j)  (1280 + 64 * (j))
#define XB_XGEN(j)  (2304 + 64 * (j))
#define XB_TOP      3328
#define XB_TOPGEN   3392
#define XCD_BAR_WORDS 3456
#define XB_SPIN_CAP (1u << 18)

__device__ __forceinline__ unsigned xb_ld(unsigned* p)              { return __hip_atomic_load(p, __ATOMIC_RELAXED, __HIP_MEMORY_SCOPE_AGENT); }
__device__ __forceinline__ unsigned xb_add(unsigned* p, unsigned v) { return __hip_atomic_fetch_add(p, v, __ATOMIC_RELAXED, __HIP_MEMORY_SCOPE_AGENT); }
__device__ __forceinline__ unsigned xb_xcc_id() { return (unsigned)__builtin_amdgcn_s_getreg((3 << 11) | 20) & 0xFu; }
#define XB_SPIN(cond, bar) do { unsigned _sp = 0; while (cond) { __builtin_amdgcn_s_sleep(1); \
    if ((++_sp & 255u) == 0u) { if (xb_ld(&(bar)[XB_TMO])) break; if (_sp > XB_SPIN_CAP) { atomicAdd(&(bar)[XB_TMO], 1u); break; } } } } while (0)

struct XcdBarrier {
    unsigned* bar; unsigned x;
    volatile LAS unsigned* st;
};

__device__ __forceinline__ XcdBarrier xcd_barrier_post(unsigned* bar, volatile LAS unsigned* st) {
    XcdBarrier b; b.bar = bar; b.x = xb_xcc_id(); b.st = st;
    if (threadIdx.x == 0) (void)xb_add(&bar[XB_XCNT(b.x)], 1u);
    return b;
}
__device__ __forceinline__ void xcd_barrier_complete(unsigned* bar, unsigned x, unsigned& nloc, unsigned& nx) {
    const unsigned G = gridDim.x * gridDim.y * gridDim.z;
    unsigned sum, cnt, mine, sp = 0u;
    for (;;) {
        sum = 0u; cnt = 0u; mine = 0u;
#pragma unroll
        for (unsigned j = 0; j < 16; ++j) { const unsigned c = xb_ld(&bar[XB_XCNT(j)]); sum += c; cnt += (c > 0u) ? 1u : 0u; mine = (j == x) ? c : mine; }
        if (sum == G) break;
        __builtin_amdgcn_s_sleep(1);
        if ((++sp & 255u) == 0u) { if (xb_ld(&bar[XB_TMO])) break; if (sp > XB_SPIN_CAP) { atomicAdd(&bar[XB_TMO], 1u); break; } }
    }
    nloc = mine > 0u ? mine : 1u; nx = cnt > 0u ? cnt : 1u;
}

__device__ __forceinline__ void xcd_barrier(const XcdBarrier& b) {
    asm volatile("s_waitcnt vmcnt(0)" ::: "memory");
    __syncthreads();
    if (threadIdx.x == 0) {
        unsigned* bar = b.bar;
        __builtin_amdgcn_s_waitcnt(0);
        unsigned nloc = b.st[0], nx = b.st[1];
        if (nloc == 0u) { xcd_barrier_complete(bar, b.x, nloc, nx); b.st[0] = nloc; b.st[1] = nx; }
        const unsigned old = xb_add(&bar[XB_XSUB(b.x)], 1u);
        const unsigned gen = old / nloc;
        if (old + 1u == (gen + 1u) * nloc) {
            __builtin_amdgcn_fence(__ATOMIC_RELEASE, "agent");
            asm volatile("s_waitcnt vmcnt(0)" ::: "memory");
            const unsigned og = xb_add(&bar[XB_TOP], 1u);
            const unsigned tg = og / nx;
            if (og + 1u == (tg + 1u) * nx) xb_add(&bar[XB_TOPGEN], 1u);
            else XB_SPIN(xb_ld(&bar[XB_TOPGEN]) == tg, bar);
            __builtin_amdgcn_fence(__ATOMIC_ACQUIRE, "agent");
            xb_add(&bar[XB_XGEN(b.x)], 1u);
            asm volatile("s_waitcnt vmcnt(0)" ::: "memory");
        } else {
            XB_SPIN(xb_ld(&bar[XB_XGEN(b.x)]) == gen, bar);
            __builtin_amdgcn_fence(__ATOMIC_ACQUIRE, "agent");
            asm volatile("s_waitcnt vmcnt(0)" ::: "memory");
        }
    }
    __syncthreads();
}
constexpr int NWAVES = 8;
#ifndef MK_N_LAUNCHES
#define MK_N_LAUNCHES 1
#endif
constexpr int N_PHASES = 8;
constexpr int N_LAUNCHES = MK_N_LAUNCHES;

constexpr int BATCH = 2, T = 8192, D = 1024, M = BATCH * T;
constexpr int NIN = 3200, LDP = 3328;
constexpr int SEG0 = 1024;
constexpr int C_R = 0, C_WLO = 512, C_K = 576, C_V = 1088, C_ALO = 1600, C_Z = 1664;
constexpr float NORM_EPS = 1e-6f, GN_EPS = 64e-5f;

constexpr size_t MiB = 1u << 20;
constexpr size_t WS_CTL = 0, CTL_ZERO_BYTES = 1 * MiB;
constexpr size_t WS_W1T = 1 * MiB, WS_W2T = 8 * MiB, WS_XN = 10 * MiB, WS_P = 42 * MiB, WS_MIX = 146 * MiB, WS_BONUS = 27 * MiB;
constexpr size_t WS_WUPT = 7 * MiB + 512 * 1024, WS_AUPT = WS_WUPT + 65536, WS_YI = 10 * MiB, WS_WC = 26 * MiB, WS_PT = 178 * MiB, WS_QM = 210 * MiB, WS_PRM = 7 * MiB + 768 * 1024;
constexpr size_t WS_END = 256 * MiB;
constexpr int CW_BAR = 4096;
constexpr size_t CTL_MOD = 65536, CTL_ROWSS = 131072;

constexpr int RING_BYTES = 131072, LDSCTL_OFF = 163328 - 64, MISC_OFF = LDSCTL_OFF + 320, LDS_BYTES = 163840;

struct Frame {
    LAS unsigned char* lds;
    volatile LAS unsigned* MISC;
    int tid, lane, wave, vcu, G;
    const float *x, *c, *w_ada, *b_ada, *norm_g, *w_in, *pool_w, *pool_scale, *mu, *w0, *w_up, *a0, *a_up, *k_k, *k_a, *r_k, *ln_w, *ln_b, *w_out, *final_g;
    float* out;
    float *mod, *rowss, *bonus;
    bf16 *W1t, *W2t, *XN, *P, *MIX, *WUPT, *AUPT, *YI, *PT, *QM;
    float *WC, *PRM;
};

__device__ __forceinline__ float bf2f(unsigned short u) { return __builtin_bit_cast(float, (unsigned)u << 16); }
__device__ __forceinline__ float bflo(unsigned u) { return __builtin_bit_cast(float, u << 16); }
__device__ __forceinline__ float bfhi(unsigned u) { return __builtin_bit_cast(float, u & 0xffff0000u); }
__device__ __forceinline__ float sigmoidf_(float v) { return __builtin_amdgcn_rcpf(1.f + __expf(-v)); }
__device__ __forceinline__ float siluf_(float v) { return v * __builtin_amdgcn_rcpf(1.f + __expf(-v)); }
__device__ __forceinline__ float wave_sum(float v) {
#pragma unroll
    for (int o = 1; o < 64; o <<= 1) v += __shfl_xor(v, o);
    return v;
}

__device__ __forceinline__ void p0_transpose_item(const float* W, int K, int N, bf16* WT, LAS float* scr, int item, int lane) {
    const int nblk = N / 32, kb = item / nblk, nb = item % nblk, k0 = 64 * kb, n0 = 32 * nb;
#pragma unroll 8
    for (int i = 0; i < 32; ++i) { const int kk = 2 * i + (lane >> 5); scr[kk * 33 + (lane & 31)] = W[(size_t)(k0 + kk) * N + n0 + (lane & 31)]; }
    LDS_WAIT(); asm volatile("" ::: "memory");
    const int c = lane & 7;
#pragma unroll
    for (int j = 0; j < 4; ++j) { const int n = (lane >> 3) + 8 * j; const LAS float* s = scr + (8 * c) * 33 + n;
        v4u o; o.x = pk2(s[0 * 33], s[1 * 33]); o.y = pk2(s[2 * 33], s[3 * 33]); o.z = pk2(s[4 * 33], s[5 * 33]); o.w = pk2(s[6 * 33], s[7 * 33]);
        *(v4u*)(WT + (size_t)(n0 + n) * K + k0 + 8 * c) = o; }
    LDS_WAIT(); asm volatile("" ::: "memory");
}

__device__ __forceinline__ void p0_prologue(Frame& F) {
    LAS float* scr = (LAS float*)(F.lds + F.wave * 16384);
    const int gw = F.vcu * NWAVES + F.wave, NGW = F.G * NWAVES;
    constexpr int I_1 = (D / 64) * (NIN / 32), I_2 = (D / 64) * (D / 32), I_Z = (LDP - NIN) * D * 2 / 1024, I_L = 16;
    for (int it = gw; it < I_1 + I_2 + I_Z + 2 * I_L; it += NGW) {
        int r = it;
        if (r < I_1) { p0_transpose_item(F.w_in, D, NIN, F.W1t, scr, r, F.lane); continue; } r -= I_1;
        if (r < I_2) { p0_transpose_item(F.w_out, D, D, F.W2t, scr, r, F.lane); continue; } r -= I_2;
        if (r < I_Z) { *(v4u*)((unsigned char*)(F.W1t + (size_t)NIN * D) + (size_t)r * 1024 + F.lane * 16) = (v4u){0u, 0u, 0u, 0u}; continue; } r -= I_Z;
        if (r < I_L) { p0_transpose_item(F.w_up, 64, 512, F.WUPT, scr, r, F.lane); continue; } r -= I_L;
        p0_transpose_item(F.a_up, 64, 512, F.AUPT, scr, r, F.lane);
    }
    { const int gt = blockIdx.x * (NWAVES * 64) + F.tid;
      if (gt < 512) { float* o = F.PRM + gt * 8; o[0] = F.w0[gt]; o[1] = F.a0[gt]; o[2] = F.k_k[gt]; o[3] = F.k_a[gt]; o[4] = F.r_k[gt]; o[5] = F.mu[C_R + gt]; o[6] = F.mu[C_K + gt]; o[7] = F.mu[C_V + gt]; }
      else if (gt < 576) F.PRM[4096 + gt - 512] = F.mu[C_WLO + gt - 512];
      else if (gt < 640) F.PRM[4096 + gt - 512] = F.mu[C_ALO + gt - 576]; }
    __syncthreads();
    LAS float* red = (LAS float*)F.lds;
    for (int u = blockIdx.x; u < 192; u += F.G) {
        const int cg = u % 48, ks = u / 48, n = cg * 64 + F.lane, k0 = ks * 256 + F.wave * 32;
        float s0 = 0.f, s1 = 0.f;
#pragma unroll 8
        for (int kk = 0; kk < 32; ++kk) { const float wv = F.w_ada[(size_t)(k0 + kk) * 3072 + n]; s0 += F.c[k0 + kk] * wv; s1 += F.c[D + k0 + kk] * wv; }
        red[F.wave * 128 + F.lane] = s0; red[F.wave * 128 + 64 + F.lane] = s1;
        __syncthreads();
        if (F.wave < 2) { float s = 0.f;
#pragma unroll
            for (int w = 0; w < 8; ++w) s += red[w * 128 + F.wave * 64 + F.lane];
            if (ks == 0) s += F.b_ada[n];
            __hip_atomic_fetch_add(F.mod + F.wave * 3072 + n, s, __ATOMIC_RELAXED, __HIP_MEMORY_SCOPE_AGENT); }
        __syncthreads();
    }
}

__device__ __forceinline__ void p1_hrows(Frame& F) {
    const int gw = F.vcu * NWAVES + F.wave, NGW = F.G * NWAVES;
    for (int m = gw; m < M; m += NGW) {
        const int b = m >> 13;
        const f32x4* xr = (const f32x4*)(F.x + (size_t)m * D) + F.lane;
        f32x4 v[4]; float s = 0.f;
#pragma unroll
        for (int j = 0; j < 4; ++j) { v[j] = xr[64 * j]; s += (v[j].x * v[j].x + v[j].y * v[j].y) + (v[j].z * v[j].z + v[j].w * v[j].w); }
        const float rstd = 1.f / sqrtf(wave_sum(s) * (1.f / D) + NORM_EPS);
        unsigned long long* o8 = (unsigned long long*)(F.XN + (size_t)m * D) + F.lane;
#pragma unroll
        for (int j = 0; j < 4; ++j) {
            const f32x4 g = ((const f32x4*)F.norm_g)[F.lane + 64 * j];
            const f32x4 sh = ((const f32x4*)(F.mod + b * 3072))[F.lane + 64 * j];
            const f32x4 sc = ((const f32x4*)(F.mod + b * 3072 + 1024))[F.lane + 64 * j];
            const f32x4 h = v[j] * rstd * g * (sc + 1.f) + sh;
            o8[64 * j] = (unsigned long long)pk2(h.x, h.y) | ((unsigned long long)pk2(h.z, h.w) << 32);
        }
    }
}

template <int GI> __device__ __forceinline__ void pool_item(Frame& F, int tb, LAS float* scr) {
    constexpr int WIN = 2 << GI;
    const int t0 = tb * 8, pos0 = t0 & (T - 1), lane = F.lane;
    float u0[23], u1[23];
#pragma unroll
    for (int q = 0; q < 23; ++q) { const int pos = pos0 - 15 + q; unsigned w = 0u;
        if (q >= 16 - WIN) { if (pos >= 0) w = *(const unsigned*)(F.P + (size_t)(t0 - 15 + q) * LDP + GI * 128 + 2 * lane); }
        u0[q] = bflo(w); u1[q] = bfhi(w); }
#pragma unroll
    for (int tt = 0; tt < 8; ++tt) { float s0 = 0.f, s1 = 0.f;
#pragma unroll
        for (int q = 0; q < WIN; ++q) { s0 += u0[tt + 15 - q]; s1 += u1[tt + 15 - q]; }
        const int pos = pos0 + tt; const float cnt = (float)((pos + 1 < WIN) ? (pos + 1) : WIN);
        scr[(2 * lane) * 8 + tt] = s0 / cnt - u0[tt + 15]; scr[(2 * lane + 1) * 8 + tt] = s1 / cnt - u1[tt + 15]; }
    LDS_WAIT(); asm volatile("" ::: "memory");
    float acc0[8], acc1[8];
#pragma unroll
    for (int tt = 0; tt < 8; ++tt) { acc0[tt] = 0.f; acc1[tt] = 0.f; }
    const float* pw = F.pool_w + (size_t)GI * 128 * 128 + 2 * lane;
#pragma unroll 4
    for (int c = 0; c < 128; ++c) {
        const f32x4 da = *(const LAS f32x4*)(scr + c * 8), db = *(const LAS f32x4*)(scr + c * 8 + 4);
        const float w0 = pw[c * 128], w1 = pw[c * 128 + 1];
        acc0[0] += da.x * w0; acc1[0] += da.x * w1; acc0[1] += da.y * w0; acc1[1] += da.y * w1; acc0[2] += da.z * w0; acc1[2] += da.z * w1; acc0[3] += da.w * w0; acc1[3] += da.w * w1;
        acc0[4] += db.x * w0; acc1[4] += db.x * w1; acc0[5] += db.y * w0; acc1[5] += db.y * w1; acc0[6] += db.z * w0; acc1[6] += db.z * w1; acc0[7] += db.w * w0; acc1[7] += db.w * w1;
    }
    const float ps0 = F.pool_scale[GI * 128 + 2 * lane], ps1 = F.pool_scale[GI * 128 + 2 * lane + 1];
#pragma unroll
    for (int tt = 0; tt < 8; ++tt) {
        const unsigned zw = *(const unsigned*)(F.P + (size_t)(t0 + tt) * LDP + 512 + GI * 128 + 2 * lane);
        const float y0 = acc0[tt] * ps0 * siluf_(bflo(zw)), y1 = acc1[tt] * ps1 * siluf_(bfhi(zw));
        *(unsigned*)(F.MIX + (size_t)(t0 + tt) * D + GI * 128 + 2 * lane) = pk2(y0, y1);
    }
    LDS_WAIT(); asm volatile("" ::: "memory");
}

typedef float f32x16 __attribute__((ext_vector_type(16)));
typedef float f32x8 __attribute__((ext_vector_type(8)));
typedef __bf16 bf16x8v __attribute__((ext_vector_type(8)));
typedef __bf16 bf16x4v __attribute__((ext_vector_type(4)));
typedef unsigned u32x2 __attribute__((ext_vector_type(2)));
#define MFMA32(a, b, c) __builtin_amdgcn_mfma_f32_32x32x16_bf16((a), (b), (c), 0, 0, 0)
#define MFMA16(a, b, c) __builtin_amdgcn_mfma_f32_16x16x32_bf16((a), (b), (c), 0, 0, 0)

__device__ __forceinline__ bf16x8 cvt8(f32x8 v) { return __builtin_bit_cast(bf16x8, __builtin_convertvector(v, bf16x8v)); }
__device__ __forceinline__ u32x2 cvt4(f32x4 v) { return __builtin_bit_cast(u32x2, __builtin_convertvector(v, bf16x4v)); }
__device__ __forceinline__ bf16x8 pack_lo(const f32x16& x) { return cvt8(__builtin_shufflevector(x, x, 0, 1, 2, 3, 4, 5, 6, 7)); }
__device__ __forceinline__ bf16x8 pack_hi(const f32x16& x) { return cvt8(__builtin_shufflevector(x, x, 8, 9, 10, 11, 12, 13, 14, 15)); }
__device__ __forceinline__ f32x8 unpack8(bf16x8 p) { const v4u w = __builtin_bit_cast(v4u, p); return (f32x8){bflo(w.x), bfhi(w.x), bflo(w.y), bfhi(w.y), bflo(w.z), bfhi(w.z), bflo(w.w), bfhi(w.w)}; }
__device__ __forceinline__ f32x16 unpack16(bf16x8 lo, bf16x8 hi) { const f32x8 a = unpack8(lo), b = unpack8(hi); return __builtin_shufflevector(a, b, 0, 1, 2, 3, 4, 5, 6, 7, 8, 9, 10, 11, 12, 13, 14, 15); }
__device__ __forceinline__ f32x4 unpack4(u32x2 w) { return (f32x4){bflo(w.x), bfhi(w.x), bflo(w.y), bfhi(w.y)}; }
__device__ __forceinline__ float tanh_fast(float x) { return 1.f - 2.f * __builtin_amdgcn_rcpf(1.f + __expf(2.f * x)); }
#define CROW(reg, h) (((reg) & 3) + 8 * ((reg) >> 2) + 4 * (h))
__device__ __forceinline__ f32x16 zero16() { f32x16 z;
#pragma unroll
    for (int i = 0; i < 16; ++i) z[i] = 0.f; return z; }

struct PK2 { bf16x8 s[2]; };
__device__ __forceinline__ PK2 pack2(const f32x16& x) { PK2 p; p.s[0] = pack_lo(x); p.s[1] = pack_hi(x); return p; }

typedef __amdgpu_buffer_rsrc_t rsrc_t;
__device__ __forceinline__ rsrc_t mkrsrc(const void* p) { return __builtin_amdgcn_make_buffer_rsrc((void*)p, 0, 0x7fffffff, 0x00020000); }
#define BLD128(rs, voff, soff) __builtin_bit_cast(v4u, __builtin_amdgcn_raw_buffer_load_b128((rs), (voff), (soff), 0))
#define BLD64(rs, voff, soff) __builtin_bit_cast(u32x2, __builtin_amdgcn_raw_buffer_load_b64((rs), (voff), (soff), 0))
#define BLDF(rs, voff, soff) __builtin_bit_cast(float, __builtin_amdgcn_raw_buffer_load_b32((rs), (voff), (soff), 0))
#define BST64(v, rs, voff, soff) __builtin_amdgcn_raw_buffer_store_b64((v), (rs), (voff), (soff), 0)
#define BST32F(v, rs, voff, soff) __builtin_amdgcn_raw_buffer_store_b32(__builtin_bit_cast(unsigned, (float)(v)), (rs), (voff), (soff), 0)
#define BST16(v, rs, voff, soff) __builtin_amdgcn_raw_buffer_store_b16((unsigned short)(v), (rs), (voff), (soff), 0)

__device__ __forceinline__ void pass1_item(Frame& F, int it, LAS unsigned char* lds, LAS float* wct) {
    const int head = it & 7, cc = (it >> 3) & 255, b = it >> 11;
    int lane = F.lane, c, h;
#define REFRESH do { asm volatile("" : "+v"(lane)); c = lane & 31; h = lane >> 5; } while (0)
    REFRESH;
    const int row0 = b * T + 32 * cc, pos0 = 32 * cc;
    const rsrc_t rsP = mkrsrc(F.P + SEG0 + (size_t)(row0 - 1) * LDP);
    const rsrc_t rsW = mkrsrc(F.WUPT + (size_t)head * 64 * 64);
    const rsrc_t rsR = mkrsrc(F.PRM + (size_t)head * 64 * 8);
    const rsrc_t rsM = mkrsrc(F.PRM + 512 * 8);
    {
        const unsigned voff = (unsigned)((lane >> 3) * (LDP * 2) + (lane & 7) * 16);
        const bool z0 = (pos0 == 0) && ((lane >> 3) == 0);
        v4u w[3][5];
#pragma unroll
        for (int a = 0; a < 3; ++a)
#pragma unroll
            for (int j = 0; j < 5; ++j) w[a][j] = BLD128(rsP, voff, (head * 64 + (a == 0 ? C_R : (a == 1 ? C_K : C_V))) * 2 + j * 8 * (LDP * 2));
#pragma unroll
        for (int a = 0; a < 3; ++a) { if (z0) w[a][0] = (v4u){0u, 0u, 0u, 0u};
#pragma unroll
            for (int j = 0; j < 5; ++j) if (j < 4 || (lane >> 3) == 0) *(LAS v4u*)(lds + (a * 33 + j * 8 + (lane >> 3)) * 128 + (lane & 7) * 16) = w[a][j]; }
    }
    REFRESH;
    bf16x8 Aw[4], Aa[4];
    {
        const unsigned voff = (unsigned)(c * (LDP * 2) + h * 16);
        const bool zp = (pos0 + c) == 0;
#pragma unroll
        for (int ks = 0; ks < 4; ++ks) {
            const f32x8 cw = unpack8(__builtin_bit_cast(bf16x8, BLD128(rsP, voff, LDP * 2 + (C_WLO + 16 * ks) * 2))), ca = unpack8(__builtin_bit_cast(bf16x8, BLD128(rsP, voff, LDP * 2 + (C_ALO + 16 * ks) * 2)));
            f32x8 pw = unpack8(__builtin_bit_cast(bf16x8, BLD128(rsP, voff, (C_WLO + 16 * ks) * 2))), pa = unpack8(__builtin_bit_cast(bf16x8, BLD128(rsP, voff, (C_ALO + 16 * ks) * 2)));
            if (zp) { pw = pw * 0.f; pa = pa * 0.f; }
            const f32x4 mw0 = __builtin_bit_cast(f32x4, BLD128(rsM, (unsigned)(h * 32), ks * 64)), mw1 = __builtin_bit_cast(f32x4, BLD128(rsM, (unsigned)(h * 32), ks * 64 + 16));
            const f32x4 ma0 = __builtin_bit_cast(f32x4, BLD128(rsM, (unsigned)(h * 32), 256 + ks * 64)), ma1 = __builtin_bit_cast(f32x4, BLD128(rsM, (unsigned)(h * 32), 256 + ks * 64 + 16));
            const f32x8 muw = __builtin_shufflevector(mw0, mw1, 0, 1, 2, 3, 4, 5, 6, 7), mua = __builtin_shufflevector(ma0, ma1, 0, 1, 2, 3, 4, 5, 6, 7);
            f32x8 xw = cw + (pw - cw) * muw; const f32x8 xa = ca + (pa - ca) * mua;
#pragma unroll
            for (int j = 0; j < 8; ++j) xw[j] = tanh_fast(xw[j]);
            Aw[ks] = cvt8(xw); Aa[ks] = cvt8(xa);
        }
    }
    LDS_WAIT(); asm volatile("" ::: "memory");
    unsigned rbase = (unsigned)(size_t)lds + (unsigned)(c * 2);
#define TIE(dep) asm volatile("" : "+v"(rbase) : "v"(dep))
#define RAW(a, rowi, ch) bf2f(*(const LAS unsigned short*)(size_t)(rbase + (unsigned)(((a) * 33 + (rowi)) * 128 + ((ch) - c) * 2)))
    REFRESH;
    TIE(Aw[3][0]);
    float ss[16];
#pragma unroll
    for (int reg = 0; reg < 16; ++reg) ss[reg] = 0.f;
#pragma unroll
    for (int nb = 0; nb < 2; ++nb) {
        const int ch = 32 * nb + c;
        const f32x4 pa_ = __builtin_bit_cast(f32x4, BLD128(rsR, (unsigned)(c * 32), nb * 1024)), pb_ = __builtin_bit_cast(f32x4, BLD128(rsR, (unsigned)(c * 32), nb * 1024 + 16));
#pragma unroll
        for (int rho = 0; rho < 4; ++rho) {
            const int tb = 8 * rho + 4 * h;
            float prk = RAW(1, tb, ch);
#pragma unroll
            for (int b_ = 0; b_ < 4; ++b_) {
                const float ck = RAW(1, tb + b_ + 1, ch);
                const float kkr = (ck + (prk - ck) * pb_.z) * pa_.z; prk = ck;
                ss[4 * rho + b_] += kkr * kkr;
            }
        }
    }
#pragma unroll
    for (int reg = 0; reg < 16; ++reg) {
        float s = ss[reg];
#pragma unroll
        for (int o = 1; o < 32; o <<= 1) s += __shfl_xor(s, o);
        ss[reg] = __builtin_amdgcn_rsqf(fmaxf(s, 1e-24f));
    }
    if (c == 0) {
#pragma unroll
        for (int reg = 0; reg < 16; ++reg) *(LAS float*)(lds + 17152 + CROW(reg, h) * 4) = ss[reg];
    }
    LDS_WAIT(); asm volatile("" ::: "memory");
    REFRESH;
    PK2 at_pk[2], bt_pk[2], kt_pk[2], v_pk[2];
    float wcl[2], bon[2];
    bon[0] = 0.f; bon[1] = 0.f;
    const rsrc_t rsC = mkrsrc(F.WC + (size_t)it * 64);
#pragma unroll
    for (int nb = 0; nb < 2; ++nb) {
        REFRESH;
        const int ch = 32 * nb + c;
        rbase = (unsigned)(size_t)lds + (unsigned)(c * 2);
        unsigned wvo = (unsigned)(c * 128 + h * 16); asm volatile("" : "+v"(wvo) : "v"(rbase));
        f32x16 accw = zero16(), acca = zero16();
#pragma unroll
        for (int ks = 0; ks < 4; ++ks) {
            const bf16x8 Bw = __builtin_bit_cast(bf16x8, BLD128(rsW, wvo, nb * 4096 + ks * 32)), Ba = __builtin_bit_cast(bf16x8, BLD128(rsW, wvo, 65536 + nb * 4096 + ks * 32));
            accw = MFMA32(Aw[ks], Bw, accw); acca = MFMA32(Aa[ks], Ba, acca);
        }
        const f32x4 pa_ = __builtin_bit_cast(f32x4, BLD128(rsR, (unsigned)(c * 32), nb * 1024)), pb_ = __builtin_bit_cast(f32x4, BLD128(rsR, (unsigned)(c * 32), nb * 1024 + 16));
        const float p_w0 = pa_.x, p_a0 = pa_.y, p_kk = pa_.z, p_ka = pa_.w, p_rk = pb_.x, m_r = pb_.y, m_k = pb_.z, m_v = pb_.w;
        float ldv[16], av[16];
#pragma unroll
        for (int reg = 0; reg < 16; ++reg) { ldv[reg] = -0.60653066f * sigmoidf_(p_w0 + accw[reg]); av[reg] = sigmoidf_(p_a0 + acca[reg]); }
        float Gt[4], Gp[4];
#pragma unroll
        for (int rho = 0; rho < 4; ++rho) { Gt[rho] = (ldv[4 * rho] + ldv[4 * rho + 1]) + (ldv[4 * rho + 2] + ldv[4 * rho + 3]); Gp[rho] = __shfl_xor(Gt[rho], 32); }
        const float tot = ((Gt[0] + Gp[0]) + (Gt[1] + Gp[1])) + ((Gt[2] + Gp[2]) + (Gt[3] + Gp[3]));
        const float wc = __expf(tot); wcl[nb] = wc;
        if (h == 0) BST32F(wc, rsC, (unsigned)(c * 4), nb * 128);
        float off = 0.f;
#pragma unroll
        for (int sh = 0; sh < 2; ++sh) {
            float lw0[2];
#pragma unroll
            for (int r2 = 0; r2 < 2; ++r2) { const int rho = 2 * sh + r2; lw0[r2] = off + (h ? Gp[rho] : 0.f); off += Gt[rho] + Gp[rho]; }
            {
                TIE(lw0[1]);
                float at[8], bt[8];
#pragma unroll
                for (int r2 = 0; r2 < 2; ++r2) {
                    const int rho = 2 * sh + r2, tb = 8 * rho + 4 * h;
                    float prk = RAW(1, tb, ch), lw = lw0[r2], epm = __expf(lw);
                    const f32x4 iv4 = *(const LAS f32x4*)(size_t)(rbase - (unsigned)(c * 2) + 17152u + (unsigned)(tb * 4));
                    const float ivs[4] = {iv4.x, iv4.y, iv4.z, iv4.w};
#pragma unroll
                    for (int b_ = 0; b_ < 4; ++b_) {
                        const int reg = 4 * rho + b_, e8 = 4 * r2 + b_;
                        const float ck = RAW(1, tb + b_ + 1, ch);
                        const float k = ck + (prk - ck) * m_k; prk = ck;
                        lw += ldv[reg];
                        const float ep = __expf(lw), em = __builtin_amdgcn_rcpf(ep);
                        const float kk = k * p_kk * ivs[b_];
                        at[e8] = -kk * epm; bt[e8] = kk * av[reg] * em; epm = ep;
                    }
                }
#define V8(x) ((f32x8){x[0], x[1], x[2], x[3], x[4], x[5], x[6], x[7]})
                at_pk[nb].s[sh] = cvt8(V8(at)); bt_pk[nb].s[sh] = cvt8(V8(bt));
                asm volatile("" : "+v"(at_pk[nb].s[sh]), "+v"(bt_pk[nb].s[sh]));
            }
            {
                TIE(bt_pk[nb].s[sh][7]);
                float kt[8], vv[8], bp[8];
#pragma unroll
                for (int r2 = 0; r2 < 2; ++r2) {
                    const int rho = 2 * sh + r2, tb = 8 * rho + 4 * h;
                    float prr = RAW(0, tb, ch), prk = RAW(1, tb, ch), prv = RAW(2, tb, ch), lw = lw0[r2];
#pragma unroll
                    for (int b_ = 0; b_ < 4; ++b_) {
                        const int reg = 4 * rho + b_, e8 = 4 * r2 + b_;
                        const float cr = RAW(0, tb + b_ + 1, ch), ck = RAW(1, tb + b_ + 1, ch), cv = RAW(2, tb + b_ + 1, ch);
                        const float r = cr + (prr - cr) * m_r, k = ck + (prk - ck) * m_k, v = cv + (prv - cv) * m_v; prr = cr; prk = ck; prv = cv;
                        lw += ldv[reg];
                        const float ep = __expf(lw), em = __builtin_amdgcn_rcpf(ep);
                        const float km = k * (1.f + (av[reg] - 1.f) * p_ka);
                        bp[e8] = r * km * p_rk; kt[e8] = km * em; vv[e8] = v;
                        *(LAS unsigned short*)(lds + 12800 + (tb + b_) * 128 + ch * 2) = (unsigned short)f2bf(r * ep);
                    }
                }
                kt_pk[nb].s[sh] = cvt8(V8(kt)); v_pk[nb].s[sh] = cvt8(V8(vv));
                asm volatile("" : "+v"(kt_pk[nb].s[sh]), "+v"(v_pk[nb].s[sh]));
#undef V8
                float keep = 0.f;
#pragma unroll
                for (int e8 = 0; e8 < 8; ++e8) { float q = bp[e8];
#pragma unroll
                    for (int o = 1; o < 32; o <<= 1) q += __shfl_xor(q, o);
                    keep = (c == e8) ? q : keep; }
                bon[sh] += keep;
                TIE(keep);
            }
        }
    }
#undef RAW
#undef TIE
    REFRESH;
    if (c < 8) {
        const rsrc_t rsB = mkrsrc(F.bonus + (size_t)row0 * 8 + head);
        const unsigned vo = (unsigned)(((c & 3) + 8 * (c >> 2) + 4 * h) * 32);
        BST32F(bon[0], rsB, vo, 0); BST32F(bon[1], rsB, vo, 16 * 32);
    }
    LDS_WAIT(); asm volatile("" ::: "memory");
    REFRESH;
#pragma unroll
    for (int nb = 0; nb < 2; ++nb) {
#pragma unroll
        for (int reg = 0; reg < 16; ++reg) {
            const int o = CROW(reg, h) * 128 + (32 * nb + c) * 2;
            *(LAS unsigned short*)(lds + 0 * 4096 + o) = (unsigned short)at_pk[nb].s[reg >> 3][reg & 7];
            *(LAS unsigned short*)(lds + 1 * 4096 + o) = (unsigned short)bt_pk[nb].s[reg >> 3][reg & 7];
            *(LAS unsigned short*)(lds + 2 * 4096 + o) = (unsigned short)kt_pk[nb].s[reg >> 3][reg & 7];
        }
        if (h == 0) wct[32 * nb + c] = wcl[nb];
    }
    LDS_WAIT(); asm volatile("" ::: "memory");
    REFRESH;
#define FRAG(tile, ks) (*(const LAS bf16x8*)(lds + ((tile) < 3 ? (tile) * 4096 : 12800) + c * 128 + (16 * (ks) + 8 * h) * 2))
    f32x16 N = zero16(), Lm = zero16(), AakT = zero16(), ArbT = zero16(), ArkT = zero16();
#pragma unroll
    for (int ks = 0; ks < 4; ++ks) {
        const bf16x8 fa = FRAG(0, ks), fb = FRAG(1, ks), fk = FRAG(2, ks), fr = FRAG(3, ks);
        N = MFMA32(fb, fa, N); Lm = MFMA32(fa, fb, Lm); AakT = MFMA32(fk, fa, AakT); ArbT = MFMA32(fb, fr, ArbT); ArkT = MFMA32(fk, fr, ArkT);
    }
#undef FRAG
#pragma unroll
    for (int reg = 0; reg < 16; ++reg) { const int rw = CROW(reg, h);
        N[reg] = (rw < c) ? N[reg] : 0.f; Lm[reg] = (c < rw) ? Lm[reg] : 0.f; AakT[reg] = (rw < c) ? AakT[reg] : 0.f;
        ArbT[reg] = (rw <= c) ? ArbT[reg] : 0.f; ArkT[reg] = (rw <= c) ? ArkT[reg] : 0.f; }
    const PK2 AakT_pk = pack2(AakT), ArbT_pk = pack2(ArbT), ArkT_pk = pack2(ArkT);
    REFRESH;
    PK2 Xpk;
    {
        f32x16 X = N, Pw = N, PwT = Lm;
#pragma unroll
        for (int lvl = 0; lvl < 5; ++lvl) {
            const PK2 pa = pack2(PwT), pb = pack2(X);
            X = MFMA32(pa.s[0], pb.s[0], X); X = MFMA32(pa.s[1], pb.s[1], X);
            if (lvl < 4) { const PK2 pw = pack2(Pw);
                f32x16 n1 = zero16(), n2 = zero16();
                n1 = MFMA32(pa.s[0], pw.s[0], n1); n1 = MFMA32(pa.s[1], pw.s[1], n1);
                n2 = MFMA32(pw.s[0], pa.s[0], n2); n2 = MFMA32(pw.s[1], pa.s[1], n2);
                Pw = n1; PwT = n2; }
        }
        Xpk = pack2(X);
    }
    REFRESH;
    PK2 U_pk[2], Ab_pk[2];
#pragma unroll
    for (int ib = 0; ib < 2; ++ib) {
        f32x16 xm = zero16();
        xm = MFMA32(AakT_pk.s[0], v_pk[ib].s[0], xm); xm = MFMA32(AakT_pk.s[1], v_pk[ib].s[1], xm);
        const PK2 xp = pack2(xm);
        xm = MFMA32(Xpk.s[0], xp.s[0], xm); xm = MFMA32(Xpk.s[1], xp.s[1], xm);
        U_pk[ib] = pack2(xm);
    }
#pragma unroll
    for (int jb = 0; jb < 2; ++jb) {
        f32x16 ab = unpack16(at_pk[jb].s[0], at_pk[jb].s[1]);
        ab = MFMA32(Xpk.s[0], at_pk[jb].s[0], ab); ab = MFMA32(Xpk.s[1], at_pk[jb].s[1], ab);
        Ab_pk[jb] = pack2(ab);
    }
    REFRESH;
    const rsrc_t rsX = mkrsrc(F.MIX + (size_t)row0 * D + 512 + head * 64);
    const rsrc_t rsY = mkrsrc(F.YI + (size_t)it * 2048);
    const rsrc_t rsT = mkrsrc(F.PT + (size_t)it * 4096);
    const rsrc_t rsQ = mkrsrc(F.QM + (size_t)it * 4096);
#pragma unroll
    for (int jb = 0; jb < 2; ++jb) {
        f32x16 rh;
#pragma unroll
        for (int reg = 0; reg < 16; ++reg) rh[reg] = bf2f(*(const LAS unsigned short*)(lds + 12800 + CROW(reg, h) * 128 + (32 * jb + c) * 2));
        rh = MFMA32(ArbT_pk.s[0], Ab_pk[jb].s[0], rh); rh = MFMA32(ArbT_pk.s[1], Ab_pk[jb].s[1], rh);
        const PK2 rp = pack2(rh);
#pragma unroll
        for (int reg = 0; reg < 16; ++reg) BST16(rp.s[reg >> 3][reg & 7], rsX, (unsigned)(h * (4 * D * 2) + c * 2), CROW(reg, 0) * (D * 2) + jb * 64);
    }
#pragma unroll
    for (int ib = 0; ib < 2; ++ib) {
        f32x16 y = zero16();
        y = MFMA32(U_pk[ib].s[0], ArbT_pk.s[0], y); y = MFMA32(U_pk[ib].s[1], ArbT_pk.s[1], y);
        y = MFMA32(v_pk[ib].s[0], ArkT_pk.s[0], y); y = MFMA32(v_pk[ib].s[1], ArkT_pk.s[1], y);
        const PK2 yp = pack2(y);
        const v4u w0 = __builtin_bit_cast(v4u, yp.s[0]), w1 = __builtin_bit_cast(v4u, yp.s[1]);
        const unsigned vo = (unsigned)(c * 128 + h * 8);
        BST64(((u32x2){w0.x, w0.y}), rsY, vo, ib * 64); BST64(((u32x2){w0.z, w0.w}), rsY, vo, ib * 64 + 16); BST64(((u32x2){w1.x, w1.y}), rsY, vo, ib * 64 + 32); BST64(((u32x2){w1.z, w1.w}), rsY, vo, ib * 64 + 48);
    }
    REFRESH;
#pragma unroll
    for (int jb = 0; jb < 2; ++jb)
#pragma unroll
        for (int jb2 = 0; jb2 < 2; ++jb2) {
            f32x16 pm = zero16();
            pm = MFMA32(Ab_pk[jb].s[0], bt_pk[jb2].s[0], pm); pm = MFMA32(Ab_pk[jb].s[1], bt_pk[jb2].s[1], pm);
            const PK2 pp = pack2(pm * wcl[jb2]);
            const v4u w0 = __builtin_bit_cast(v4u, pp.s[0]), w1 = __builtin_bit_cast(v4u, pp.s[1]);
            const unsigned vo = (unsigned)(h * 1024 + c * 16); const int so = jb * 4096 + jb2 * 512;
            BST64(((u32x2){w0.x, w0.y}), rsT, vo, so);
            BST64(((u32x2){w0.z, w0.w}), rsT, vo, so + 2048);
            BST64(((u32x2){w1.x, w1.y}), rsT, vo, so + 8);
            BST64(((u32x2){w1.z, w1.w}), rsT, vo, so + 2048 + 8);
        }
#pragma unroll
    for (int jb2 = 0; jb2 < 2; ++jb2)
#pragma unroll
        for (int ib = 0; ib < 2; ++ib) {
            f32x16 q = zero16();
            q = MFMA32(bt_pk[jb2].s[0], U_pk[ib].s[0], q); q = MFMA32(bt_pk[jb2].s[1], U_pk[ib].s[1], q);
            q = MFMA32(kt_pk[jb2].s[0], v_pk[ib].s[0], q); q = MFMA32(kt_pk[jb2].s[1], v_pk[ib].s[1], q);
#pragma unroll
            for (int rho = 0; rho < 4; ++rho) { const f32x4 w4 = *(const LAS f32x4*)(wct + 32 * jb2 + 8 * rho + 4 * h); q[4 * rho] *= w4.x; q[4 * rho + 1] *= w4.y; q[4 * rho + 2] *= w4.z; q[4 * rho + 3] *= w4.w; }
            const PK2 qp = pack2(q);
            const v4u w0 = __builtin_bit_cast(v4u, qp.s[0]), w1 = __builtin_bit_cast(v4u, qp.s[1]);
            const unsigned vo = (unsigned)(c * 128 + h * 8); const int so = ib * 4096 + jb2 * 64;
            BST64(((u32x2){w0.x, w0.y}), rsQ, vo, so); BST64(((u32x2){w0.z, w0.w}), rsQ, vo, so + 16); BST64(((u32x2){w1.x, w1.y}), rsQ, vo, so + 32); BST64(((u32x2){w1.z, w1.w}), rsQ, vo, so + 48);
        }
    LDS_WAIT(); asm volatile("" ::: "memory");
#undef REFRESH
}

__device__ __forceinline__ void pass2_wave(Frame& F, int b, int head, int iblk) {
    const int lane = F.lane, il = lane & 15, g = lane >> 4, i = 16 * iblk + il;
    f32x4 acc[4];
#pragma unroll
    for (int rt = 0; rt < 4; ++rt) acc[rt] = (f32x4){0.f, 0.f, 0.f, 0.f};
    for (int cc = 0; cc < 256; ++cc) {
        const size_t it = (size_t)((b * 256 + cc) * 8 + head);
        const bf16* pt = F.PT + it * 4096; bf16* qm = F.QM + it * 4096 + (size_t)i * 64 + 4 * g; const float* wcp = F.WC + it * 64 + 4 * g;
        bf16x8 Af[4][2]; u32x2 qv[4]; f32x4 wc[4];
#pragma unroll
        for (int rt = 0; rt < 4; ++rt) {
#pragma unroll
            for (int ks = 0; ks < 2; ++ks) Af[rt][ks] = *(const bf16x8*)(pt + (size_t)((ks * 4 + g) * 64 + 16 * rt + il) * 8);
            qv[rt] = *(const u32x2*)(qm + 16 * rt); wc[rt] = *(const f32x4*)(wcp + 16 * rt);
        }
        u32x2 sv[4];
#pragma unroll
        for (int rt = 0; rt < 4; ++rt) sv[rt] = cvt4(acc[rt]);
        bf16x8 Bf[2];
        Bf[0] = __builtin_bit_cast(bf16x8, (v4u){sv[0].x, sv[0].y, sv[1].x, sv[1].y}); Bf[1] = __builtin_bit_cast(bf16x8, (v4u){sv[2].x, sv[2].y, sv[3].x, sv[3].y});
#pragma unroll
        for (int rt = 0; rt < 4; ++rt) {
            f32x4 a_ = wc[rt] * acc[rt] + unpack4(qv[rt]);
            a_ = MFMA16(Af[rt][0], Bf[0], a_); a_ = MFMA16(Af[rt][1], Bf[1], a_);
            acc[rt] = a_;
        }
        asm volatile("" ::: "memory");
#pragma unroll
        for (int rt = 0; rt < 4; ++rt) *(u32x2*)(qm + 16 * rt) = sv[rt];
    }
}

__device__ __forceinline__ void pass3_item(Frame& F, int it) {
    const int head = it & 7, cc = (it >> 3) & 255, b = it >> 11;
    const int lane = F.lane, c = lane & 31, h = lane >> 5;
    const int row0 = b * T + 32 * cc, pos0 = 32 * cc;
    const bf16* sm = F.QM + (size_t)it * 4096;
    bf16* mixrow = F.MIX + (size_t)(row0 + c) * D + 512 + head * 64;
    f32x16 y[2];
#pragma unroll
    for (int ib = 0; ib < 2; ++ib) {
        const bf16* yi = F.YI + (size_t)it * 2048 + c * 64 + 32 * ib + 4 * h;
        const f32x4 y0 = unpack4(*(const u32x2*)(yi)), y1 = unpack4(*(const u32x2*)(yi + 8)), y2 = unpack4(*(const u32x2*)(yi + 16)), y3 = unpack4(*(const u32x2*)(yi + 24));
        y[ib] = (f32x16){y0.x, y0.y, y0.z, y0.w, y1.x, y1.y, y1.z, y1.w, y2.x, y2.y, y2.z, y2.w, y3.x, y3.y, y3.z, y3.w};
    }
#pragma unroll
    for (int ks = 0; ks < 4; ++ks) {
        const bf16x8 Bf = *(const bf16x8*)(mixrow + 16 * ks + 8 * h);
#pragma unroll
        for (int ib = 0; ib < 2; ++ib) { const bf16x8 Af = *(const bf16x8*)(sm + (size_t)(32 * ib + c) * 64 + 16 * ks + 8 * h); y[ib] = MFMA32(Af, Bf, y[ib]); }
    }
    float s = 0.f;
#pragma unroll
    for (int reg = 0; reg < 16; ++reg) s += y[0][reg] + y[1][reg];
    s += __shfl_xor(s, 32);
    const float mean = s * (1.f / 64.f);
    float q = 0.f;
#pragma unroll
    for (int reg = 0; reg < 16; ++reg) { const float d0 = y[0][reg] - mean, d1 = y[1][reg] - mean; q += d0 * d0 + d1 * d1; }
    q += __shfl_xor(q, 32);
    const float rstd = 1.f / sqrtf(q * (1.f / 64.f) + GN_EPS);
    const float bo = F.bonus[(size_t)(row0 + c) * 8 + head];
    const bool hp = (pos0 + c) > 0;
    const bf16* prow = F.P + SEG0 + (size_t)(row0 + c) * LDP + head * 64;
#pragma unroll
    for (int ib = 0; ib < 2; ++ib)
#pragma unroll
        for (int rho = 0; rho < 4; ++rho) {
            const int i0 = 32 * ib + 8 * rho + 4 * h, gi = head * 64 + i0;
            const f32x4 cv = unpack4(*(const u32x2*)(prow + C_V + i0)), cz = unpack4(*(const u32x2*)(prow + C_Z + i0));
            f32x4 pv = cv * 0.f, pz = cz * 0.f;
            if (hp) { pv = unpack4(*(const u32x2*)(prow - LDP + C_V + i0)); pz = unpack4(*(const u32x2*)(prow - LDP + C_Z + i0)); }
            const f32x4 v = cv + (pv - cv) * *(const f32x4*)(F.mu + C_V + gi), z = cz + (pz - cz) * *(const f32x4*)(F.mu + C_Z + gi);
            const f32x4 lw = *(const f32x4*)(F.ln_w + gi), lb = *(const f32x4*)(F.ln_b + gi);
            const f32x4 yy = (f32x4){y[ib][4 * rho], y[ib][4 * rho + 1], y[ib][4 * rho + 2], y[ib][4 * rho + 3]};
            f32x4 o = (yy - mean) * rstd * lw + lb + bo * v;
            o.x *= siluf_(z.x); o.y *= siluf_(z.y); o.z *= siluf_(z.z); o.w *= siluf_(z.w);
            *(u32x2*)(mixrow + i0) = cvt4(o);
        }
}

__device__ __forceinline__ void p3_pool_pass1(Frame& F) {
    LAS float* scr = (LAS float*)(F.lds + F.wave * 19456);
    const int gw = F.vcu * NWAVES + F.wave, NGW = F.G * NWAVES;
    for (int it = gw; it < 8192; it += NGW) {
        const int g = it & 3, tb = it >> 2;
        if (g == 0) pool_item<0>(F, tb, scr); else if (g == 1) pool_item<1>(F, tb, scr); else if (g == 2) pool_item<2>(F, tb, scr); else pool_item<3>(F, tb, scr);
    }
    for (int it = gw; it < 4096; it += NGW) pass1_item(F, it, F.lds + F.wave * 19456, (LAS float*)(F.lds + F.wave * 19456 + 16896));
}
__device__ __forceinline__ void p4_pass2(Frame& F) {
    const int B = blockIdx.x;
    if (B < 64 && F.wave == 0) { const int x = B & 7, m = B >> 3, bh = x + 8 * (m >> 2), iblk = m & 3; pass2_wave(F, bh >> 3, bh & 7, iblk); }
}
__device__ __forceinline__ void p5_pass3(Frame& F) {
    const int gw = F.vcu * NWAVES + F.wave, NGW = F.G * NWAVES;
    for (int it = gw; it < 4096; it += NGW) pass3_item(F, it);
}

struct EpiResGate {
    static constexpr bool PERM = false, AFTER_DRAIN = false;
    const float* x; const float* mod; float* out; float* rowss;
    __device__ __forceinline__ void operator()(const pg8::f32x4 (&acc)[2][2][4][2], const pg8::Unit& u, int wr, int wc, int fr, int fq) const {
        const int col0 = u.pn * 256 + wc * 32 + 4 * fq;
        const int b = (u.pm * 256) >> 13;
        const float* gate = mod + b * 3072 + 2048;
        f32x4 gv[2][2];
#pragma unroll
        for (int bj = 0; bj < 2; ++bj)
#pragma unroll
            for (int n = 0; n < 2; ++n) gv[bj][n] = *(const f32x4*)(gate + col0 + bj * 128 + n * 16);
#pragma unroll
        for (int ai = 0; ai < 2; ++ai)
#pragma unroll
            for (int m = 0; m < 4; ++m) { const int r = u.pm * 256 + ai * 128 + wr * 64 + m * 16 + fr; const size_t off = (size_t)r * D + col0; float ss = 0.f;
#pragma unroll
                for (int bj = 0; bj < 2; ++bj)
#pragma unroll
                    for (int n = 0; n < 2; ++n) { const f32x4 xv = *(const f32x4*)(x + off + bj * 128 + n * 16); const f32x4 o = xv + gv[bj][n] * acc[ai][bj][m][n];
                        *(f32x4*)(out + off + bj * 128 + n * 16) = o; ss += (o.x * o.x + o.y * o.y) + (o.z * o.z + o.w * o.w); }
                ss += __shfl_xor(ss, 16); ss += __shfl_xor(ss, 32);
                if (fq == 0) __hip_atomic_fetch_add(rowss + r, ss, __ATOMIC_RELAXED, __HIP_MEMORY_SCOPE_AGENT); }
    }
};

__device__ __forceinline__ void p7_final(Frame& F) {
    const int gw = F.vcu * NWAVES + F.wave, NGW = F.G * NWAVES;
    for (int m = gw; m < M; m += NGW) {
        const float rstd = 1.f / sqrtf(F.rowss[m] * (1.f / D) + NORM_EPS);
        f32x4* o = (f32x4*)(F.out + (size_t)m * D) + F.lane;
#pragma unroll
        for (int j = 0; j < 4; ++j) { const f32x4 g = ((const f32x4*)F.final_g)[F.lane + 64 * j]; o[64 * j] = o[64 * j] * rstd * g; }
    }
}

struct Args { const float* in[20]; float* out; unsigned char* ws; int ph_lo, ph_hi; };
__global__ void __launch_bounds__(NWAVES * 64, 2) fwd_kernel(Args args) {
    extern __shared__ __attribute__((aligned(16))) unsigned char lds[];
    Frame F;
    F.lds = (LAS unsigned char*)lds;
    F.MISC = (volatile LAS unsigned*)(F.lds + MISC_OFF);
    F.tid = threadIdx.x; F.lane = F.tid & 63; F.wave = __builtin_amdgcn_readfirstlane(F.tid >> 6);
    F.G = gridDim.x; { const int bx = blockIdx.x; F.vcu = (F.G % 8 == 0) ? (bx % 8) * (F.G / 8) + bx / 8 : bx; }
    unsigned char* ws = args.ws;
    F.x = args.in[0]; F.c = args.in[1]; F.w_ada = args.in[2]; F.b_ada = args.in[3]; F.norm_g = args.in[4]; F.w_in = args.in[5]; F.pool_w = args.in[6]; F.pool_scale = args.in[7];
    F.mu = args.in[8]; F.w0 = args.in[9]; F.w_up = args.in[10]; F.a0 = args.in[11]; F.a_up = args.in[12]; F.k_k = args.in[13]; F.k_a = args.in[14]; F.r_k = args.in[15];
    F.ln_w = args.in[16]; F.ln_b = args.in[17]; F.w_out = args.in[18]; F.final_g = args.in[19]; F.out = args.out;
    F.mod = (float*)(ws + WS_CTL + CTL_MOD); F.rowss = (float*)(ws + WS_CTL + CTL_ROWSS); F.bonus = (float*)(ws + WS_BONUS); F.WC = (float*)(ws + WS_WC); F.PRM = (float*)(ws + WS_PRM);
    F.W1t = (bf16*)(ws + WS_W1T); F.W2t = (bf16*)(ws + WS_W2T); F.XN = (bf16*)(ws + WS_XN); F.P = (bf16*)(ws + WS_P); F.MIX = (bf16*)(ws + WS_MIX);
    F.WUPT = (bf16*)(ws + WS_WUPT); F.AUPT = (bf16*)(ws + WS_AUPT); F.YI = (bf16*)(ws + WS_YI); F.PT = (bf16*)(ws + WS_PT); F.QM = (bf16*)(ws + WS_QM);
    for (int u = F.tid; u < (LDS_BYTES - LDSCTL_OFF) / 4; u += NWAVES * 64) ((LAS unsigned*)(F.lds + LDSCTL_OFF))[u] = 0u;
    __syncthreads();
    XcdBarrier bar; bar.bar = (unsigned*)(ws + WS_CTL) + CW_BAR; bar.x = 0; bar.st = nullptr;
    if (N_LAUNCHES == 1) bar = xcd_barrier_post((unsigned*)(ws + WS_CTL) + CW_BAR, F.MISC + 8);
    const int lo = args.ph_lo, hi = args.ph_hi;
#define IN(k) (lo <= (k) && (k) < hi)
#define SEAM(k) do { if (IN(k) && IN((k) + 1)) xcd_barrier(bar); } while (0)
    if (IN(0)) { p0_prologue(F); } SEAM(0);
    if (IN(1)) { p1_hrows(F); } SEAM(1);
    if (IN(2)) {
        pg8::Gemm g{F.XN, F.W1t, M, LDP, D}; pg8::StaticOrder S; S.init(M, LDP, F.G, (int)blockIdx.x);
        pg8::EpiBf16<0> E{F.P, LDP, nullptr, 0, 0, 1.f};
        pg8::gemm_phase<pg8::EpiBf16<0>, pg8::StaticOrder, true, true>(F.lds, g, S, E);
    } SEAM(2);
    if (IN(3)) { p3_pool_pass1(F); } SEAM(3);
    if (IN(4)) { p4_pass2(F); } SEAM(4);
    if (IN(5)) { p5_pass3(F); } SEAM(5);
    if (IN(6)) {
        pg8::Gemm g{F.MIX, F.W2t, M, D, D}; pg8::StaticOrder S; S.init(M, D, F.G, (int)blockIdx.x);
        EpiResGate E{F.x, F.mod, F.out, F.rowss};
        pg8::gemm_phase<EpiResGate, pg8::StaticOrder, true, true>(F.lds, g, S, E);
    } SEAM(6);
    if (IN(7)) { p7_final(F); }
#undef IN
#undef SEAM
}

extern "C" void kernel_launch(void* const* d_in, const int* in_sizes, int n_in, void* d_out, int out_size, void* d_ws, size_t ws_size, hipStream_t stream) {
    static int grid = 0;
    if (grid == 0) {
        if (n_in != 20 || in_sizes[0] != M * D || out_size != M * D || ws_size < WS_END) { fprintf(stderr, "kernel_launch: unexpected shapes (n_in %d, in0 %d, out %d, ws %zu); nothing launched\n", n_in, n_in > 0 ? in_sizes[0] : -1, out_size, ws_size); grid = -1; return; }
        int dev = 0, cus = 0, per_cu = 0;
        if (hipGetDevice(&dev) != hipSuccess || hipDeviceGetAttribute(&cus, hipDeviceAttributeMultiprocessorCount, dev) != hipSuccess) { grid = -1; return; }
        if (hipFuncSetAttribute((const void*)fwd_kernel, hipFuncAttributeMaxDynamicSharedMemorySize, LDS_BYTES) != hipSuccess) { fprintf(stderr, "kernel_launch: hipFuncSetAttribute failed\n"); grid = -1; return; }
        if (hipOccupancyMaxActiveBlocksPerMultiprocessor(&per_cu, (const void*)fwd_kernel, NWAVES * 64, LDS_BYTES) != hipSuccess || per_cu < 1) { fprintf(stderr, "kernel_launch: occupancy query reports %d blocks per CU\n", per_cu); grid = -1; (void)hipGetLastError(); return; }
        (void)hipGetLastError();
        grid = cus;
    }
    if (grid < 0) return;
    if (hipMemsetAsync((char*)d_ws + WS_CTL, 0, CTL_ZERO_BYTES, stream) != hipSuccess) return;
    Args a{};
    for (int i = 0; i < 20; ++i) a.in[i] = (const float*)d_in[i];
    a.out = (float*)d_out; a.ws = (unsigned char*)d_ws;
    if (N_LAUNCHES == 1) { a.ph_lo = 0; a.ph_hi = N_PHASES; hipLaunchKernelGGL(fwd_kernel, dim3(grid), dim3(NWAVES * 64), LDS_BYTES, stream, a); }
    else for (int li = 0; li < N_PHASES; ++li) { a.ph_lo = li; a.ph_hi = li + 1; hipLaunchKernelGGL(fwd_kernel, dim3(grid), dim3(NWAVES * 64), LDS_BYTES, stream, a); }
}
```

```cpp
#include <hip/hip_runtime.h>
#include <cstdio>
#include <cstdint>
namespace pg8 {
#define PG8_LAS __attribute__((address_space(3)))
typedef unsigned short bf16_t;
typedef short bf16x8 __attribute__((ext_vector_type(8)));
typedef float f32x4 __attribute__((ext_vector_type(4)));
typedef unsigned u32x4 __attribute__((ext_vector_type(4)));
constexpr int BM = 256, BK = 64, HALF = 128, HTB = HALF * BK * 2  , STAGE_BYTES = 8 * HTB, NXCD = 8, WGM = 8;

__host__ __device__ __forceinline__ int lds_byte(int r, int c) { const int st = (r >> 4) * 2 + (c >> 5), rr = r & 15, cc = c & 31, ob = rr * 64 + cc * 2; return st * 1024 + (ob ^ (((ob >> 9) & 1) << 5)); }
__host__ __device__ __forceinline__ void stage_rc(int b, int& R, int& C) { const int st = b / 1024, sb = b % 1024, swz = sb ^ (((sb >> 9) & 1) << 5); R = (st >> 1) * 16 + swz / 64; C = (st & 1) * 32 + (swz % 64) / 2; }
__host__ __device__ __forceinline__ int perm32(int rho) { const int n = rho >> 4, i = rho & 15; return 8 * (i >> 2) + 4 * n + (i & 3); }

struct Unit { int pm, pn; };
struct Gemm { const bf16_t* A; const bf16_t* Bt; int M, N, K; };

struct StaticOrder {
    int nM, nN, nwg, G, c;
    __host__ __device__ void init(int M, int N, int G_, int c_) { nM = M / BM; nN = N / BM; nwg = nM * nN; G = G_; c = c_; }
    __host__ __device__ bool next(int i, Unit& u) const {
        const long L = (long)i * G + c; if (L >= nwg) return false;
        int wgid = (int)L; { const int q = nwg / NXCD, r = nwg % NXCD, xcd = wgid % NXCD, off = wgid / NXCD; wgid = (xcd < r ? xcd * (q + 1) : r * (q + 1) + (xcd - r) * q) + off; }
        const int nig = WGM * nN, gid = wgid / nig, fm = gid * WGM, gsz = (nM - fm) < WGM ? (nM - fm) : WGM;
        u.pm = fm + ((wgid % nig) % gsz); u.pn = (wgid % nig) / gsz; return true;
    }
    __device__ __forceinline__ void a_ready(const Unit&) const {}
    __device__ __forceinline__ void done(const Unit&) const {}
};

__device__ __forceinline__ unsigned cvt_pk_bf16(float lo, float hi) { unsigned r; asm volatile("v_cvt_pk_bf16_f32 %0, %1, %2" : "=v"(r) : "v"(lo), "v"(hi)); return r; }
typedef float f32x2 __attribute__((ext_vector_type(2)));
__device__ __forceinline__ f32x2 gelu_pk(f32x2 v) {
    const f32x2 av = __builtin_elementwise_abs(v), d = av * 0.2316418882f + 1.0f;
    f32x2 t; t.x = __builtin_amdgcn_rcpf(d.x); t.y = __builtin_amdgcn_rcpf(d.y);
    f32x2 q = t * 0.5307027145f + (-0.7265760135f); q = q * t + 0.7107068705f; q = q * t + (-0.142248368f); q = q * t + 0.127414796f; q = q * t;
    const f32x2 s = (v * v) * (-0.72134752044f);
    f32x2 e; e.x = __builtin_amdgcn_exp2f(s.x); e.y = __builtin_amdgcn_exp2f(s.y);
    const f32x2 m = v * (q * e), r = v - m;
    f32x2 o; o.x = v.x < 0.f ? m.x : r.x; o.y = v.y < 0.f ? m.y : r.y; return o;
}

template <int ACT  > struct EpiBf16 {
    static constexpr bool PERM = true, AFTER_DRAIN = false; static_assert(ACT == 0 || ACT == 1, "EpiBf16: ACT is 0 (none) or 1 (gelu_pk)");
    bf16_t* O; int ldc; const float* bias; int split_cols; size_t split_stride; float scale0;
    __device__ __forceinline__ void operator()(const f32x4 (&acc)[2][2][4][2], const Unit& u, int wr, int wc, int fr, int fq) const {
        const int row0 = u.pm * BM + wr * 64 + fr; int colt = u.pn * BM; bf16_t* base = O;
        float sc = 1.f; if (split_cols) { const int t = colt / split_cols; base += (size_t)t * split_stride; colt -= t * split_cols; if (t == 0) sc = scale0; }
        const int col0 = colt + wc * 32 + 8 * fq, bcol0 = u.pn * BM + wc * 32 + 8 * fq;
        f32x4 bv[2][2];
#pragma unroll
        for (int bj = 0; bj < 2; ++bj)
#pragma unroll
            for (int n = 0; n < 2; ++n) bv[bj][n] = bias ? *(const f32x4*)(bias + bcol0 + bj * HALF + 4 * n) : (f32x4){0.f, 0.f, 0.f, 0.f};
#pragma unroll
        for (int ai = 0; ai < 2; ++ai)
#pragma unroll
            for (int m = 0; m < 4; ++m) { bf16_t* rowp = base + (size_t)(row0 + ai * HALF + m * 16) * ldc + col0;
#pragma unroll
                for (int bj = 0; bj < 2; ++bj) { f32x4 v0 = acc[ai][bj][m][0] + bv[bj][0], v1 = acc[ai][bj][m][1] + bv[bj][1];
                    if (ACT == 1) { f32x2 a = gelu_pk((f32x2){v0[0], v0[1]}), b = gelu_pk((f32x2){v0[2], v0[3]}), c = gelu_pk((f32x2){v1[0], v1[1]}), d = gelu_pk((f32x2){v1[2], v1[3]});
                        v0 = (f32x4){a.x, a.y, b.x, b.y}; v1 = (f32x4){c.x, c.y, d.x, d.y}; }
                    v0 = v0 * sc; v1 = v1 * sc; u32x4 w; w.x = cvt_pk_bf16(v0[0], v0[1]); w.y = cvt_pk_bf16(v0[2], v0[3]); w.z = cvt_pk_bf16(v1[0], v1[1]); w.w = cvt_pk_bf16(v1[2], v1[3]);
                    *(u32x4*)(rowp + bj * HALF) = w; } }
    }
};

struct PanelStats {
    unsigned* xbuf;
    unsigned* cnt;
    unsigned* tmo;
    int ntn; float eps;
    unsigned code;
    __device__ __forceinline__ bool run(const f32x4 (&v)[2][2][4][2], const Unit& u, int wr, int wc, int fr, int fq, PG8_LAS unsigned char* lds, int wid, int lane) const {
        typedef float f32x2v __attribute__((ext_vector_type(2)));
        PG8_LAS f32x2v* P = (PG8_LAS f32x2v*)lds;
        PG8_LAS f32x2v* S = (PG8_LAS f32x2v*)(lds + 8192);
        PG8_LAS unsigned* flag = (PG8_LAS unsigned*)(lds + 8192 + 2048);
#pragma unroll
        for (int ai = 0; ai < 2; ++ai)
#pragma unroll
            for (int m = 0; m < 4; ++m) {
                float s = 0.f;
#pragma unroll
                for (int bj = 0; bj < 2; ++bj)
#pragma unroll
                    for (int n = 0; n < 2; ++n) { const f32x4 x = v[ai][bj][m][n]; s += (x[0] + x[1]) + (x[2] + x[3]); }
                s += __shfl_xor(s, 16); s += __shfl_xor(s, 32);
                const float mw = s * (1.0f / 64.0f); float q = 0.f;
#pragma unroll
                for (int bj = 0; bj < 2; ++bj)
#pragma unroll
                    for (int n = 0; n < 2; ++n) { const f32x4 d = v[ai][bj][m][n] - mw; q += (d[0] * d[0] + d[1] * d[1]) + (d[2] * d[2] + d[3] * d[3]); }
                q += __shfl_xor(q, 16); q += __shfl_xor(q, 32);
                if (fq == 0) P[(ai * HALF + wr * 64 + m * 16 + fr) * 4 + wc] = (f32x2v){mw, q};
            }
        asm volatile("s_waitcnt lgkmcnt(0)" ::: "memory"); __builtin_amdgcn_s_barrier(); asm volatile("" ::: "memory");
#if defined(BROKEN_EXCHANGE_NO_WAIT)
#warning BROKEN CONTROL BUILD: the row-statistics exchange does not wait; results are wrong by design
        if (blockIdx.x >= 64) { const long long t0_ = clock64(); while (clock64() - t0_ < 60000) __builtin_amdgcn_s_sleep(8); }
#endif
        const int row = wid * 32 + (lane & 31);
        if (lane < 32) {
            const f32x2v a = P[row * 4 + 0], b = P[row * 4 + 1], c = P[row * 4 + 2], d = P[row * 4 + 3];
            const float mt = (a.x + b.x + c.x + d.x) * 0.25f;
            const float da = a.x - mt, db = b.x - mt, dc = c.x - mt, dd = d.x - mt;
            const float m2 = (a.y + b.y) + (c.y + d.y) + 64.0f * ((da * da + db * db) + (dc * dc + dd * dd));
            unsigned long long* slot = (unsigned long long*)xbuf + ((size_t)(u.pm * BM + row) * 4 + u.pn);
            __hip_atomic_store(slot, ((unsigned long long)__float_as_uint(m2) << 32) | __float_as_uint(mt), __ATOMIC_RELAXED, __HIP_MEMORY_SCOPE_AGENT);
        }
        asm volatile("s_waitcnt vmcnt(0)" ::: "memory");
        if (lane == 0) __hip_atomic_fetch_add(cnt + 64 * u.pm, 1u, __ATOMIC_RELAXED, __HIP_MEMORY_SCOPE_AGENT);
        if (wid == 0) {
            bool dead = false; const unsigned long long t0 = __builtin_amdgcn_s_memrealtime(); const unsigned want = 8u * (unsigned)ntn;
            for (;;) {
#if defined(BROKEN_EXCHANGE_NO_WAIT)
                break;
#endif
                if ((unsigned)__builtin_amdgcn_readfirstlane(__hip_atomic_load(cnt + 64 * u.pm, __ATOMIC_RELAXED, __HIP_MEMORY_SCOPE_AGENT)) >= want) break;
                if (__builtin_amdgcn_s_memrealtime() - t0 > 2000000ull) {
                    if (lane == 0) { unsigned expect = 0u; __hip_atomic_compare_exchange_strong(tmo + 1, &expect, code | (unsigned)(u.pm & 0xff), __ATOMIC_RELAXED, __ATOMIC_RELAXED, __HIP_MEMORY_SCOPE_AGENT);
                                     __hip_atomic_store(tmo, 1u, __ATOMIC_RELAXED, __HIP_MEMORY_SCOPE_AGENT); }
                    dead = true; break; }
                __builtin_amdgcn_s_sleep(2);
            }
            __builtin_amdgcn_fence(__ATOMIC_ACQUIRE, "agent");
            if (lane == 0) flag[0] = dead ? 1u : 0u;
        }
        asm volatile("s_waitcnt vmcnt(0) lgkmcnt(0)" ::: "memory"); __builtin_amdgcn_s_barrier(); asm volatile("" ::: "memory");
        const bool bad = flag[0] != 0u;
        if (lane < 32) {
            const unsigned long long* slot = (const unsigned long long*)xbuf + (size_t)(u.pm * BM + row) * 4; float mt[4], m2[4]; float ms = 0.f;
#pragma unroll
            for (int t = 0; t < 4; ++t) { if (t < ntn) { const unsigned long long w = __hip_atomic_load(slot + t, __ATOMIC_RELAXED, __HIP_MEMORY_SCOPE_AGENT); mt[t] = __uint_as_float((unsigned)w); m2[t] = __uint_as_float((unsigned)(w >> 32)); } else { mt[t] = 0.f; m2[t] = 0.f; } ms += mt[t]; }
            const float mean = ms / (float)ntn; float q = 0.f;
#pragma unroll
            for (int t = 0; t < 4; ++t) if (t < ntn) { const float dm = mt[t] - mean; q += m2[t] + 256.0f * dm * dm; }
            S[row] = (f32x2v){mean, 1.0f / sqrtf(q / (256.0f * (float)ntn) + eps)};
        }
        asm volatile("s_waitcnt lgkmcnt(0)" ::: "memory"); __builtin_amdgcn_s_barrier(); asm volatile("" ::: "memory");
        return bad;
    }
};
struct EpiLnRes {
    static constexpr bool PERM = false, AFTER_DRAIN = true;
    const float* base; float* out; int ldc; const float* bias; PanelStats st; unsigned poison;
    __device__ __forceinline__ void fused(f32x4 (&acc)[2][2][4][2], const Unit& u, int wr, int wc, int fr, int fq, PG8_LAS unsigned char* lds, int wid, int lane) const {
        typedef float f32x2v __attribute__((ext_vector_type(2)));
        const PG8_LAS f32x2v* S = (const PG8_LAS f32x2v*)(lds + 8192);
        const int col0 = u.pn * BM + wc * 32 + 4 * fq;
#pragma unroll
        for (int bj = 0; bj < 2; ++bj)
#pragma unroll
            for (int n = 0; n < 2; ++n) { const f32x4 bv = bias ? *(const f32x4*)(bias + col0 + bj * HALF + n * 16) : (f32x4){0.f, 0.f, 0.f, 0.f};
#pragma unroll
                for (int ai = 0; ai < 2; ++ai)
#pragma unroll
                    for (int m = 0; m < 4; ++m) acc[ai][bj][m][n] += bv; }
        f32x4 pre[4][2][2];
#pragma unroll
        for (int m = 0; m < 4; ++m) { const size_t off = (size_t)(u.pm * BM + wr * 64 + m * 16 + fr) * ldc + col0;
#pragma unroll
            for (int bj = 0; bj < 2; ++bj)
#pragma unroll
                for (int n = 0; n < 2; ++n) pre[m][bj][n] = *(const f32x4*)(base + off + bj * HALF + n * 16); }
        const bool bad = st.run(acc, u, wr, wc, fr, fq, lds, wid, lane) || poison != 0u;
        const float qnan = __builtin_nanf("");
#pragma unroll
        for (int ai = 0; ai < 2; ++ai)
#pragma unroll
            for (int m = 0; m < 4; ++m) { const int r = ai * HALF + wr * 64 + m * 16 + fr; const f32x2v sr = S[r]; const size_t off = (size_t)(u.pm * BM + r) * ldc + col0;
#pragma unroll
                for (int bj = 0; bj < 2; ++bj)
#pragma unroll
                    for (int n = 0; n < 2; ++n) { const f32x4 bs = ai == 0 ? pre[m][bj][n] : *(const f32x4*)(base + off + bj * HALF + n * 16); f32x4 o = bs + (acc[ai][bj][m][n] - sr.x) * sr.y;
                        if (bad) o = (f32x4){qnan, qnan, qnan, qnan}; *(f32x4*)(out + off + bj * HALF + n * 16) = o; }
                if (m & 1) asm volatile("" ::: "memory"); }
    }
};
struct EpiLnResLn {
    static constexpr bool PERM = false, AFTER_DRAIN = true;
    const float* base; float* out; bf16_t* xn; int ldc; const float* bias; PanelStats st1, st2; unsigned poison;
    __device__ __forceinline__ void fused(f32x4 (&acc)[2][2][4][2], const Unit& u, int wr, int wc, int fr, int fq, PG8_LAS unsigned char* lds, int wid, int lane) const {
        typedef float f32x2v __attribute__((ext_vector_type(2))); typedef unsigned u32x2v __attribute__((ext_vector_type(2)));
        const PG8_LAS f32x2v* S = (const PG8_LAS f32x2v*)(lds + 8192);
        const int col0 = u.pn * BM + wc * 32 + 4 * fq;
#pragma unroll
        for (int bj = 0; bj < 2; ++bj)
#pragma unroll
            for (int n = 0; n < 2; ++n) { const f32x4 bv = bias ? *(const f32x4*)(bias + col0 + bj * HALF + n * 16) : (f32x4){0.f, 0.f, 0.f, 0.f};
#pragma unroll
                for (int ai = 0; ai < 2; ++ai)
#pragma unroll
                    for (int m = 0; m < 4; ++m) acc[ai][bj][m][n] += bv; }
        bool bad = st1.run(acc, u, wr, wc, fr, fq, lds, wid, lane) || poison != 0u;
        const float qnan = __builtin_nanf("");
#pragma unroll
        for (int ai = 0; ai < 2; ++ai)
#pragma unroll
            for (int m = 0; m < 4; ++m) { const int r = ai * HALF + wr * 64 + m * 16 + fr; const f32x2v sr = S[r]; const size_t off = (size_t)(u.pm * BM + r) * ldc + col0;
#pragma unroll
                for (int bj = 0; bj < 2; ++bj)
#pragma unroll
                    for (int n = 0; n < 2; ++n) { const f32x4 bs = *(const f32x4*)(base + off + bj * HALF + n * 16); acc[ai][bj][m][n] = bs + (acc[ai][bj][m][n] - sr.x) * sr.y; }
                asm volatile("" : "+v"(acc[ai][0][m][0]), "+v"(acc[ai][0][m][1]), "+v"(acc[ai][1][m][0]), "+v"(acc[ai][1][m][1]));
                if (m & 1) asm volatile("" ::: "memory"); }
        const bool bad1 = bad;
        bad = st2.run(acc, u, wr, wc, fr, fq, lds, wid, lane) || bad;
#pragma unroll
        for (int ai = 0; ai < 2; ++ai)
#pragma unroll
            for (int m = 0; m < 4; ++m) { const int r = ai * HALF + wr * 64 + m * 16 + fr; const f32x2v sr = S[r]; const size_t off = (size_t)(u.pm * BM + r) * ldc + col0;
#pragma unroll
                for (int bj = 0; bj < 2; ++bj)
#pragma unroll
                    for (int n = 0; n < 2; ++n) { const f32x4 x1 = acc[ai][bj][m][n]; *(f32x4*)(out + off + bj * HALF + n * 16) = bad1 ? (f32x4){qnan, qnan, qnan, qnan} : x1;
                        const f32x4 o = (x1 - sr.x) * sr.y; u32x2v w; w.x = cvt_pk_bf16(o[0], o[1]); w.y = cvt_pk_bf16(o[2], o[3]);
                        if (bad) { w.x = 0x7fc07fc0u; w.y = 0x7fc07fc0u; } *(u32x2v*)(xn + off + bj * HALF + n * 16) = w; }
                asm volatile("" ::: "memory"); }
    }
};

template <class Epi, class Sched, bool ALIGN_EPI = false, bool SP2 = false>
__device__ __forceinline__ void gemm_phase(PG8_LAS unsigned char* lds, const Gemm g, const Sched& S, const Epi& E) {
    const int tid = threadIdx.x, wid = __builtin_amdgcn_readfirstlane(tid >> 6), lane = tid & 63, wr = wid >> 2, wc = wid & 3, fr = lane & 15, fq = lane >> 4;
    const int K = g.K, nt = K / BK;
    unsigned voffA[2], voffB[2];
#pragma unroll
    for (int i = 0; i < 2; ++i) { int R, C; stage_rc(tid * 16 + i * 8192, R, C); const int Rb = Epi::PERM ? ((R & ~31) + perm32(R & 31)) : R;
        voffA[i] = (unsigned)(R * K + C) * 2u; voffB[i] = (unsigned)(Rb * K + C) * 2u; }
    const size_t kstep = (size_t)(BK * 2);
    const size_t hstep = (size_t)HALF * K * 2;
    const size_t tstep = 2 * hstep;
    const unsigned ldsw = (unsigned)wid * 1024u;
    const int aoff = lds_byte(wr * 64 + fr, fq * 8), boff = lds_byte(wc * 32 + fr, fq * 8);
#define PG8_SA(b, h) (((b) * 2 + (h)) * HTB)
#define PG8_SB(b, h) ((4 + (b) * 2 + (h)) * HTB)
#define PG8_STAGE(bufoff, gbase, voff) do { _Pragma("unroll") for (int _i = 0; _i < 2; ++_i) \
        __builtin_amdgcn_global_load_lds((const unsigned*)((const char*)(gbase) + (voff)[_i]), (PG8_LAS unsigned*)(lds + (bufoff) + ldsw + _i * 8192), 16, 0, 0); } while (0)
#define PG8_LDA(dst, b, h) do { _Pragma("unroll") for (int m = 0; m < 4; ++m) _Pragma("unroll") for (int k = 0; k < 2; ++k) dst[m][k] = *(const PG8_LAS bf16x8*)(lds + PG8_SA(b, h) + aoff + m * 2048 + k * 1024); } while (0)
#define PG8_LDB(dst, b, h) do { _Pragma("unroll") for (int n = 0; n < 2; ++n) _Pragma("unroll") for (int k = 0; k < 2; ++k) dst[n][k] = *(const PG8_LAS bf16x8*)(lds + PG8_SB(b, h) + boff + n * 2048 + k * 1024); } while (0)
#define PG8_MMA(ai, bj, At, Bt) do { __builtin_amdgcn_s_setprio(1); _Pragma("unroll") for (int m = 0; m < 4; ++m) _Pragma("unroll") for (int n = 0; n < 2; ++n) _Pragma("unroll") for (int k = 0; k < 2; ++k) \
        acc[ai][bj][m][n] = __builtin_amdgcn_mfma_f32_16x16x32_bf16(Bt[n][k], At[m][k], acc[ai][bj][m][n], 0, 0, 0); __builtin_amdgcn_s_setprio(0); } while (0)
#define PG8_WAIT_V(n) asm volatile("s_waitcnt vmcnt(" #n ")" ::: "memory")
#define PG8_WAIT_L(n) asm volatile("s_waitcnt lgkmcnt(" #n ")" ::: "memory")
#define PG8_BAR __builtin_amdgcn_s_barrier()
#define PG8_SCHED __builtin_amdgcn_sched_barrier(0)
    Unit cur, nxt; int ui = 0;
    if (!S.next(0, cur)) return;
    f32x4 acc[2][2][4][2];
#pragma unroll
    for (int a = 0; a < 2; ++a)
#pragma unroll
        for (int b = 0; b < 2; ++b)
#pragma unroll
            for (int m = 0; m < 4; ++m)
#pragma unroll
                for (int n = 0; n < 2; ++n) acc[a][b][m][n] = (f32x4){0.f, 0.f, 0.f, 0.f};
    bf16x8 At[4][2], B0[2][2], B1[2][2];
    const char* cA = (const char*)g.A + (size_t)cur.pm * tstep; const char* cB = (const char*)g.Bt + (size_t)cur.pn * tstep;
    S.a_ready(cur);
    if constexpr (SP2) {
        PG8_STAGE(PG8_SB(0, 0), cB, voffB); PG8_STAGE(PG8_SB(0, 1), cB + hstep, voffB); PG8_STAGE(PG8_SA(0, 0), cA, voffA); PG8_STAGE(PG8_SA(0, 1), cA + hstep, voffA);
        if (wr == 1) PG8_BAR;
        PG8_WAIT_V(2); PG8_BAR;
        PG8_STAGE(PG8_SB(1, 0), cB + kstep, voffB); PG8_STAGE(PG8_SA(1, 0), cA + kstep, voffA); PG8_STAGE(PG8_SB(1, 1), cB + hstep + kstep, voffB);
        PG8_WAIT_V(6); PG8_BAR;
    } else {
        PG8_STAGE(PG8_SB(0, 0), cB, voffB); PG8_STAGE(PG8_SA(0, 0), cA, voffA); PG8_STAGE(PG8_SB(0, 1), cB + hstep, voffB); PG8_STAGE(PG8_SA(0, 1), cA + hstep, voffA);
        if (wr == 1) PG8_BAR;
        PG8_WAIT_V(4); PG8_BAR;
        PG8_STAGE(PG8_SB(1, 0), cB + kstep, voffB); PG8_STAGE(PG8_SA(1, 0), cA + kstep, voffA); PG8_STAGE(PG8_SB(1, 1), cB + hstep + kstep, voffB);
        PG8_WAIT_V(6); PG8_BAR;
    }
    for (;;) {
        const bool has_next = S.next(ui + 1, nxt);
        const char* nA = has_next ? (const char*)g.A + (size_t)nxt.pm * tstep : cA; const char* nB = has_next ? (const char*)g.Bt + (size_t)nxt.pn * tstep : cB;
        for (int t = 0; t < nt; t += 2) {
            const bool last = (t == nt - 2);
            const char* a1 = cA + (size_t)(t + 1) * kstep;
            const char* a2 = last ? nA : cA + (size_t)(t + 2) * kstep; const char* b2 = last ? nB : cB + (size_t)(t + 2) * kstep;
            const char* a3 = a2 + kstep; const char* b3 = b2 + kstep;
            if (last && has_next) S.a_ready(nxt);
            if constexpr (SP2) {
            PG8_LDB(B0, 0, 0); PG8_LDB(B1, 0, 1); PG8_SCHED; PG8_LDA(At, 0, 0); PG8_STAGE(PG8_SA(1, 1), a1 + hstep, voffA);
            PG8_WAIT_V(8); PG8_WAIT_L(0); PG8_BAR; PG8_MMA(0, 0, At, B0); PG8_MMA(0, 1, At, B1); PG8_BAR; PG8_SCHED;
            PG8_LDA(At, 0, 1); PG8_STAGE(PG8_SB(0, 0), b2, voffB); PG8_STAGE(PG8_SB(0, 1), b2 + hstep, voffB); PG8_STAGE(PG8_SA(0, 0), a2, voffA);
            PG8_WAIT_V(8); PG8_WAIT_L(0); PG8_BAR; PG8_MMA(1, 0, At, B0); PG8_MMA(1, 1, At, B1); PG8_BAR; PG8_SCHED;
            PG8_LDB(B0, 1, 0); PG8_LDB(B1, 1, 1); PG8_SCHED; PG8_LDA(At, 1, 0); PG8_STAGE(PG8_SA(0, 1), a2 + hstep, voffA);
            PG8_WAIT_V(8); PG8_WAIT_L(0); PG8_BAR; PG8_MMA(0, 0, At, B0); PG8_MMA(0, 1, At, B1); PG8_BAR; PG8_SCHED;
            PG8_LDA(At, 1, 1); PG8_STAGE(PG8_SB(1, 0), b3, voffB); PG8_STAGE(PG8_SB(1, 1), b3 + hstep, voffB); PG8_STAGE(PG8_SA(1, 0), a3, voffA);
            PG8_WAIT_V(8); PG8_WAIT_L(0); PG8_BAR; PG8_MMA(1, 0, At, B0); PG8_MMA(1, 1, At, B1); PG8_BAR; PG8_SCHED;
            } else {
            PG8_LDB(B0, 0, 0); PG8_SCHED; PG8_LDA(At, 0, 0); PG8_STAGE(PG8_SA(1, 1), a1 + hstep, voffA);
            PG8_WAIT_L(8); PG8_BAR; PG8_WAIT_L(0); PG8_MMA(0, 0, At, B0); PG8_BAR; PG8_SCHED;
            PG8_LDB(B1, 0, 1); PG8_STAGE(PG8_SB(0, 0), b2, voffB);
            PG8_BAR; PG8_WAIT_L(0); PG8_MMA(0, 1, At, B1); PG8_BAR;
            PG8_LDA(At, 0, 1); PG8_STAGE(PG8_SA(0, 0), a2, voffA);
            PG8_BAR; PG8_WAIT_L(0); PG8_MMA(1, 0, At, B0); PG8_BAR; PG8_SCHED;
            PG8_STAGE(PG8_SB(0, 1), b2 + hstep, voffB);
            PG8_WAIT_V(6); PG8_BAR; PG8_MMA(1, 1, At, B1); PG8_BAR;
            PG8_LDB(B0, 1, 0); PG8_SCHED; PG8_LDA(At, 1, 0); PG8_STAGE(PG8_SA(0, 1), a2 + hstep, voffA);
            PG8_WAIT_L(8); PG8_BAR; PG8_WAIT_L(0); PG8_MMA(0, 0, At, B0); PG8_BAR; PG8_SCHED;
            PG8_LDB(B1, 1, 1); PG8_STAGE(PG8_SB(1, 0), b3, voffB);
            PG8_BAR; PG8_WAIT_L(0); PG8_MMA(0, 1, At, B1); PG8_BAR;
            PG8_LDA(At, 1, 1); PG8_STAGE(PG8_SA(1, 0), a3, voffA);
            PG8_BAR; PG8_WAIT_L(0); PG8_MMA(1, 0, At, B0); PG8_BAR; PG8_SCHED;
            PG8_STAGE(PG8_SB(1, 1), b3 + hstep, voffB);
            PG8_WAIT_V(6); PG8_BAR; PG8_MMA(1, 1, At, B1); PG8_BAR;
            }
        }
        if constexpr (ALIGN_EPI) { if (wr == 0) PG8_BAR; }
        if constexpr (!Epi::AFTER_DRAIN) { E(acc, cur, wr, wc, fr, fq); S.done(cur); }
        if (!has_next) break;
#pragma unroll
        for (int a = 0; a < 2; ++a)
#pragma unroll
            for (int b = 0; b < 2; ++b)
#pragma unroll
                for (int m = 0; m < 4; ++m)
#pragma unroll
                    for (int n = 0; n < 2; ++n) acc[a][b][m][n] = (f32x4){0.f, 0.f, 0.f, 0.f};
        cur = nxt; cA = nA; cB = nB; ++ui;
        if constexpr (ALIGN_EPI) { if (wr == 1) PG8_BAR; }
    }
    PG8_WAIT_V(0);
    if constexpr (!ALIGN_EPI) { if (wr == 0) PG8_BAR; }
    PG8_BAR;
    if constexpr (Epi::AFTER_DRAIN) { E.fused(acc, cur, wr, wc, fr, fq, lds, wid, lane); S.done(cur); }
#undef PG8_SA
#undef PG8_SB
#undef PG8_STAGE
#undef PG8_LDA
#undef PG8_LDB
#undef PG8_MMA
#undef PG8_WAIT_V
#undef PG8_WAIT_L
#undef PG8_BAR
#undef PG8_SCHED
}
}
#define GAS __attribute__((address_space(1)))
#define LAS __attribute__((address_space(3)))
typedef unsigned short bf16;
typedef unsigned v4u __attribute__((ext_vector_type(4)));
typedef float f32x4 __attribute__((ext_vector_type(4)));
typedef short bf16x8 __attribute__((ext_vector_type(8)));
typedef GAS unsigned gu32;
typedef GAS unsigned long long gu64;
#define RLX_AGENT __ATOMIC_RELAXED, __HIP_MEMORY_SCOPE_AGENT
#define LDS_WAIT() asm volatile("s_waitcnt lgkmcnt(0)" ::: "memory")
#define VM_WAIT() asm volatile("s_waitcnt vmcnt(0)" ::: "memory")
__device__ __forceinline__ unsigned long long rt() { return __builtin_amdgcn_s_memrealtime(); }
__device__ __forceinline__ unsigned f2bf(float f) { unsigned u = __builtin_bit_cast(unsigned, f); return (u + 0x7fffu + ((u >> 16) & 1u)) >> 16; }
__device__ __forceinline__ unsigned pk2(float lo, float hi) { return f2bf(lo) | (f2bf(hi) << 16); }

#define XB_TMO      128
#define XB_XCNT(j)  (256  + 64 * (j))
#define XB_XSUB(j)  (1280 + 64 * (j))
#define XB_XGEN(j)  (2304 + 64 * (j))
#define XB_TOP      3328
#define XB_TOPGEN   3392
#define XCD_BAR_WORDS 3456
#define XB_SPIN_CAP (1u << 18)

__device__ __forceinline__ unsigned xb_ld(unsigned* p)              { return __hip_atomic_load(p, __ATOMIC_RELAXED, __HIP_MEMORY_SCOPE_AGENT); }
__device__ __forceinline__ unsigned xb_add(unsigned* p, unsigned v) { return __hip_atomic_fetch_add(p, v, __ATOMIC_RELAXED, __HIP_MEMORY_SCOPE_AGENT); }
__device__ __forceinline__ unsigned xb_xcc_id() { return (unsigned)__builtin_amdgcn_s_getreg((3 << 11) | 20) & 0xFu; }
#define XB_SPIN(cond, bar) do { unsigned _sp = 0; while (cond) { __builtin_amdgcn_s_sleep(1); \
    if ((++_sp & 255u) == 0u) { if (xb_ld(&(bar)[XB_TMO])) break; if (_sp > XB_SPIN_CAP) { atomicAdd(&(bar)[XB_TMO], 1u); break; } } } } while (0)

struct XcdBarrier {
    unsigned* bar; unsigned x;
    volatile LAS unsigned* st;
};

__device__ __forceinline__ XcdBarrier xcd_barrier_post(unsigned* bar, volatile LAS unsigned* st) {
    XcdBarrier b; b.bar = bar; b.x = xb_xcc_id(); b.st = st;
    if (threadIdx.x == 0) (void)xb_add(&bar[XB_XCNT(b.x)], 1u);
    return b;
}
__device__ __forceinline__ void xcd_barrier_complete(unsigned* bar, unsigned x, unsigned& nloc, unsigned& nx) {
    const unsigned G = gridDim.x * gridDim.y * gridDim.z;
    unsigned sum, cnt, mine, sp = 0u;
    for (;;) {
        sum = 0u; cnt = 0u; mine = 0u;
#pragma unroll
        for (unsigned j = 0; j < 16; ++j) { const unsigned c = xb_ld(&bar[XB_XCNT(j)]); sum += c; cnt += (c > 0u) ? 1u : 0u; mine = (j == x) ? c : mine; }
        if (sum == G) break;
        __builtin_amdgcn_s_sleep(1);
        if ((++sp & 255u) == 0u) { if (xb_ld(&bar[XB_TMO])) break; if (sp > XB_SPIN_CAP) { atomicAdd(&bar[XB_TMO], 1u); break; } }
    }
    nloc = mine > 0u ? mine : 1u; nx = cnt > 0u ? cnt : 1u;
}

__device__ __forceinline__ void xcd_barrier(const XcdBarrier& b) {
    asm volatile("s_waitcnt vmcnt(0)" ::: "memory");
    __syncthreads();
    if (threadIdx.x == 0) {
        unsigned* bar = b.bar;
        __builtin_amdgcn_s_waitcnt(0);
        unsigned nloc = b.st[0], nx = b.st[1];
        if (nloc == 0u) { xcd_barrier_complete(bar, b.x, nloc, nx); b.st[0] = nloc; b.st[1] = nx; }
        const unsigned old = xb_add(&bar[XB_XSUB(b.x)], 1u);
        const unsigned gen = old / nloc;
        if (old + 1u == (gen + 1u) * nloc) {
            __builtin_amdgcn_fence(__ATOMIC_RELEASE, "agent");
            asm volatile("s_waitcnt vmcnt(0)" ::: "memory");
            const unsigned og = xb_add(&bar[XB_TOP], 1u);
            const unsigned tg = og / nx;
            if (og + 1u == (tg + 1u) * nx) xb_add(&bar[XB_TOPGEN], 1u);
            else XB_SPIN(xb_ld(&bar[XB_TOPGEN]) == tg, bar);
            __builtin_amdgcn_fence(__ATOMIC_ACQUIRE, "agent");
            xb_add(&bar[XB_XGEN(b.x)], 1u);
            asm volatile("s_waitcnt vmcnt(0)" ::: "memory");
        } else {
            XB_SPIN(xb_ld(&bar[XB_XGEN(b.x)]) == gen, bar);
            __builtin_amdgcn_fence(__ATOMIC_ACQUIRE, "agent");
            asm volatile("s_waitcnt vmcnt(0)" ::: "memory");
        }
    }
    __syncthreads();
}
constexpr int NWAVES = 8;
#ifndef MK_N_LAUNCHES
#define MK_N_LAUNCHES 1
#endif
constexpr int N_PHASES = 8;
constexpr int N_LAUNCHES = MK_N_LAUNCHES;

constexpr int BATCH = 2, T = 8192, D = 1024, M = BATCH * T;
constexpr int NIN = 3200, LDP = 3328;
constexpr int SEG0 = 1024;
constexpr int C_R = 0, C_WLO = 512, C_K = 576, C_V = 1088, C_ALO = 1600, C_Z = 1664;
constexpr float NORM_EPS = 1e-6f, GN_EPS = 64e-5f;

constexpr size_t MiB = 1u << 20;
constexpr size_t WS_CTL = 0, CTL_ZERO_BYTES = 1 * MiB;
constexpr size_t WS_W1T = 1 * MiB, WS_W2T = 8 * MiB, WS_XN = 10 * MiB, WS_P = 42 * MiB, WS_MIX = 146 * MiB, WS_BONUS = 27 * MiB;
constexpr size_t WS_WUPT = 7 * MiB + 512 * 1024, WS_AUPT = WS_WUPT + 65536, WS_YI = 10 * MiB, WS_WC = 26 * MiB, WS_PT = 178 * MiB, WS_QM = 210 * MiB, WS_PRM = 7 * MiB + 768 * 1024;
constexpr size_t WS_END = 256 * MiB;
constexpr int CW_BAR = 4096;
constexpr size_t CTL_MOD = 65536, CTL_ROWSS = 131072;

constexpr int RING_BYTES = 131072, LDSCTL_OFF = 163328 - 64, MISC_OFF = LDSCTL_OFF + 320, LDS_BYTES = 163840;

struct Frame {
    LAS unsigned char* lds;
    volatile LAS unsigned* MISC;
    int tid, lane, wave, vcu, G;
    const float *x, *c, *w_ada, *b_ada, *norm_g, *w_in, *pool_w, *pool_scale, *mu, *w0, *w_up, *a0, *a_up, *k_k, *k_a, *r_k, *ln_w, *ln_b, *w_out, *final_g;
    float* out;
    float *mod, *rowss, *bonus;
    bf16 *W1t, *W2t, *XN, *P, *MIX, *WUPT, *AUPT, *YI, *PT, *QM;
    float *WC, *PRM;
};

__device__ __forceinline__ float bf2f(unsigned short u) { return __builtin_bit_cast(float, (unsigned)u << 16); }
__device__ __forceinline__ float bflo(unsigned u) { return __builtin_bit_cast(float, u << 16); }
__device__ __forceinline__ float bfhi(unsigned u) { return __builtin_bit_cast(float, u & 0xffff0000u); }
__device__ __forceinline__ float sigmoidf_(float v) { return __builtin_amdgcn_rcpf(1.f + __expf(-v)); }
__device__ __forceinline__ float siluf_(float v) { return v * __builtin_amdgcn_rcpf(1.f + __expf(-v)); }
__device__ __forceinline__ float wave_sum(float v) {
#pragma unroll
    for (int o = 1; o < 64; o <<= 1) v += __shfl_xor(v, o);
    return v;
}

__device__ __forceinline__ void p0_transpose_item(const float* W, int K, int N, bf16* WT, LAS float* scr, int item, int lane) {
    const int nblk = N / 32, kb = item / nblk, nb = item % nblk, k0 = 64 * kb, n0 = 32 * nb;
#pragma unroll 8
    for (int i = 0; i < 32; ++i) { const int kk = 2 * i + (lane >> 5); scr[kk * 33 + (lane & 31)] = W[(size_t)(k0 + kk) * N + n0 + (lane & 31)]; }
    LDS_WAIT(); asm volatile("" ::: "memory");
    const int c = lane & 7;
#pragma unroll
    for (int j = 0; j < 4; ++j) { const int n = (lane >> 3) + 8 * j; const LAS float* s = scr + (8 * c) * 33 + n;
        v4u o; o.x = pk2(s[0 * 33], s[1 * 33]); o.y = pk2(s[2 * 33], s[3 * 33]); o.z = pk2(s[4 * 33], s[5 * 33]); o.w = pk2(s[6 * 33], s[7 * 33]);
        *(v4u*)(WT + (size_t)(n0 + n) * K + k0 + 8 * c) = o; }
    LDS_WAIT(); asm volatile("" ::: "memory");
}

__device__ __forceinline__ void p0_prologue(Frame& F) {
    LAS float* scr = (LAS float*)(F.lds + F.wave * 16384);
    const int gw = F.vcu * NWAVES + F.wave, NGW = F.G * NWAVES;
    constexpr int I_1 = (D / 64) * (NIN / 32), I_2 = (D / 64) * (D / 32), I_Z = (LDP - NIN) * D * 2 / 1024, I_L = 16;
    for (int it = gw; it < I_1 + I_2 + I_Z + 2 * I_L; it += NGW) {
        int r = it;
        if (r < I_1) { p0_transpose_item(F.w_in, D, NIN, F.W1t, scr, r, F.lane); continue; } r -= I_1;
        if (r < I_2) { p0_transpose_item(F.w_out, D, D, F.W2t, scr, r, F.lane); continue; } r -= I_2;
        if (r < I_Z) { *(v4u*)((unsigned char*)(F.W1t + (size_t)NIN * D) + (size_t)r * 1024 + F.lane * 16) = (v4u){0u, 0u, 0u, 0u}; continue; } r -= I_Z;
        if (r < I_L) { p0_transpose_item(F.w_up, 64, 512, F.WUPT, scr, r, F.lane); continue; } r -= I_L;
        p0_transpose_item(F.a_up, 64, 512, F.AUPT, scr, r, F.lane);
    }
    { const int gt = blockIdx.x * (NWAVES * 64) + F.tid;
      if (gt < 512) { float* o = F.PRM + gt * 8; o[0] = F.w0[gt]; o[1] = F.a0[gt]; o[2] = F.k_k[gt]; o[3] = F.k_a[gt]; o[4] = F.r_k[gt]; o[5] = F.mu[C_R + gt]; o[6] = F.mu[C_K + gt]; o[7] = F.mu[C_V + gt]; }
      else if (gt < 576) F.PRM[4096 + gt - 512] = F.mu[C_WLO + gt - 512];
      else if (gt < 640) F.PRM[4096 + gt - 512] = F.mu[C_ALO + gt - 576]; }
    __syncthreads();
    LAS float* red = (LAS float*)F.lds;
    for (int u = blockIdx.x; u < 192; u += F.G) {
        const int cg = u % 48, ks = u / 48, n = cg * 64 + F.lane, k0 = ks * 256 + F.wave * 32;
        float s0 = 0.f, s1 = 0.f;
#pragma unroll 8
        for (int kk = 0; kk < 32; ++kk) { const float wv = F.w_ada[(size_t)(k0 + kk) * 3072 + n]; s0 += F.c[k0 + kk] * wv; s1 += F.c[D + k0 + kk] * wv; }
        red[F.wave * 128 + F.lane] = s0; red[F.wave * 128 + 64 + F.lane] = s1;
        __syncthreads();
        if (F.wave < 2) { float s = 0.f;
#pragma unroll
            for (int w = 0; w < 8; ++w) s += red[w * 128 + F.wave * 64 + F.lane];
            if (ks == 0) s += F.b_ada[n];
            __hip_atomic_fetch_add(F.mod + F.wave * 3072 + n, s, __ATOMIC_RELAXED, __HIP_MEMORY_SCOPE_AGENT); }
        __syncthreads();
    }
}

__device__ __forceinline__ void p1_hrows(Frame& F) {
    const int gw = F.vcu * NWAVES + F.wave, NGW = F.G * NWAVES;
    for (int m = gw; m < M; m += NGW) {
        const int b = m >> 13;
        const f32x4* xr = (const f32x4*)(F.x + (size_t)m * D) + F.lane;
        f32x4 v[4]; float s = 0.f;
#pragma unroll
        for (int j = 0; j < 4; ++j) { v[j] = xr[64 * j]; s += (v[j].x * v[j].x + v[j].y * v[j].y) + (v[j].z * v[j].z + v[j].w * v[j].w); }
        const float rstd = 1.f / sqrtf(wave_sum(s) * (1.f / D) + NORM_EPS);
        unsigned long long* o8 = (unsigned long long*)(F.XN + (size_t)m * D) + F.lane;
#pragma unroll
        for (int j = 0; j < 4; ++j) {
            const f32x4 g = ((const f32x4*)F.norm_g)[F.lane + 64 * j];
            const f32x4 sh = ((const f32x4*)(F.mod + b * 3072))[F.lane + 64 * j];
            const f32x4 sc = ((const f32x4*)(F.mod + b * 3072 + 1024))[F.lane + 64 * j];
            const f32x4 h = v[j] * rstd * g * (sc + 1.f) + sh;
            o8[64 * j] = (unsigned long long)pk2(h.x, h.y) | ((unsigned long long)pk2(h.z, h.w) << 32);
        }
    }
}

template <int GI> __device__ __forceinline__ void pool_item(Frame& F, int tb, LAS float* scr) {
    constexpr int WIN = 2 << GI;
    const int t0 = tb * 8, pos0 = t0 & (T - 1), lane = F.lane;
    float u0[23], u1[23];
#pragma unroll
    for (int q = 0; q < 23; ++q) { const int pos = pos0 - 15 + q; unsigned w = 0u;
        if (q >= 16 - WIN) { if (pos >= 0) w = *(const unsigned*)(F.P + (size_t)(t0 - 15 + q) * LDP + GI * 128 + 2 * lane); }
        u0[q] = bflo(w); u1[q] = bfhi(w); }
#pragma unroll
    for (int tt = 0; tt < 8; ++tt) { float s0 = 0.f, s1 = 0.f;
#pragma unroll
        for (int q = 0; q < WIN; ++q) { s0 += u0[tt + 15 - q]; s1 += u1[tt + 15 - q]; }
        const int pos = pos0 + tt; const float cnt = (float)((pos + 1 < WIN) ? (pos + 1) : WIN);
        scr[(2 * lane) * 8 + tt] = s0 / cnt - u0[tt + 15]; scr[(2 * lane + 1) * 8 + tt] = s1 / cnt - u1[tt + 15]; }
    LDS_WAIT(); asm volatile("" ::: "memory");
    float acc0[8], acc1[8];
#pragma unroll
    for (int tt = 0; tt < 8; ++tt) { acc0[tt] = 0.f; acc1[tt] = 0.f; }
    const float* pw = F.pool_w + (size_t)GI * 128 * 128 + 2 * lane;
#pragma unroll 4
    for (int c = 0; c < 128; ++c) {
        const f32x4 da = *(const LAS f32x4*)(scr + c * 8), db = *(const LAS f32x4*)(scr + c * 8 + 4);
        const float w0 = pw[c * 128], w1 = pw[c * 128 + 1];
        acc0[0] += da.x * w0; acc1[0] += da.x * w1; acc0[1] += da.y * w0; acc1[1] += da.y * w1; acc0[2] += da.z * w0; acc1[2] += da.z * w1; acc0[3] += da.w * w0; acc1[3] += da.w * w1;
        acc0[4] += db.x * w0; acc1[4] += db.x * w1; acc0[5] += db.y * w0; acc1[5] += db.y * w1; acc0[6] += db.z * w0; acc1[6] += db.z * w1; acc0[7] += db.w * w0; acc1[7] += db.w * w1;
    }
    const float ps0 = F.pool_scale[GI * 128 + 2 * lane], ps1 = F.pool_scale[GI * 128 + 2 * lane + 1];
#pragma unroll
    for (int tt = 0; tt < 8; ++tt) {
        const unsigned zw = *(const unsigned*)(F.P + (size_t)(t0 + tt) * LDP + 512 + GI * 128 + 2 * lane);
        const float y0 = acc0[tt] * ps0 * siluf_(bflo(zw)), y1 = acc1[tt] * ps1 * siluf_(bfhi(zw));
        *(unsigned*)(F.MIX + (size_t)(t0 + tt) * D + GI * 128 + 2 * lane) = pk2(y0, y1);
    }
    LDS_WAIT(); asm volatile("" ::: "memory");
}

typedef float f32x16 __attribute__((ext_vector_type(16)));
typedef float f32x8 __attribute__((ext_vector_type(8)));
typedef __bf16 bf16x8v __attribute__((ext_vector_type(8)));
typedef __bf16 bf16x4v __attribute__((ext_vector_type(4)));
typedef unsigned u32x2 __attribute__((ext_vector_type(2)));
#define MFMA32(a, b, c) __builtin_amdgcn_mfma_f32_32x32x16_bf16((a), (b), (c), 0, 0, 0)
#define MFMA16(a, b, c) __builtin_amdgcn_mfma_f32_16x16x32_bf16((a), (b), (c), 0, 0, 0)

__device__ __forceinline__ bf16x8 cvt8(f32x8 v) { return __builtin_bit_cast(bf16x8, __builtin_convertvector(v, bf16x8v)); }
__device__ __forceinline__ u32x2 cvt4(f32x4 v) { return __builtin_bit_cast(u32x2, __builtin_convertvector(v, bf16x4v)); }
__device__ __forceinline__ bf16x8 pack_lo(const f32x16& x) { return cvt8(__builtin_shufflevector(x, x, 0, 1, 2, 3, 4, 5, 6, 7)); }
__device__ __forceinline__ bf16x8 pack_hi(const f32x16& x) { return cvt8(__builtin_shufflevector(x, x, 8, 9, 10, 11, 12, 13, 14, 15)); }
__device__ __forceinline__ f32x8 unpack8(bf16x8 p) { const v4u w = __builtin_bit_cast(v4u, p); return (f32x8){bflo(w.x), bfhi(w.x), bflo(w.y), bfhi(w.y), bflo(w.z), bfhi(w.z), bflo(w.w), bfhi(w.w)}; }
__device__ __forceinline__ f32x16 unpack16(bf16x8 lo, bf16x8 hi) { const f32x8 a = unpack8(lo), b = unpack8(hi); return __builtin_shufflevector(a, b, 0, 1, 2, 3, 4, 5, 6, 7, 8, 9, 10, 11, 12, 13, 14, 15); }
__device__ __forceinline__ f32x4 unpack4(u32x2 w) { return (f32x4){bflo(w.x), bfhi(w.x), bflo(w.y), bfhi(w.y)}; }
__device__ __forceinline__ float tanh_fast(float x) { return 1.f - 2.f * __builtin_amdgcn_rcpf(1.f + __expf(2.f * x)); }
#define CROW(reg, h) (((reg) & 3) + 8 * ((reg) >> 2) + 4 * (h))
__device__ __forceinline__ f32x16 zero16() { f32x16 z;
#pragma unroll
    for (int i = 0; i < 16; ++i) z[i] = 0.f; return z; }

struct PK2 { bf16x8 s[2]; };
__device__ __forceinline__ PK2 pack2(const f32x16& x) { PK2 p; p.s[0] = pack_lo(x); p.s[1] = pack_hi(x); return p; }

typedef __amdgpu_buffer_rsrc_t rsrc_t;
__device__ __forceinline__ rsrc_t mkrsrc(const void* p) { return __builtin_amdgcn_make_buffer_rsrc((void*)p, 0, 0x7fffffff, 0x00020000); }
#define BLD128(rs, voff, soff) __builtin_bit_cast(v4u, __builtin_amdgcn_raw_buffer_load_b128((rs), (voff), (soff), 0))
#define BLD64(rs, voff, soff) __builtin_bit_cast(u32x2, __builtin_amdgcn_raw_buffer_load_b64((rs), (voff), (soff), 0))
#define BLDF(rs, voff, soff) __builtin_bit_cast(float, __builtin_amdgcn_raw_buffer_load_b32((rs), (voff), (soff), 0))
#define BST64(v, rs, voff, soff) __builtin_amdgcn_raw_buffer_store_b64((v), (rs), (voff), (soff), 0)
#define BST32F(v, rs, voff, soff) __builtin_amdgcn_raw_buffer_store_b32(__builtin_bit_cast(unsigned, (float)(v)), (rs), (voff), (soff), 0)
#define BST16(v, rs, voff, soff) __builtin_amdgcn_raw_buffer_store_b16((unsigned short)(v), (rs), (voff), (soff), 0)

__device__ __forceinline__ void pass1_item(Frame& F, int it, LAS unsigned char* lds, LAS float* wct) {
    const int head = it & 7, cc = (it >> 3) & 255, b = it >> 11;
    int lane = F.lane, c, h;
#define REFRESH do { asm volatile("" : "+v"(lane)); c = lane & 31; h = lane >> 5; } while (0)
    REFRESH;
    const int row0 = b * T + 32 * cc, pos0 = 32 * cc;
    const rsrc_t rsP = mkrsrc(F.P + SEG0 + (size_t)(row0 - 1) * LDP);
    const rsrc_t rsW = mkrsrc(F.WUPT + (size_t)head * 64 * 64);
    const rsrc_t rsR = mkrsrc(F.PRM + (size_t)head * 64 * 8);
    const rsrc_t rsM = mkrsrc(F.PRM + 512 * 8);
    {
        const unsigned voff = (unsigned)((lane >> 3) * (LDP * 2) + (lane & 7) * 16);
        const bool z0 = (pos0 == 0) && ((lane >> 3) == 0);
        v4u w[3][5];
#pragma unroll
        for (int a = 0; a < 3; ++a)
#pragma unroll
            for (int j = 0; j < 5; ++j) w[a][j] = BLD128(rsP, voff, (head * 64 + (a == 0 ? C_R : (a == 1 ? C_K : C_V))) * 2 + j * 8 * (LDP * 2));
#pragma unroll
        for (int a = 0; a < 3; ++a) { if (z0) w[a][0] = (v4u){0u, 0u, 0u, 0u};
#pragma unroll
            for (int j = 0; j < 5; ++j) if (j < 4 || (lane >> 3) == 0) *(LAS v4u*)(lds + (a * 33 + j * 8 + (lane >> 3)) * 128 + (lane & 7) * 16) = w[a][j]; }
    }
    REFRESH;
    bf16x8 Aw[4], Aa[4];
    {
        const unsigned voff = (unsigned)(c * (LDP * 2) + h * 16);
        const bool zp = (pos0 + c) == 0;
#pragma unroll
        for (int ks = 0; ks < 4; ++ks) {
            const f32x8 cw = unpack8(__builtin_bit_cast(bf16x8, BLD128(rsP, voff, LDP * 2 + (C_WLO + 16 * ks) * 2))), ca = unpack8(__builtin_bit_cast(bf16x8, BLD128(rsP, voff, LDP * 2 + (C_ALO + 16 * ks) * 2)));
            f32x8 pw = unpack8(__builtin_bit_cast(bf16x8, BLD128(rsP, voff, (C_WLO + 16 * ks) * 2))), pa = unpack8(__builtin_bit_cast(bf16x8, BLD128(rsP, voff, (C_ALO + 16 * ks) * 2)));
            if (zp) { pw = pw * 0.f; pa = pa * 0.f; }
            const f32x4 mw0 = __builtin_bit_cast(f32x4, BLD128(rsM, (unsigned)(h * 32), ks * 64)), mw1 = __builtin_bit_cast(f32x4, BLD128(rsM, (unsigned)(h * 32), ks * 64 + 16));
            const f32x4 ma0 = __builtin_bit_cast(f32x4, BLD128(rsM, (unsigned)(h * 32), 256 + ks * 64)), ma1 = __builtin_bit_cast(f32x4, BLD128(rsM, (unsigned)(h * 32), 256 + ks * 64 + 16));
            const f32x8 muw = __builtin_shufflevector(mw0, mw1, 0, 1, 2, 3, 4, 5, 6, 7), mua = __builtin_shufflevector(ma0, ma1, 0, 1, 2, 3, 4, 5, 6, 7);
            f32x8 xw = cw + (pw - cw) * muw; const f32x8 xa = ca + (pa - ca) * mua;
#pragma unroll
            for (int j = 0; j < 8; ++j) xw[j] = tanh_fast(xw[j]);
            Aw[ks] = cvt8(xw); Aa[ks] = cvt8(xa);
        }
    }
    LDS_WAIT(); asm volatile("" ::: "memory");
    unsigned rbase = (unsigned)(size_t)lds + (unsigned)(c * 2);
#define TIE(dep) asm volatile("" : "+v"(rbase) : "v"(dep))
#define RAW(a, rowi, ch) bf2f(*(const LAS unsigned short*)(size_t)(rbase + (unsigned)(((a) * 33 + (rowi)) * 128 + ((ch) - c) * 2)))
    REFRESH;
    TIE(Aw[3][0]);
    float ss[16];
#pragma unroll
    for (int reg = 0; reg < 16; ++reg) ss[reg] = 0.f;
#pragma unroll
    for (int nb = 0; nb < 2; ++nb) {
        const int ch = 32 * nb + c;
        const f32x4 pa_ = __builtin_bit_cast(f32x4, BLD128(rsR, (unsigned)(c * 32), nb * 1024)), pb_ = __builtin_bit_cast(f32x4, BLD128(rsR, (unsigned)(c * 32), nb * 1024 + 16));
#pragma unroll
        for (int rho = 0; rho < 4; ++rho) {
            const int tb = 8 * rho + 4 * h;
            float prk = RAW(1, tb, ch);
#pragma unroll
            for (int b_ = 0; b_ < 4; ++b_) {
                const float ck = RAW(1, tb + b_ + 1, ch);
                const float kkr = (ck + (prk - ck) * pb_.z) * pa_.z; prk = ck;
                ss[4 * rho + b_] += kkr * kkr;
            }
        }
    }
#pragma unroll
    for (int reg = 0; reg < 16; ++reg) {
        float s = ss[reg];
#pragma unroll
        for (int o = 1; o < 32; o <<= 1) s += __shfl_xor(s, o);
        ss[reg] = __builtin_amdgcn_rsqf(fmaxf(s, 1e-24f));
    }
    if (c == 0) {
#pragma unroll
        for (int reg = 0; reg < 16; ++reg) *(LAS float*)(lds + 17152 + CROW(reg, h) * 4) = ss[reg];
    }
    LDS_WAIT(); asm volatile("" ::: "memory");
    REFRESH;
    PK2 at_pk[2], bt_pk[2], kt_pk[2], v_pk[2];
    float wcl[2], bon[2];
    bon[0] = 0.f; bon[1] = 0.f;
    const rsrc_t rsC = mkrsrc(F.WC + (size_t)it * 64);
#pragma unroll
    for (int nb = 0; nb < 2; ++nb) {
        REFRESH;
        const int ch = 32 * nb + c;
        rbase = (unsigned)(size_t)lds + (unsigned)(c * 2);
        unsigned wvo = (unsigned)(c * 128 + h * 16); asm volatile("" : "+v"(wvo) : "v"(rbase));
        f32x16 accw = zero16(), acca = zero16();
#pragma unroll
        for (int ks = 0; ks < 4; ++ks) {
            const bf16x8 Bw = __builtin_bit_cast(bf16x8, BLD128(rsW, wvo, nb * 4096 + ks * 32)), Ba = __builtin_bit_cast(bf16x8, BLD128(rsW, wvo, 65536 + nb * 4096 + ks * 32));
            accw = MFMA32(Aw[ks], Bw, accw); acca = MFMA32(Aa[ks], Ba, acca);
        }
        const f32x4 pa_ = __builtin_bit_cast(f32x4, BLD128(rsR, (unsigned)(c * 32), nb * 1024)), pb_ = __builtin_bit_cast(f32x4, BLD128(rsR, (unsigned)(c * 32), nb * 1024 + 16));
        const float p_w0 = pa_.x, p_a0 = pa_.y, p_kk = pa_.z, p_ka = pa_.w, p_rk = pb_.x, m_r = pb_.y, m_k = pb_.z, m_v = pb_.w;
        float ldv[16], av[16];
#pragma unroll
        for (int reg = 0; reg < 16; ++reg) { ldv[reg] = -0.60653066f * sigmoidf_(p_w0 + accw[reg]); av[reg] = sigmoidf_(p_a0 + acca[reg]); }
        float Gt[4], Gp[4];
#pragma unroll
        for (int rho = 0; rho < 4; ++rho) { Gt[rho] = (ldv[4 * rho] + ldv[4 * rho + 1]) + (ldv[4 * rho + 2] + ldv[4 * rho + 3]); Gp[rho] = __shfl_xor(Gt[rho], 32); }
        const float tot = ((Gt[0] + Gp[0]) + (Gt[1] + Gp[1])) + ((Gt[2] + Gp[2]) + (Gt[3] + Gp[3]));
        const float wc = __expf(tot); wcl[nb] = wc;
        if (h == 0) BST32F(wc, rsC, (unsigned)(c * 4), nb * 128);
        float off = 0.f;
#pragma unroll
        for (int sh = 0; sh < 2; ++sh) {
            float lw0[2];
#pragma unroll
            for (int r2 = 0; r2 < 2; ++r2) { const int rho = 2 * sh + r2; lw0[r2] = off + (h ? Gp[rho] : 0.f); off += Gt[rho] + Gp[rho]; }
            {
                TIE(lw0[1]);
                float at[8], bt[8];
#pragma unroll
                for (int r2 = 0; r2 < 2; ++r2) {
                    const int rho = 2 * sh + r2, tb = 8 * rho + 4 * h;
                    float prk = RAW(1, tb, ch), lw = lw0[r2], epm = __expf(lw);
                    const f32x4 iv4 = *(const LAS f32x4*)(size_t)(rbase - (unsigned)(c * 2) + 17152u + (unsigned)(tb * 4));
                    const float ivs[4] = {iv4.x, iv4.y, iv4.z, iv4.w};
#pragma unroll
                    for (int b_ = 0; b_ < 4; ++b_) {
                        const int reg = 4 * rho + b_, e8 = 4 * r2 + b_;
                        const float ck = RAW(1, tb + b_ + 1, ch);
                        const float k = ck + (prk - ck) * m_k; prk = ck;
                        lw += ldv[reg];
                        const float ep = __expf(lw), em = __builtin_amdgcn_rcpf(ep);
                        const float kk = k * p_kk * ivs[b_];
                        at[e8] = -kk * epm; bt[e8] = kk * av[reg] * em; epm = ep;
                    }
                }
#define V8(x) ((f32x8){x[0], x[1], x[2], x[3], x[4], x[5], x[6], x[7]})
                at_pk[nb].s[sh] = cvt8(V8(at)); bt_pk[nb].s[sh] = cvt8(V8(bt));
                asm volatile("" : "+v"(at_pk[nb].s[sh]), "+v"(bt_pk[nb].s[sh]));
            }
            {
                TIE(bt_pk[nb].s[sh][7]);
                float kt[8], vv[8], bp[8];
#pragma unroll
                for (int r2 = 0; r2 < 2; ++r2) {
                    const int rho = 2 * sh + r2, tb = 8 * rho + 4 * h;
                    float prr = RAW(0, tb, ch), prk = RAW(1, tb, ch), prv = RAW(2, tb, ch), lw = lw0[r2];
#pragma unroll
                    for (int b_ = 0; b_ < 4; ++b_) {
                        const int reg = 4 * rho + b_, e8 = 4 * r2 + b_;
                        const float cr = RAW(0, tb + b_ + 1, ch), ck = RAW(1, tb + b_ + 1, ch), cv = RAW(2, tb + b_ + 1, ch);
                        const float r = cr + (prr - cr) * m_r, k = ck + (prk - ck) * m_k, v = cv + (prv - cv) * m_v; prr = cr; prk = ck; prv = cv;
                        lw += ldv[reg];
                        const float ep = __expf(lw), em = __builtin_amdgcn_rcpf(ep);
                        const float km = k * (1.f + (av[reg] - 1.f) * p_ka);
                        bp[e8] = r * km * p_rk; kt[e8] = km * em; vv[e8] = v;
                        *(LAS unsigned short*)(lds + 12800 + (tb + b_) * 128 + ch * 2) = (unsigned short)f2bf(r * ep);
                    }
                }
                kt_pk[nb].s[sh] = cvt8(V8(kt)); v_pk[nb].s[sh] = cvt8(V8(vv));
                asm volatile("" : "+v"(kt_pk[nb].s[sh]), "+v"(v_pk[nb].s[sh]));
#undef V8
                float keep = 0.f;
#pragma unroll
                for (int e8 = 0; e8 < 8; ++e8) { float q = bp[e8];
#pragma unroll
                    for (int o = 1; o < 32; o <<= 1) q += __shfl_xor(q, o);
                    keep = (c == e8) ? q : keep; }
                bon[sh] += keep;
                TIE(keep);
            }
        }
    }
#undef RAW
#undef TIE
    REFRESH;
    if (c < 8) {
        const rsrc_t rsB = mkrsrc(F.bonus + (size_t)row0 * 8 + head);
        const unsigned vo = (unsigned)(((c & 3) + 8 * (c >> 2) + 4 * h) * 32);
        BST32F(bon[0], rsB, vo, 0); BST32F(bon[1], rsB, vo, 16 * 32);
    }
    LDS_WAIT(); asm volatile("" ::: "memory");
    REFRESH;
#pragma unroll
    for (int nb = 0; nb < 2; ++nb) {
#pragma unroll
        for (int reg = 0; reg < 16; ++reg) {
            const int o = CROW(reg, h) * 128 + (32 * nb + c) * 2;
            *(LAS unsigned short*)(lds + 0 * 4096 + o) = (unsigned short)at_pk[nb].s[reg >> 3][reg & 7];
            *(LAS unsigned short*)(lds + 1 * 4096 + o) = (unsigned short)bt_pk[nb].s[reg >> 3][reg & 7];
            *(LAS unsigned short*)(lds + 2 * 4096 + o) = (unsigned short)kt_pk[nb].s[reg >> 3][reg & 7];
        }
        if (h == 0) wct[32 * nb + c] = wcl[nb];
    }
    LDS_WAIT(); asm volatile("" ::: "memory");
    REFRESH;
#define FRAG(tile, ks) (*(const LAS bf16x8*)(lds + ((tile) < 3 ? (tile) * 4096 : 12800) + c * 128 + (16 * (ks) + 8 * h) * 2))
    f32x16 N = zero16(), Lm = zero16(), AakT = zero16(), ArbT = zero16(), ArkT = zero16();
#pragma unroll
    for (int ks = 0; ks < 4; ++ks) {
        const bf16x8 fa = FRAG(0, ks), fb = FRAG(1, ks), fk = FRAG(2, ks), fr = FRAG(3, ks);
        N = MFMA32(fb, fa, N); Lm = MFMA32(fa, fb, Lm); AakT = MFMA32(fk, fa, AakT); ArbT = MFMA32(fb, fr, ArbT); ArkT = MFMA32(fk, fr, ArkT);
    }
#undef FRAG
#pragma unroll
    for (int reg = 0; reg < 16; ++reg) { const int rw = CROW(reg, h);
        N[reg] = (rw < c) ? N[reg] : 0.f; Lm[reg] = (c < rw) ? Lm[reg] : 0.f; AakT[reg] = (rw < c) ? AakT[reg] : 0.f;
        ArbT[reg] = (rw <= c) ? ArbT[reg] : 0.f; ArkT[reg] = (rw <= c) ? ArkT[reg] : 0.f; }
    const PK2 AakT_pk = pack2(AakT), ArbT_pk = pack2(ArbT), ArkT_pk = pack2(ArkT);
    REFRESH;
    PK2 Xpk;
    {
        f32x16 X = N, Pw = N, PwT = Lm;
#pragma unroll
        for (int lvl = 0; lvl < 5; ++lvl) {
            const PK2 pa = pack2(PwT), pb = pack2(X);
            X = MFMA32(pa.s[0], pb.s[0], X); X = MFMA32(pa.s[1], pb.s[1], X);
            if (lvl < 4) { const PK2 pw = pack2(Pw);
                f32x16 n1 = zero16(), n2 = zero16();
                n1 = MFMA32(pa.s[0], pw.s[0], n1); n1 = MFMA32(pa.s[1], pw.s[1], n1);
                n2 = MFMA32(pw.s[0], pa.s[0], n2); n2 = MFMA32(pw.s[1], pa.s[1], n2);
                Pw = n1; PwT = n2; }
        }
        Xpk = pack2(X);
    }
    REFRESH;
    PK2 U_pk[2], Ab_pk[2];
#pragma unroll
    for (int ib = 0; ib < 2; ++ib) {
        f32x16 xm = zero16();
        xm = MFMA32(AakT_pk.s[0], v_pk[ib].s[0], xm); xm = MFMA32(AakT_pk.s[1], v_pk[ib].s[1], xm);
        const PK2 xp = pack2(xm);
        xm = MFMA32(Xpk.s[0], xp.s[0], xm); xm = MFMA32(Xpk.s[1], xp.s[1], xm);
        U_pk[ib] = pack2(xm);
    }
#pragma unroll
    for (int jb = 0; jb < 2; ++jb) {
        f32x16 ab = unpack16(at_pk[jb].s[0], at_pk[jb].s[1]);
        ab = MFMA32(Xpk.s[0], at_pk[jb].s[0], ab); ab = MFMA32(Xpk.s[1], at_pk[jb].s[1], ab);
        Ab_pk[jb] = pack2(ab);
    }
    REFRESH;
    const rsrc_t rsX = mkrsrc(F.MIX + (size_t)row0 * D + 512 + head * 64);
    const rsrc_t rsY = mkrsrc(F.YI + (size_t)it * 2048);
    const rsrc_t rsT = mkrsrc(F.PT + (size_t)it * 4096);
    const rsrc_t rsQ = mkrsrc(F.QM + (size_t)it * 4096);
#pragma unroll
    for (int jb = 0; jb < 2; ++jb) {
        f32x16 rh;
#pragma unroll
        for (int reg = 0; reg < 16; ++reg) rh[reg] = bf2f(*(const LAS unsigned short*)(lds + 12800 + CROW(reg, h) * 128 + (32 * jb + c) * 2));
        rh = MFMA32(ArbT_pk.s[0], Ab_pk[jb].s[0], rh); rh = MFMA32(ArbT_pk.s[1], Ab_pk[jb].s[1], rh);
        const PK2 rp = pack2(rh);
#pragma unroll
        for (int reg = 0; reg < 16; ++reg) BST16(rp.s[reg >> 3][reg & 7], rsX, (unsigned)(h * (4 * D * 2) + c * 2), CROW(reg, 0) * (D * 2) + jb * 64);
    }
#pragma unroll
    for (int ib = 0; ib < 2; ++ib) {
        f32x16 y = zero16();
        y = MFMA32(U_pk[ib].s[0], ArbT_pk.s[0], y); y = MFMA32(U_pk[ib].s[1], ArbT_pk.s[1], y);
        y = MFMA32(v_pk[ib].s[0], ArkT_pk.s[0], y); y = MFMA32(v_pk[ib].s[1], ArkT_pk.s[1], y);
        const PK2 yp = pack2(y);
        const v4u w0 = __builtin_bit_cast(v4u, yp.s[0]), w1 = __builtin_bit_cast(v4u, yp.s[1]);
        const unsigned vo = (unsigned)(c * 128 + h * 8);
        BST64(((u32x2){w0.x, w0.y}), rsY, vo, ib * 64); BST64(((u32x2){w0.z, w0.w}), rsY, vo, ib * 64 + 16); BST64(((u32x2){w1.x, w1.y}), rsY, vo, ib * 64 + 32); BST64(((u32x2){w1.z, w1.w}), rsY, vo, ib * 64 + 48);
    }
    REFRESH;
#pragma unroll
    for (int jb = 0; jb < 2; ++jb)
#pragma unroll
        for (int jb2 = 0; jb2 < 2; ++jb2) {
            f32x16 pm = zero16();
            pm = MFMA32(Ab_pk[jb].s[0], bt_pk[jb2].s[0], pm); pm = MFMA32(Ab_pk[jb].s[1], bt_pk[jb2].s[1], pm);
            const PK2 pp = pack2(pm * wcl[jb2]);
            const v4u w0 = __builtin_bit_cast(v4u, pp.s[0]), w1 = __builtin_bit_cast(v4u, pp.s[1]);
            const unsigned vo = (unsigned)(h * 1024 + c * 16); const int so = jb * 4096 + jb2 * 512;
            BST64(((u32x2){w0.x, w0.y}), rsT, vo, so);
            BST64(((u32x2){w0.z, w0.w}), rsT, vo, so + 2048);
            BST64(((u32x2){w1.x, w1.y}), rsT, vo, so + 8);
            BST64(((u32x2){w1.z, w1.w}), rsT, vo, so + 2048 + 8);
        }
#pragma unroll
    for (int jb2 = 0; jb2 < 2; ++jb2)
#pragma unroll
        for (int ib = 0; ib < 2; ++ib) {
            f32x16 q = zero16();
            q = MFMA32(bt_pk[jb2].s[0], U_pk[ib].s[0], q); q = MFMA32(bt_pk[jb2].s[1], U_pk[ib].s[1], q);
            q = MFMA32(kt_pk[jb2].s[0], v_pk[ib].s[0], q); q = MFMA32(kt_pk[jb2].s[1], v_pk[ib].s[1], q);
#pragma unroll
            for (int rho = 0; rho < 4; ++rho) { const f32x4 w4 = *(const LAS f32x4*)(wct + 32 * jb2 + 8 * rho + 4 * h); q[4 * rho] *= w4.x; q[4 * rho + 1] *= w4.y; q[4 * rho + 2] *= w4.z; q[4 * rho + 3] *= w4.w; }
            const PK2 qp = pack2(q);
            const v4u w0 = __builtin_bit_cast(v4u, qp.s[0]), w1 = __builtin_bit_cast(v4u, qp.s[1]);
            const unsigned vo = (unsigned)(c * 128 + h * 8); const int so = ib * 4096 + jb2 * 64;
            BST64(((u32x2){w0.x, w0.y}), rsQ, vo, so); BST64(((u32x2){w0.z, w0.w}), rsQ, vo, so + 16); BST64(((u32x2){w1.x, w1.y}), rsQ, vo, so + 32); BST64(((u32x2){w1.z, w1.w}), rsQ, vo, so + 48);
        }
    LDS_WAIT(); asm volatile("" ::: "memory");
#undef REFRESH
}

constexpr int P2_SLOT = 11264, P2_R = 13, P2_D = 11;
__device__ __forceinline__ void pass2_block(Frame& F, int b, int head, int iblk) {
    const int lane = F.lane, w = F.wave;
    LAS unsigned char* ring = F.lds;
    const char* ptg = (const char*)F.PT + (size_t)(b * 256 * 8 + head) * 8192;
    const char* qmg = (const char*)F.QM + (size_t)(b * 256 * 8 + head) * 8192 + iblk * 2048;
    const char* wcg = (const char*)F.WC + (size_t)(b * 256 * 8 + head) * 256;
#define P2_GLDS(g, l) __builtin_amdgcn_global_load_lds((const unsigned*)(g), (LAS unsigned*)(l), 16, 0, 0)
#define P2_ISSUE(n) do { const size_t o_ = (size_t)(n) * 65536; LAS unsigned char* sl_ = ring + ((n) % P2_R) * P2_SLOT; \
        if (w < 4) { P2_GLDS(ptg + o_ + (2 * w) * 1024 + lane * 16, sl_ + (2 * w) * 1024); P2_GLDS(ptg + o_ + (2 * w + 1) * 1024 + lane * 16, sl_ + (2 * w + 1) * 1024); } \
        else if (w < 6) P2_GLDS(qmg + o_ + (w - 4) * 1024 + lane * 16, sl_ + 8192 + (w - 4) * 1024); \
        else if (w == 6) P2_GLDS(wcg + (size_t)(n) * 2048 + (lane & 15) * 16, sl_ + 10240); } while (0)
    for (int n = 0; n < P2_D; ++n) P2_ISSUE(n);
    const int il = lane & 15, g = lane >> 4, i = 16 * iblk + il;
    f32x4 acc[4];
#pragma unroll
    for (int rt = 0; rt < 4; ++rt) acc[rt] = (f32x4){0.f, 0.f, 0.f, 0.f};
    for (int n = 0; n < 256; ++n) {
        if (n + P2_D < 256) {
            P2_ISSUE(n + P2_D);
            if (w < 4) asm volatile("s_waitcnt vmcnt(22)" ::: "memory"); else if (w < 7) asm volatile("s_waitcnt vmcnt(11)" ::: "memory");
        } else if (w < 7) asm volatile("s_waitcnt vmcnt(0)" ::: "memory");
        __builtin_amdgcn_s_barrier();
        if (w == 7) {
            const LAS unsigned char* sl = ring + (n % P2_R) * P2_SLOT;
            bf16x8 Af[4][2]; u32x2 qv[4]; f32x4 wc[4];
#pragma unroll
            for (int rt = 0; rt < 4; ++rt) {
#pragma unroll
                for (int ks = 0; ks < 2; ++ks) Af[rt][ks] = *(const LAS bf16x8*)(sl + ((ks * 4 + g) * 64 + 16 * rt + il) * 16);
                qv[rt] = *(const LAS u32x2*)(sl + 8192 + il * 128 + (16 * rt + 4 * g) * 2); wc[rt] = *(const LAS f32x4*)(sl + 10240 + (16 * rt + 4 * g) * 4);
            }
            u32x2 sv[4];
#pragma unroll
            for (int rt = 0; rt < 4; ++rt) sv[rt] = cvt4(acc[rt]);
            bf16x8 Bf[2];
            Bf[0] = __builtin_bit_cast(bf16x8, (v4u){sv[0].x, sv[0].y, sv[1].x, sv[1].y}); Bf[1] = __builtin_bit_cast(bf16x8, (v4u){sv[2].x, sv[2].y, sv[3].x, sv[3].y});
#pragma unroll
            for (int rt = 0; rt < 4; ++rt) {
                f32x4 a_ = wc[rt] * acc[rt] + unpack4(qv[rt]);
                a_ = MFMA16(Af[rt][0], Bf[0], a_); a_ = MFMA16(Af[rt][1], Bf[1], a_);
                acc[rt] = a_;
            }
            bf16* qm = F.QM + ((size_t)((b * 256 + n) * 8 + head)) * 4096 + (size_t)i * 64 + 4 * g;
#pragma unroll
            for (int rt = 0; rt < 4; ++rt) *(u32x2*)(qm + 16 * rt) = sv[rt];
        }
    }
    asm volatile("s_waitcnt vmcnt(0)" ::: "memory");
    __builtin_amdgcn_s_barrier();
#undef P2_ISSUE
#undef P2_GLDS
}

__device__ __forceinline__ void pass3_item(Frame& F, int it) {
    const int head = it & 7, cc = (it >> 3) & 255, b = it >> 11;
    const int lane = F.lane, c = lane & 31, h = lane >> 5;
    const int row0 = b * T + 32 * cc, pos0 = 32 * cc;
    const bf16* sm = F.QM + (size_t)it * 4096;
    bf16* mixrow = F.MIX + (size_t)(row0 + c) * D + 512 + head * 64;
    f32x16 y[2];
#pragma unroll
    for (int ib = 0; ib < 2; ++ib) {
        const bf16* yi = F.YI + (size_t)it * 2048 + c * 64 + 32 * ib + 4 * h;
        const f32x4 y0 = unpack4(*(const u32x2*)(yi)), y1 = unpack4(*(const u32x2*)(yi + 8)), y2 = unpack4(*(const u32x2*)(yi + 16)), y3 = unpack4(*(const u32x2*)(yi + 24));
        y[ib] = (f32x16){y0.x, y0.y, y0.z, y0.w, y1.x, y1.y, y1.z, y1.w, y2.x, y2.y, y2.z, y2.w, y3.x, y3.y, y3.z, y3.w};
    }
#pragma unroll
    for (int ks = 0; ks < 4; ++ks) {
        const bf16x8 Bf = *(const bf16x8*)(mixrow + 16 * ks + 8 * h);
#pragma unroll
        for (int ib = 0; ib < 2; ++ib) { const bf16x8 Af = *(const bf16x8*)(sm + (size_t)(32 * ib + c) * 64 + 16 * ks + 8 * h); y[ib] = MFMA32(Af, Bf, y[ib]); }
    }
    float s = 0.f;
#pragma unroll
    for (int reg = 0; reg < 16; ++reg) s += y[0][reg] + y[1][reg];
    s += __shfl_xor(s, 32);
    const float mean = s * (1.f / 64.f);
    float q = 0.f;
#pragma unroll
    for (int reg = 0; reg < 16; ++reg) { const float d0 = y[0][reg] - mean, d1 = y[1][reg] - mean; q += d0 * d0 + d1 * d1; }
    q += __shfl_xor(q, 32);
    const float rstd = 1.f / sqrtf(q * (1.f / 64.f) + GN_EPS);
    const float bo = F.bonus[(size_t)(row0 + c) * 8 + head];
    const bool hp = (pos0 + c) > 0;
    const bf16* prow = F.P + SEG0 + (size_t)(row0 + c) * LDP + head * 64;
#pragma unroll
    for (int ib = 0; ib < 2; ++ib)
#pragma unroll
        for (int rho = 0; rho < 4; ++rho) {
            const int i0 = 32 * ib + 8 * rho + 4 * h, gi = head * 64 + i0;
            const f32x4 cv = unpack4(*(const u32x2*)(prow + C_V + i0)), cz = unpack4(*(const u32x2*)(prow + C_Z + i0));
            f32x4 pv = cv * 0.f, pz = cz * 0.f;
            if (hp) { pv = unpack4(*(const u32x2*)(prow - LDP + C_V + i0)); pz = unpack4(*(const u32x2*)(prow - LDP + C_Z + i0)); }
            const f32x4 v = cv + (pv - cv) * *(const f32x4*)(F.mu + C_V + gi), z = cz + (pz - cz) * *(const f32x4*)(F.mu + C_Z + gi);
            const f32x4 lw = *(const f32x4*)(F.ln_w + gi), lb = *(const f32x4*)(F.ln_b + gi);
            const f32x4 yy = (f32x4){y[ib][4 * rho], y[ib][4 * rho + 1], y[ib][4 * rho + 2], y[ib][4 * rho + 3]};
            f32x4 o = (yy - mean) * rstd * lw + lb + bo * v;
            o.x *= siluf_(z.x); o.y *= siluf_(z.y); o.z *= siluf_(z.z); o.w *= siluf_(z.w);
            *(u32x2*)(mixrow + i0) = cvt4(o);
        }
}

__device__ __forceinline__ void p3_pass1(Frame& F) {
    const int gw = F.vcu * NWAVES + F.wave, NGW = F.G * NWAVES;
    for (int it = gw; it < 4096; it += NGW) pass1_item(F, it, F.lds + F.wave * 19456, (LAS float*)(F.lds + F.wave * 19456 + 16896));
}
__device__ __forceinline__ void p4_pass2_pool(Frame& F) {
    const int B = blockIdx.x;
    if (B < 64 && F.G >= 128) { const int x = B & 7, m = B >> 3, bh = x + 8 * (m >> 2), iblk = m & 3; pass2_block(F, bh >> 3, bh & 7, iblk); return; }
    LAS float* scr = (LAS float*)(F.lds + F.wave * 16384);
    const int gw = (B - 64) * NWAVES + F.wave, NGW = (F.G - 64) * NWAVES;
    for (int it = gw; it < 8192; it += NGW) {
        const int g = it & 3, tb = it >> 2;
        if (g == 0) pool_item<0>(F, tb, scr); else if (g == 1) pool_item<1>(F, tb, scr); else if (g == 2) pool_item<2>(F, tb, scr); else pool_item<3>(F, tb, scr);
    }
}
__device__ __forceinline__ void p5_pass3(Frame& F) {
    const int gw = F.vcu * NWAVES + F.wave, NGW = F.G * NWAVES;
    for (int it = gw; it < 4096; it += NGW) pass3_item(F, it);
}

struct EpiResGate {
    static constexpr bool PERM = false, AFTER_DRAIN = false;
    const float* x; const float* mod; float* out; float* rowss;
    __device__ __forceinline__ void operator()(const pg8::f32x4 (&acc)[2][2][4][2], const pg8::Unit& u, int wr, int wc, int fr, int fq) const {
        const int col0 = u.pn * 256 + wc * 32 + 4 * fq;
        const int b = (u.pm * 256) >> 13;
        const float* gate = mod + b * 3072 + 2048;
        f32x4 gv[2][2];
#pragma unroll
        for (int bj = 0; bj < 2; ++bj)
#pragma unroll
            for (int n = 0; n < 2; ++n) gv[bj][n] = *(const f32x4*)(gate + col0 + bj * 128 + n * 16);
#pragma unroll
        for (int ai = 0; ai < 2; ++ai)
#pragma unroll
            for (int m = 0; m < 4; ++m) { const int r = u.pm * 256 + ai * 128 + wr * 64 + m * 16 + fr; const size_t off = (size_t)r * D + col0; float ss = 0.f;
#pragma unroll
                for (int bj = 0; bj < 2; ++bj)
#pragma unroll
                    for (int n = 0; n < 2; ++n) { const f32x4 xv = *(const f32x4*)(x + off + bj * 128 + n * 16); const f32x4 o = xv + gv[bj][n] * acc[ai][bj][m][n];
                        *(f32x4*)(out + off + bj * 128 + n * 16) = o; ss += (o.x * o.x + o.y * o.y) + (o.z * o.z + o.w * o.w); }
                ss += __shfl_xor(ss, 16); ss += __shfl_xor(ss, 32);
                if (fq == 0) __hip_atomic_fetch_add(rowss + r, ss, __ATOMIC_RELAXED, __HIP_MEMORY_SCOPE_AGENT); }
    }
};

__device__ __forceinline__ void p7_final(Frame& F) {
    const int gw = F.vcu * NWAVES + F.wave, NGW = F.G * NWAVES;
    for (int m = gw; m < M; m += NGW) {
        const float rstd = 1.f / sqrtf(F.rowss[m] * (1.f / D) + NORM_EPS);
        f32x4* o = (f32x4*)(F.out + (size_t)m * D) + F.lane;
#pragma unroll
        for (int j = 0; j < 4; ++j) { const f32x4 g = ((const f32x4*)F.final_g)[F.lane + 64 * j]; o[64 * j] = o[64 * j] * rstd * g; }
    }
}

struct Args { const float* in[20]; float* out; unsigned char* ws; int ph_lo, ph_hi; };
__global__ void __launch_bounds__(NWAVES * 64, 2) fwd_kernel(Args args) {
    extern __shared__ __attribute__((aligned(16))) unsigned char lds[];
    Frame F;
    F.lds = (LAS unsigned char*)lds;
    F.MISC = (volatile LAS unsigned*)(F.lds + MISC_OFF);
    F.tid = threadIdx.x; F.lane = F.tid & 63; F.wave = __builtin_amdgcn_readfirstlane(F.tid >> 6);
    F.G = gridDim.x; { const int bx = blockIdx.x; F.vcu = (F.G % 8 == 0) ? (bx % 8) * (F.G / 8) + bx / 8 : bx; }
    unsigned char* ws = args.ws;
    F.x = args.in[0]; F.c = args.in[1]; F.w_ada = args.in[2]; F.b_ada = args.in[3]; F.norm_g = args.in[4]; F.w_in = args.in[5]; F.pool_w = args.in[6]; F.pool_scale = args.in[7];
    F.mu = args.in[8]; F.w0 = args.in[9]; F.w_up = args.in[10]; F.a0 = args.in[11]; F.a_up = args.in[12]; F.k_k = args.in[13]; F.k_a = args.in[14]; F.r_k = args.in[15];
    F.ln_w = args.in[16]; F.ln_b = args.in[17]; F.w_out = args.in[18]; F.final_g = args.in[19]; F.out = args.out;
    F.mod = (float*)(ws + WS_CTL + CTL_MOD); F.rowss = (float*)(ws + WS_CTL + CTL_ROWSS); F.bonus = (float*)(ws + WS_BONUS); F.WC = (float*)(ws + WS_WC); F.PRM = (float*)(ws + WS_PRM);
    F.W1t = (bf16*)(ws + WS_W1T); F.W2t = (bf16*)(ws + WS_W2T); F.XN = (bf16*)(ws + WS_XN); F.P = (bf16*)(ws + WS_P); F.MIX = (bf16*)(ws + WS_MIX);
    F.WUPT = (bf16*)(ws + WS_WUPT); F.AUPT = (bf16*)(ws + WS_AUPT); F.YI = (bf16*)(ws + WS_YI); F.PT = (bf16*)(ws + WS_PT); F.QM = (bf16*)(ws + WS_QM);
    for (int u = F.tid; u < (LDS_BYTES - LDSCTL_OFF) / 4; u += NWAVES * 64) ((LAS unsigned*)(F.lds + LDSCTL_OFF))[u] = 0u;
    __syncthreads();
    XcdBarrier bar; bar.bar = (unsigned*)(ws + WS_CTL) + CW_BAR; bar.x = 0; bar.st = nullptr;
    if (N_LAUNCHES == 1) bar = xcd_barrier_post((unsigned*)(ws + WS_CTL) + CW_BAR, F.MISC + 8);
    const int lo = args.ph_lo, hi = args.ph_hi;
#define IN(k) (lo <= (k) && (k) < hi)
#define SEAM(k) do { if (IN(k) && IN((k) + 1)) xcd_barrier(bar); } while (0)
    if (IN(0)) { p0_prologue(F); } SEAM(0);
    if (IN(1)) { p1_hrows(F); } SEAM(1);
    if (IN(2)) {
        pg8::Gemm g{F.XN, F.W1t, M, LDP, D}; pg8::StaticOrder S; S.init(M, LDP, F.G, (int)blockIdx.x);
        pg8::EpiBf16<0> E{F.P, LDP, nullptr, 0, 0, 1.f};
        pg8::gemm_phase<pg8::EpiBf16<0>, pg8::StaticOrder, true, true>(F.lds, g, S, E);
    } SEAM(2);
    if (IN(3)) { p3_pass1(F); } SEAM(3);
    if (IN(4)) { p4_pass2_pool(F); } SEAM(4);
    if (IN(5)) { p5_pass3(F); } SEAM(5);
    if (IN(6)) {
        pg8::Gemm g{F.MIX, F.W2t, M, D, D}; pg8::StaticOrder S; S.init(M, D, F.G, (int)blockIdx.x);
        EpiResGate E{F.x, F.mod, F.out, F.rowss};
        pg8::gemm_phase<EpiResGate, pg8::StaticOrder, true, true>(F.lds, g, S, E);
    } SEAM(6);
    if (IN(7)) { p7_final(F); }
#undef IN
#undef SEAM
}

extern "C" void kernel_launch(void* const* d_in, const int* in_sizes, int n_in, void* d_out, int out_size, void* d_ws, size_t ws_size, hipStream_t stream) {
    static int grid = 0;
    if (grid == 0) {
        if (n_in != 20 || in_sizes[0] != M * D || out_size != M * D || ws_size < WS_END) { fprintf(stderr, "kernel_launch: unexpected shapes (n_in %d, in0 %d, out %d, ws %zu); nothing launched\n", n_in, n_in > 0 ? in_sizes[0] : -1, out_size, ws_size); grid = -1; return; }
        int dev = 0, cus = 0, per_cu = 0;
        if (hipGetDevice(&dev) != hipSuccess || hipDeviceGetAttribute(&cus, hipDeviceAttributeMultiprocessorCount, dev) != hipSuccess) { grid = -1; return; }
        if (hipFuncSetAttribute((const void*)fwd_kernel, hipFuncAttributeMaxDynamicSharedMemorySize, LDS_BYTES) != hipSuccess) { fprintf(stderr, "kernel_launch: hipFuncSetAttribute failed\n"); grid = -1; return; }
        if (hipOccupancyMaxActiveBlocksPerMultiprocessor(&per_cu, (const void*)fwd_kernel, NWAVES * 64, LDS_BYTES) != hipSuccess || per_cu < 1) { fprintf(stderr, "kernel_launch: occupancy query reports %d blocks per CU\n", per_cu); grid = -1; (void)hipGetLastError(); return; }
        (void)hipGetLastError();
        grid = cus;
    }
    if (grid < 0) return;
    if (hipMemsetAsync((char*)d_ws + WS_CTL, 0, CTL_ZERO_BYTES, stream) != hipSuccess) return;
    Args a{};
    for (int i = 0; i < 20; ++i) a.in[i] = (const float*)d_in[i];
    a.out = (float*)d_out; a.ws = (unsigned char*)d_ws;
    if (N_LAUNCHES == 1) { a.ph_lo = 0; a.ph_hi = N_PHASES; hipLaunchKernelGGL(fwd_kernel, dim3(grid), dim3(NWAVES * 64), LDS_BYTES, stream, a); }
    else for (int li = 0; li < N_PHASES; ++li) { a.ph_lo = li; a.ph_hi = li + 1; hipLaunchKernelGGL(fwd_kernel, dim3(grid), dim3(NWAVES * 64), LDS_BYTES, stream, a); }
}
```

```cpp
#include <hip/hip_runtime.h>
#include <cstdio>
#include <cstdint>
namespace pg8 {
#define PG8_LAS __attribute__((address_space(3)))
typedef unsigned short bf16_t;
typedef short bf16x8 __attribute__((ext_vector_type(8)));
typedef float f32x4 __attribute__((ext_vector_type(4)));
typedef unsigned u32x4 __attribute__((ext_vector_type(4)));
constexpr int BM = 256, BK = 64, HALF = 128, HTB = HALF * BK * 2  , STAGE_BYTES = 8 * HTB, NXCD = 8, WGM = 8;

__host__ __device__ __forceinline__ int lds_byte(int r, int c) { const int st = (r >> 4) * 2 + (c >> 5), rr = r & 15, cc = c & 31, ob = rr * 64 + cc * 2; return st * 1024 + (ob ^ (((ob >> 9) & 1) << 5)); }
__host__ __device__ __forceinline__ void stage_rc(int b, int& R, int& C) { const int st = b / 1024, sb = b % 1024, swz = sb ^ (((sb >> 9) & 1) << 5); R = (st >> 1) * 16 + swz / 64; C = (st & 1) * 32 + (swz % 64) / 2; }
__host__ __device__ __forceinline__ int perm32(int rho) { const int n = rho >> 4, i = rho & 15; return 8 * (i >> 2) + 4 * n + (i & 3); }

struct Unit { int pm, pn; };
struct Gemm { const bf16_t* A; const bf16_t* Bt; int M, N, K; };

struct StaticOrder {
    int nM, nN, nwg, G, c;
    __host__ __device__ void init(int M, int N, int G_, int c_) { nM = M / BM; nN = N / BM; nwg = nM * nN; G = G_; c = c_; }
    __host__ __device__ bool next(int i, Unit& u) const {
        const long L = (long)i * G + c; if (L >= nwg) return false;
        int wgid = (int)L; { const int q = nwg / NXCD, r = nwg % NXCD, xcd = wgid % NXCD, off = wgid / NXCD; wgid = (xcd < r ? xcd * (q + 1) : r * (q + 1) + (xcd - r) * q) + off; }
        const int nig = WGM * nN, gid = wgid / nig, fm = gid * WGM, gsz = (nM - fm) < WGM ? (nM - fm) : WGM;
        u.pm = fm + ((wgid % nig) % gsz); u.pn = (wgid % nig) / gsz; return true;
    }
    __device__ __forceinline__ void a_ready(const Unit&) const {}
    __device__ __forceinline__ void done(const Unit&) const {}
};

__device__ __forceinline__ unsigned cvt_pk_bf16(float lo, float hi) { unsigned r; asm volatile("v_cvt_pk_bf16_f32 %0, %1, %2" : "=v"(r) : "v"(lo), "v"(hi)); return r; }
typedef float f32x2 __attribute__((ext_vector_type(2)));
__device__ __forceinline__ f32x2 gelu_pk(f32x2 v) {
    const f32x2 av = __builtin_elementwise_abs(v), d = av * 0.2316418882f + 1.0f;
    f32x2 t; t.x = __builtin_amdgcn_rcpf(d.x); t.y = __builtin_amdgcn_rcpf(d.y);
    f32x2 q = t * 0.5307027145f + (-0.7265760135f); q = q * t + 0.7107068705f; q = q * t + (-0.142248368f); q = q * t + 0.127414796f; q = q * t;
    const f32x2 s = (v * v) * (-0.72134752044f);
    f32x2 e; e.x = __builtin_amdgcn_exp2f(s.x); e.y = __builtin_amdgcn_exp2f(s.y);
    const f32x2 m = v * (q * e), r = v - m;
    f32x2 o; o.x = v.x < 0.f ? m.x : r.x; o.y = v.y < 0.f ? m.y : r.y; return o;
}

template <int ACT  > struct EpiBf16 {
    static constexpr bool PERM = true, AFTER_DRAIN = false; static_assert(ACT == 0 || ACT == 1, "EpiBf16: ACT is 0 (none) or 1 (gelu_pk)");
    bf16_t* O; int ldc; const float* bias; int split_cols; size_t split_stride; float scale0;
    __device__ __forceinline__ void operator()(const f32x4 (&acc)[2][2][4][2], const Unit& u, int wr, int wc, int fr, int fq) const {
        const int row0 = u.pm * BM + wr * 64 + fr; int colt = u.pn * BM; bf16_t* base = O;
        float sc = 1.f; if (split_cols) { const int t = colt / split_cols; base += (size_t)t * split_stride; colt -= t * split_cols; if (t == 0) sc = scale0; }
        const int col0 = colt + wc * 32 + 8 * fq, bcol0 = u.pn * BM + wc * 32 + 8 * fq;
        f32x4 bv[2][2];
#pragma unroll
        for (int bj = 0; bj < 2; ++bj)
#pragma unroll
            for (int n = 0; n < 2; ++n) bv[bj][n] = bias ? *(const f32x4*)(bias + bcol0 + bj * HALF + 4 * n) : (f32x4){0.f, 0.f, 0.f, 0.f};
#pragma unroll
        for (int ai = 0; ai < 2; ++ai)
#pragma unroll
            for (int m = 0; m < 4; ++m) { bf16_t* rowp = base + (size_t)(row0 + ai * HALF + m * 16) * ldc + col0;
#pragma unroll
                for (int bj = 0; bj < 2; ++bj) { f32x4 v0 = acc[ai][bj][m][0] + bv[bj][0], v1 = acc[ai][bj][m][1] + bv[bj][1];
                    if (ACT == 1) { f32x2 a = gelu_pk((f32x2){v0[0], v0[1]}), b = gelu_pk((f32x2){v0[2], v0[3]}), c = gelu_pk((f32x2){v1[0], v1[1]}), d = gelu_pk((f32x2){v1[2], v1[3]});
                        v0 = (f32x4){a.x, a.y, b.x, b.y}; v1 = (f32x4){c.x, c.y, d.x, d.y}; }
                    v0 = v0 * sc; v1 = v1 * sc; u32x4 w; w.x = cvt_pk_bf16(v0[0], v0[1]); w.y = cvt_pk_bf16(v0[2], v0[3]); w.z = cvt_pk_bf16(v1[0], v1[1]); w.w = cvt_pk_bf16(v1[2], v1[3]);
                    *(u32x4*)(rowp + bj * HALF) = w; } }
    }
};

struct PanelStats {
    unsigned* xbuf;
    unsigned* cnt;
    unsigned* tmo;
    int ntn; float eps;
    unsigned code;
    __device__ __forceinline__ bool run(const f32x4 (&v)[2][2][4][2], const Unit& u, int wr, int wc, int fr, int fq, PG8_LAS unsigned char* lds, int wid, int lane) const {
        typedef float f32x2v __attribute__((ext_vector_type(2)));
        PG8_LAS f32x2v* P = (PG8_LAS f32x2v*)lds;
        PG8_LAS f32x2v* S = (PG8_LAS f32x2v*)(lds + 8192);
        PG8_LAS unsigned* flag = (PG8_LAS unsigned*)(lds + 8192 + 2048);
#pragma unroll
        for (int ai = 0; ai < 2; ++ai)
#pragma unroll
            for (int m = 0; m < 4; ++m) {
                float s = 0.f;
#pragma unroll
                for (int bj = 0; bj < 2; ++bj)
#pragma unroll
                    for (int n = 0; n < 2; ++n) { const f32x4 x = v[ai][bj][m][n]; s += (x[0] + x[1]) + (x[2] + x[3]); }
                s += __shfl_xor(s, 16); s += __shfl_xor(s, 32);
                const float mw = s * (1.0f / 64.0f); float q = 0.f;
#pragma unroll
                for (int bj = 0; bj < 2; ++bj)
#pragma unroll
                    for (int n = 0; n < 2; ++n) { const f32x4 d = v[ai][bj][m][n] - mw; q += (d[0] * d[0] + d[1] * d[1]) + (d[2] * d[2] + d[3] * d[3]); }
                q += __shfl_xor(q, 16); q += __shfl_xor(q, 32);
                if (fq == 0) P[(ai * HALF + wr * 64 + m * 16 + fr) * 4 + wc] = (f32x2v){mw, q};
            }
        asm volatile("s_waitcnt lgkmcnt(0)" ::: "memory"); __builtin_amdgcn_s_barrier(); asm volatile("" ::: "memory");
#if defined(BROKEN_EXCHANGE_NO_WAIT)
#warning BROKEN CONTROL BUILD: the row-statistics exchange does not wait; results are wrong by design
        if (blockIdx.x >= 64) { const long long t0_ = clock64(); while (clock64() - t0_ < 60000) __builtin_amdgcn_s_sleep(8); }
#endif
        const int row = wid * 32 + (lane & 31);
        if (lane < 32) {
            const f32x2v a = P[row * 4 + 0], b = P[row * 4 + 1], c = P[row * 4 + 2], d = P[row * 4 + 3];
            const float mt = (a.x + b.x + c.x + d.x) * 0.25f;
            const float da = a.x - mt, db = b.x - mt, dc = c.x - mt, dd = d.x - mt;
            const float m2 = (a.y + b.y) + (c.y + d.y) + 64.0f * ((da * da + db * db) + (dc * dc + dd * dd));
            unsigned long long* slot = (unsigned long long*)xbuf + ((size_t)(u.pm * BM + row) * 4 + u.pn);
            __hip_atomic_store(slot, ((unsigned long long)__float_as_uint(m2) << 32) | __float_as_uint(mt), __ATOMIC_RELAXED, __HIP_MEMORY_SCOPE_AGENT);
        }
        asm volatile("s_waitcnt vmcnt(0)" ::: "memory");
        if (lane == 0) __hip_atomic_fetch_add(cnt + 64 * u.pm, 1u, __ATOMIC_RELAXED, __HIP_MEMORY_SCOPE_AGENT);
        if (wid == 0) {
            bool dead = false; const unsigned long long t0 = __builtin_amdgcn_s_memrealtime(); const unsigned want = 8u * (unsigned)ntn;
            for (;;) {
#if defined(BROKEN_EXCHANGE_NO_WAIT)
                break;
#endif
                if ((unsigned)__builtin_amdgcn_readfirstlane(__hip_atomic_load(cnt + 64 * u.pm, __ATOMIC_RELAXED, __HIP_MEMORY_SCOPE_AGENT)) >= want) break;
                if (__builtin_amdgcn_s_memrealtime() - t0 > 2000000ull) {
                    if (lane == 0) { unsigned expect = 0u; __hip_atomic_compare_exchange_strong(tmo + 1, &expect, code | (unsigned)(u.pm & 0xff), __ATOMIC_RELAXED, __ATOMIC_RELAXED, __HIP_MEMORY_SCOPE_AGENT);
                                     __hip_atomic_store(tmo, 1u, __ATOMIC_RELAXED, __HIP_MEMORY_SCOPE_AGENT); }
                    dead = true; break; }
                __builtin_amdgcn_s_sleep(2);
            }
            __builtin_amdgcn_fence(__ATOMIC_ACQUIRE, "agent");
            if (lane == 0) flag[0] = dead ? 1u : 0u;
        }
        asm volatile("s_waitcnt vmcnt(0) lgkmcnt(0)" ::: "memory"); __builtin_amdgcn_s_barrier(); asm volatile("" ::: "memory");
        const bool bad = flag[0] != 0u;
        if (lane < 32) {
            const unsigned long long* slot = (const unsigned long long*)xbuf + (size_t)(u.pm * BM + row) * 4; float mt[4], m2[4]; float ms = 0.f;
#pragma unroll
            for (int t = 0; t < 4; ++t) { if (t < ntn) { const unsigned long long w = __hip_atomic_load(slot + t, __ATOMIC_RELAXED, __HIP_MEMORY_SCOPE_AGENT); mt[t] = __uint_as_float((unsigned)w); m2[t] = __uint_as_float((unsigned)(w >> 32)); } else { mt[t] = 0.f; m2[t] = 0.f; } ms += mt[t]; }
            const float mean = ms / (float)ntn; float q = 0.f;
#pragma unroll
            for (int t = 0; t < 4; ++t) if (t < ntn) { const float dm = mt[t] - mean; q += m2[t] + 256.0f * dm * dm; }
            S[row] = (f32x2v){mean, 1.0f / sqrtf(q / (256.0f * (float)ntn) + eps)};
        }
        asm volatile("s_waitcnt lgkmcnt(0)" ::: "memory"); __builtin_amdgcn_s_barrier(); asm volatile("" ::: "memory");
        return bad;
    }
};
struct EpiLnRes {
    static constexpr bool PERM = false, AFTER_DRAIN = true;
    const float* base; float* out; int ldc; const float* bias; PanelStats st; unsigned poison;
    __device__ __forceinline__ void fused(f32x4 (&acc)[2][2][4][2], const Unit& u, int wr, int wc, int fr, int fq, PG8_LAS unsigned char* lds, int wid, int lane) const {
        typedef float f32x2v __attribute__((ext_vector_type(2)));
        const PG8_LAS f32x2v* S = (const PG8_LAS f32x2v*)(lds + 8192);
        const int col0 = u.pn * BM + wc * 32 + 4 * fq;
#pragma unroll
        for (int bj = 0; bj < 2; ++bj)
#pragma unroll
            for (int n = 0; n < 2; ++n) { const f32x4 bv = bias ? *(const f32x4*)(bias + col0 + bj * HALF + n * 16) : (f32x4){0.f, 0.f, 0.f, 0.f};
#pragma unroll
                for (int ai = 0; ai < 2; ++ai)
#pragma unroll
                    for (int m = 0; m < 4; ++m) acc[ai][bj][m][n] += bv; }
        f32x4 pre[4][2][2];
#pragma unroll
        for (int m = 0; m < 4; ++m) { const size_t off = (size_t)(u.pm * BM + wr * 64 + m * 16 + fr) * ldc + col0;
#pragma unroll
            for (int bj = 0; bj < 2; ++bj)
#pragma unroll
                for (int n = 0; n < 2; ++n) pre[m][bj][n] = *(const f32x4*)(base + off + bj * HALF + n * 16); }
        const bool bad = st.run(acc, u, wr, wc, fr, fq, lds, wid, lane) || poison != 0u;
        const float qnan = __builtin_nanf("");
#pragma unroll
        for (int ai = 0; ai < 2; ++ai)
#pragma unroll
            for (int m = 0; m < 4; ++m) { const int r = ai * HALF + wr * 64 + m * 16 + fr; const f32x2v sr = S[r]; const size_t off = (size_t)(u.pm * BM + r) * ldc + col0;
#pragma unroll
                for (int bj = 0; bj < 2; ++bj)
#pragma unroll
                    for (int n = 0; n < 2; ++n) { const f32x4 bs = ai == 0 ? pre[m][bj][n] : *(const f32x4*)(base + off + bj * HALF + n * 16); f32x4 o = bs + (acc[ai][bj][m][n] - sr.x) * sr.y;
                        if (bad) o = (f32x4){qnan, qnan, qnan, qnan}; *(f32x4*)(out + off + bj * HALF + n * 16) = o; }
                if (m & 1) asm volatile("" ::: "memory"); }
    }
};
struct EpiLnResLn {
    static constexpr bool PERM = false, AFTER_DRAIN = true;
    const float* base; float* out; bf16_t* xn; int ldc; const float* bias; PanelStats st1, st2; unsigned poison;
    __device__ __forceinline__ void fused(f32x4 (&acc)[2][2][4][2], const Unit& u, int wr, int wc, int fr, int fq, PG8_LAS unsigned char* lds, int wid, int lane) const {
        typedef float f32x2v __attribute__((ext_vector_type(2))); typedef unsigned u32x2v __attribute__((ext_vector_type(2)));
        const PG8_LAS f32x2v* S = (const PG8_LAS f32x2v*)(lds + 8192);
        const int col0 = u.pn * BM + wc * 32 + 4 * fq;
#pragma unroll
        for (int bj = 0; bj < 2; ++bj)
#pragma unroll
            for (int n = 0; n < 2; ++n) { const f32x4 bv = bias ? *(const f32x4*)(bias + col0 + bj * HALF + n * 16) : (f32x4){0.f, 0.f, 0.f, 0.f};
#pragma unroll
                for (int ai = 0; ai < 2; ++ai)
#pragma unroll
                    for (int m = 0; m < 4; ++m) acc[ai][bj][m][n] += bv; }
        bool bad = st1.run(acc, u, wr, wc, fr, fq, lds, wid, lane) || poison != 0u;
        const float qnan = __builtin_nanf("");
#pragma unroll
        for (int ai = 0; ai < 2; ++ai)
#pragma unroll
            for (int m = 0; m < 4; ++m) { const int r = ai * HALF + wr * 64 + m * 16 + fr; const f32x2v sr = S[r]; const size_t off = (size_t)(u.pm * BM + r) * ldc + col0;
#pragma unroll
                for (int bj = 0; bj < 2; ++bj)
#pragma unroll
                    for (int n = 0; n < 2; ++n) { const f32x4 bs = *(const f32x4*)(base + off + bj * HALF + n * 16); acc[ai][bj][m][n] = bs + (acc[ai][bj][m][n] - sr.x) * sr.y; }
                asm volatile("" : "+v"(acc[ai][0][m][0]), "+v"(acc[ai][0][m][1]), "+v"(acc[ai][1][m][0]), "+v"(acc[ai][1][m][1]));
                if (m & 1) asm volatile("" ::: "memory"); }
        const bool bad1 = bad;
        bad = st2.run(acc, u, wr, wc, fr, fq, lds, wid, lane) || bad;
#pragma unroll
        for (int ai = 0; ai < 2; ++ai)
#pragma unroll
            for (int m = 0; m < 4; ++m) { const int r = ai * HALF + wr * 64 + m * 16 + fr; const f32x2v sr = S[r]; const size_t off = (size_t)(u.pm * BM + r) * ldc + col0;
#pragma unroll
                for (int bj = 0; bj < 2; ++bj)
#pragma unroll
                    for (int n = 0; n < 2; ++n) { const f32x4 x1 = acc[ai][bj][m][n]; *(f32x4*)(out + off + bj * HALF + n * 16) = bad1 ? (f32x4){qnan, qnan, qnan, qnan} : x1;
                        const f32x4 o = (x1 - sr.x) * sr.y; u32x2v w; w.x = cvt_pk_bf16(o[0], o[1]); w.y = cvt_pk_bf16(o[2], o[3]);
                        if (bad) { w.x = 0x7fc07fc0u; w.y = 0x7fc07fc0u; } *(u32x2v*)(xn + off + bj * HALF + n * 16) = w; }
                asm volatile("" ::: "memory"); }
    }
};

template <class Epi, class Sched, bool ALIGN_EPI = false, bool SP2 = false>
__device__ __forceinline__ void gemm_phase(PG8_LAS unsigned char* lds, const Gemm g, const Sched& S, const Epi& E) {
    const int tid = threadIdx.x, wid = __builtin_amdgcn_readfirstlane(tid >> 6), lane = tid & 63, wr = wid >> 2, wc = wid & 3, fr = lane & 15, fq = lane >> 4;
    const int K = g.K, nt = K / BK;
    unsigned voffA[2], voffB[2];
#pragma unroll
    for (int i = 0; i < 2; ++i) { int R, C; stage_rc(tid * 16 + i * 8192, R, C); const int Rb = Epi::PERM ? ((R & ~31) + perm32(R & 31)) : R;
        voffA[i] = (unsigned)(R * K + C) * 2u; voffB[i] = (unsigned)(Rb * K + C) * 2u; }
    const size_t kstep = (size_t)(BK * 2);
    const size_t hstep = (size_t)HALF * K * 2;
    const size_t tstep = 2 * hstep;
    const unsigned ldsw = (unsigned)wid * 1024u;
    const int aoff = lds_byte(wr * 64 + fr, fq * 8), boff = lds_byte(wc * 32 + fr, fq * 8);
#define PG8_SA(b, h) (((b) * 2 + (h)) * HTB)
#define PG8_SB(b, h) ((4 + (b) * 2 + (h)) * HTB)
#define PG8_STAGE(bufoff, gbase, voff) do { _Pragma("unroll") for (int _i = 0; _i < 2; ++_i) \
        __builtin_amdgcn_global_load_lds((const unsigned*)((const char*)(gbase) + (voff)[_i]), (PG8_LAS unsigned*)(lds + (bufoff) + ldsw + _i * 8192), 16, 0, 0); } while (0)
#define PG8_LDA(dst, b, h) do { _Pragma("unroll") for (int m = 0; m < 4; ++m) _Pragma("unroll") for (int k = 0; k < 2; ++k) dst[m][k] = *(const PG8_LAS bf16x8*)(lds + PG8_SA(b, h) + aoff + m * 2048 + k * 1024); } while (0)
#define PG8_LDB(dst, b, h) do { _Pragma("unroll") for (int n = 0; n < 2; ++n) _Pragma("unroll") for (int k = 0; k < 2; ++k) dst[n][k] = *(const PG8_LAS bf16x8*)(lds + PG8_SB(b, h) + boff + n * 2048 + k * 1024); } while (0)
#define PG8_MMA(ai, bj, At, Bt) do { __builtin_amdgcn_s_setprio(1); _Pragma("unroll") for (int m = 0; m < 4; ++m) _Pragma("unroll") for (int n = 0; n < 2; ++n) _Pragma("unroll") for (int k = 0; k < 2; ++k) \
        acc[ai][bj][m][n] = __builtin_amdgcn_mfma_f32_16x16x32_bf16(Bt[n][k], At[m][k], acc[ai][bj][m][n], 0, 0, 0); __builtin_amdgcn_s_setprio(0); } while (0)
#define PG8_WAIT_V(n) asm volatile("s_waitcnt vmcnt(" #n ")" ::: "memory")
#define PG8_WAIT_L(n) asm volatile("s_waitcnt lgkmcnt(" #n ")" ::: "memory")
#define PG8_BAR __builtin_amdgcn_s_barrier()
#define PG8_SCHED __builtin_amdgcn_sched_barrier(0)
    Unit cur, nxt; int ui = 0;
    if (!S.next(0, cur)) return;
    f32x4 acc[2][2][4][2];
#pragma unroll
    for (int a = 0; a < 2; ++a)
#pragma unroll
        for (int b = 0; b < 2; ++b)
#pragma unroll
            for (int m = 0; m < 4; ++m)
#pragma unroll
                for (int n = 0; n < 2; ++n) acc[a][b][m][n] = (f32x4){0.f, 0.f, 0.f, 0.f};
    bf16x8 At[4][2], B0[2][2], B1[2][2];
    const char* cA = (const char*)g.A + (size_t)cur.pm * tstep; const char* cB = (const char*)g.Bt + (size_t)cur.pn * tstep;
    S.a_ready(cur);
    if constexpr (SP2) {
        PG8_STAGE(PG8_SB(0, 0), cB, voffB); PG8_STAGE(PG8_SB(0, 1), cB + hstep, voffB); PG8_STAGE(PG8_SA(0, 0), cA, voffA); PG8_STAGE(PG8_SA(0, 1), cA + hstep, voffA);
        if (wr == 1) PG8_BAR;
        PG8_WAIT_V(2); PG8_BAR;
        PG8_STAGE(PG8_SB(1, 0), cB + kstep, voffB); PG8_STAGE(PG8_SA(1, 0), cA + kstep, voffA); PG8_STAGE(PG8_SB(1, 1), cB + hstep + kstep, voffB);
        PG8_WAIT_V(6); PG8_BAR;
    } else {
        PG8_STAGE(PG8_SB(0, 0), cB, voffB); PG8_STAGE(PG8_SA(0, 0), cA, voffA); PG8_STAGE(PG8_SB(0, 1), cB + hstep, voffB); PG8_STAGE(PG8_SA(0, 1), cA + hstep, voffA);
        if (wr == 1) PG8_BAR;
        PG8_WAIT_V(4); PG8_BAR;
        PG8_STAGE(PG8_SB(1, 0), cB + kstep, voffB); PG8_STAGE(PG8_SA(1, 0), cA + kstep, voffA); PG8_STAGE(PG8_SB(1, 1), cB + hstep + kstep, voffB);
        PG8_WAIT_V(6); PG8_BAR;
    }
    for (;;) {
        const bool has_next = S.next(ui + 1, nxt);
        const char* nA = has_next ? (const char*)g.A + (size_t)nxt.pm * tstep : cA; const char* nB = has_next ? (const char*)g.Bt + (size_t)nxt.pn * tstep : cB;
        for (int t = 0; t < nt; t += 2) {
            const bool last = (t == nt - 2);
            const char* a1 = cA + (size_t)(t + 1) * kstep;
            const char* a2 = last ? nA : cA + (size_t)(t + 2) * kstep; const char* b2 = last ? nB : cB + (size_t)(t + 2) * kstep;
            const char* a3 = a2 + kstep; const char* b3 = b2 + kstep;
            if (last && has_next) S.a_ready(nxt);
            if constexpr (SP2) {
            PG8_LDB(B0, 0, 0); PG8_LDB(B1, 0, 1); PG8_SCHED; PG8_LDA(At, 0, 0); PG8_STAGE(PG8_SA(1, 1), a1 + hstep, voffA);
            PG8_WAIT_V(8); PG8_WAIT_L(0); PG8_BAR; PG8_MMA(0, 0, At, B0); PG8_MMA(0, 1, At, B1); PG8_BAR; PG8_SCHED;
            PG8_LDA(At, 0, 1); PG8_STAGE(PG8_SB(0, 0), b2, voffB); PG8_STAGE(PG8_SB(0, 1), b2 + hstep, voffB); PG8_STAGE(PG8_SA(0, 0), a2, voffA);
            PG8_WAIT_V(8); PG8_WAIT_L(0); PG8_BAR; PG8_MMA(1, 0, At, B0); PG8_MMA(1, 1, At, B1); PG8_BAR; PG8_SCHED;
            PG8_LDB(B0, 1, 0); PG8_LDB(B1, 1, 1); PG8_SCHED; PG8_LDA(At, 1, 0); PG8_STAGE(PG8_SA(0, 1), a2 + hstep, voffA);
            PG8_WAIT_V(8); PG8_WAIT_L(0); PG8_BAR; PG8_MMA(0, 0, At, B0); PG8_MMA(0, 1, At, B1); PG8_BAR; PG8_SCHED;
            PG8_LDA(At, 1, 1); PG8_STAGE(PG8_SB(1, 0), b3, voffB); PG8_STAGE(PG8_SB(1, 1), b3 + hstep, voffB); PG8_STAGE(PG8_SA(1, 0), a3, voffA);
            PG8_WAIT_V(8); PG8_WAIT_L(0); PG8_BAR; PG8_MMA(1, 0, At, B0); PG8_MMA(1, 1, At, B1); PG8_BAR; PG8_SCHED;
            } else {
            PG8_LDB(B0, 0, 0); PG8_SCHED; PG8_LDA(At, 0, 0); PG8_STAGE(PG8_SA(1, 1), a1 + hstep, voffA);
            PG8_WAIT_L(8); PG8_BAR; PG8_WAIT_L(0); PG8_MMA(0, 0, At, B0); PG8_BAR; PG8_SCHED;
            PG8_LDB(B1, 0, 1); PG8_STAGE(PG8_SB(0, 0), b2, voffB);
            PG8_BAR; PG8_WAIT_L(0); PG8_MMA(0, 1, At, B1); PG8_BAR;
            PG8_LDA(At, 0, 1); PG8_STAGE(PG8_SA(0, 0), a2, voffA);
            PG8_BAR; PG8_WAIT_L(0); PG8_MMA(1, 0, At, B0); PG8_BAR; PG8_SCHED;
            PG8_STAGE(PG8_SB(0, 1), b2 + hstep, voffB);
            PG8_WAIT_V(6); PG8_BAR; PG8_MMA(1, 1, At, B1); PG8_BAR;
            PG8_LDB(B0, 1, 0); PG8_SCHED; PG8_LDA(At, 1, 0); PG8_STAGE(PG8_SA(0, 1), a2 + hstep, voffA);
            PG8_WAIT_L(8); PG8_BAR; PG8_WAIT_L(0); PG8_MMA(0, 0, At, B0); PG8_BAR; PG8_SCHED;
            PG8_LDB(B1, 1, 1); PG8_STAGE(PG8_SB(1, 0), b3, voffB);
            PG8_BAR; PG8_WAIT_L(0); PG8_MMA(0, 1, At, B1); PG8_BAR;
            PG8_LDA(At, 1, 1); PG8_STAGE(PG8_SA(1, 0), a3, voffA);
            PG8_BAR; PG8_WAIT_L(0); PG8_MMA(1, 0, At, B0); PG8_BAR; PG8_SCHED;
            PG8_STAGE(PG8_SB(1, 1), b3 + hstep, voffB);
            PG8_WAIT_V(6); PG8_BAR; PG8_MMA(1, 1, At, B1); PG8_BAR;
            }
        }
        if constexpr (ALIGN_EPI) { if (wr == 0) PG8_BAR; }
        if constexpr (!Epi::AFTER_DRAIN) { E(acc, cur, wr, wc, fr, fq); S.done(cur); }
        if (!has_next) break;
#pragma unroll
        for (int a = 0; a < 2; ++a)
#pragma unroll
            for (int b = 0; b < 2; ++b)
#pragma unroll
                for (int m = 0; m < 4; ++m)
#pragma unroll
                    for (int n = 0; n < 2; ++n) acc[a][b][m][n] = (f32x4){0.f, 0.f, 0.f, 0.f};
        cur = nxt; cA = nA; cB = nB; ++ui;
        if constexpr (ALIGN_EPI) { if (wr == 1) PG8_BAR; }
    }
    PG8_WAIT_V(0);
    if constexpr (!ALIGN_EPI) { if (wr == 0) PG8_BAR; }
    PG8_BAR;
    if constexpr (Epi::AFTER_DRAIN) { E.fused(acc, cur, wr, wc, fr, fq, lds, wid, lane); S.done(cur); }
#undef PG8_SA
#undef PG8_SB
#undef PG8_STAGE
#undef PG8_LDA
#undef PG8_LDB
#undef PG8_MMA
#undef PG8_WAIT_V
#undef PG8_WAIT_L
#undef PG8_BAR
#undef PG8_SCHED
}
}
#define GAS __attribute__((address_space(1)))
#define LAS __attribute__((address_space(3)))
typedef unsigned short bf16;
typedef unsigned v4u __attribute__((ext_vector_type(4)));
typedef float f32x4 __attribute__((ext_vector_type(4)));
typedef short bf16x8 __attribute__((ext_vector_type(8)));
typedef GAS unsigned gu32;
typedef GAS unsigned long long gu64;
#define RLX_AGENT __ATOMIC_RELAXED, __HIP_MEMORY_SCOPE_AGENT
#define LDS_WAIT() asm volatile("s_waitcnt lgkmcnt(0)" ::: "memory")
#define VM_WAIT() asm volatile("s_waitcnt vmcnt(0)" ::: "memory")
__device__ __forceinline__ unsigned long long rt() { return __builtin_amdgcn_s_memrealtime(); }
__device__ __forceinline__ unsigned f2bf(float f) { unsigned u = __builtin_bit_cast(unsigned, f); return (u + 0x7fffu + ((u >> 16) & 1u)) >> 16; }
__device__ __forceinline__ unsigned pk2(float lo, float hi) { return f2bf(lo) | (f2bf(hi) << 16); }

#define XB_TMO      128
#define XB_XCNT(j)  (256  + 64 * (j))
#define XB_XSUB(j)  (1280 + 64 * (j))
#define XB_XGEN(j)  (2304 + 64 * (j))
#define XB_TOP      3328
#define XB_TOPGEN   3392
#define XCD_BAR_WORDS 3456
#define XB_SPIN_CAP (1u << 18)

__device__ __forceinline__ unsigned xb_ld(unsigned* p)              { return __hip_atomic_load(p, __ATOMIC_RELAXED, __HIP_MEMORY_SCOPE_AGENT); }
__device__ __forceinline__ unsigned xb_add(unsigned* p, unsigned v) { return __hip_atomic_fetch_add(p, v, __ATOMIC_RELAXED, __HIP_MEMORY_SCOPE_AGENT); }
__device__ __forceinline__ unsigned xb_xcc_id() { return (unsigned)__builtin_amdgcn_s_getreg((3 << 11) | 20) & 0xFu; }
#define XB_SPIN(cond, bar) do { unsigned _sp = 0; while (cond) { __builtin_amdgcn_s_sleep(1); \
    if ((++_sp & 255u) == 0u) { if (xb_ld(&(bar)[XB_TMO])) break; if (_sp > XB_SPIN_CAP) { atomicAdd(&(bar)[XB_TMO], 1u); break; } } } } while (0)

struct XcdBarrier {
    unsigned* bar; unsigned x;
    volatile LAS unsigned* st;
};

__device__ __forceinline__ XcdBarrier xcd_barrier_post(unsigned* bar, volatile LAS unsigned* st) {
    XcdBarrier b; b.bar = bar; b.x = xb_xcc_id(); b.st = st;
    if (threadIdx.x == 0) (void)xb_add(&bar[XB_XCNT(b.x)], 1u);
    return b;
}
__device__ __forceinline__ void xcd_barrier_complete(unsigned* bar, unsigned x, unsigned& nloc, unsigned& nx) {
    const unsigned G = gridDim.x * gridDim.y * gridDim.z;
    unsigned sum, cnt, mine, sp = 0u;
    for (;;) {
        sum = 0u; cnt = 0u; mine = 0u;
#pragma unroll
        for (unsigned j = 0; j < 16; ++j) { const unsigned c = xb_ld(&bar[XB_XCNT(j)]); sum += c; cnt += (c > 0u) ? 1u : 0u; mine = (j == x) ? c : mine; }
        if (sum == G) break;
        __builtin_amdgcn_s_sleep(1);
        if ((++sp & 255u) == 0u) { if (xb_ld(&bar[XB_TMO])) break; if (sp > XB_SPIN_CAP) { atomicAdd(&bar[XB_TMO], 1u); break; } }
    }
    nloc = mine > 0u ? mine : 1u; nx = cnt > 0u ? cnt : 1u;
}

__device__ __forceinline__ void xcd_barrier(const XcdBarrier& b) {
    asm volatile("s_waitcnt vmcnt(0)" ::: "memory");
    __syncthreads();
    if (threadIdx.x == 0) {
        unsigned* bar = b.bar;
        __builtin_amdgcn_s_waitcnt(0);
        unsigned nloc = b.st[0], nx = b.st[1];
        if (nloc == 0u) { xcd_barrier_complete(bar, b.x, nloc, nx); b.st[0] = nloc; b.st[1] = nx; }
        const unsigned old = xb_add(&bar[XB_XSUB(b.x)], 1u);
        const unsigned gen = old / nloc;
        if (old + 1u == (gen + 1u) * nloc) {
            __builtin_amdgcn_fence(__ATOMIC_RELEASE, "agent");
            asm volatile("s_waitcnt vmcnt(0)" ::: "memory");
            const unsigned og = xb_add(&bar[XB_TOP], 1u);
            const unsigned tg = og / nx;
            if (og + 1u == (tg + 1u) * nx) xb_add(&bar[XB_TOPGEN], 1u);
            else XB_SPIN(xb_ld(&bar[XB_TOPGEN]) == tg, bar);
            __builtin_amdgcn_fence(__ATOMIC_ACQUIRE, "agent");
            xb_add(&bar[XB_XGEN(b.x)], 1u);
            asm volatile("s_waitcnt vmcnt(0)" ::: "memory");
        } else {
            XB_SPIN(xb_ld(&bar[XB_XGEN(b.x)]) == gen, bar);
            __builtin_amdgcn_fence(__ATOMIC_ACQUIRE, "agent");
            asm volatile("s_waitcnt vmcnt(0)" ::: "memory");
        }
    }
    __syncthreads();
}
constexpr int NWAVES = 8;
#ifndef MK_N_LAUNCHES
#define MK_N_LAUNCHES 1
#endif
constexpr int N_PHASES = 8;
constexpr int N_LAUNCHES = MK_N_LAUNCHES;

constexpr int BATCH = 2, T = 8192, D = 1024, M = BATCH * T;
constexpr int NIN = 3200, LDP = 3328;
constexpr int SEG0 = 1024;
constexpr int C_R = 0, C_WLO = 512, C_K = 576, C_V = 1088, C_ALO = 1600, C_Z = 1664;
constexpr float NORM_EPS = 1e-6f, GN_EPS = 64e-5f;

constexpr size_t MiB = 1u << 20;
constexpr size_t WS_CTL = 0, CTL_ZERO_BYTES = 1 * MiB;
constexpr size_t WS_W1T = 1 * MiB, WS_W2T = 8 * MiB, WS_XN = 10 * MiB, WS_P = 42 * MiB, WS_MIX = 146 * MiB, WS_BONUS = 27 * MiB;
constexpr size_t WS_WUPT = 7 * MiB + 512 * 1024, WS_AUPT = WS_WUPT + 65536, WS_YI = 10 * MiB, WS_WC = 26 * MiB, WS_PT = 178 * MiB, WS_QM = 210 * MiB, WS_PRM = 7 * MiB + 768 * 1024, WS_POOLWT = 7 * MiB + 832 * 1024;
constexpr size_t WS_END = 256 * MiB;
constexpr int CW_BAR = 4096;
constexpr size_t CTL_MOD = 65536, CTL_ROWSS = 131072;

constexpr int RING_BYTES = 131072, LDSCTL_OFF = 163328 - 64, MISC_OFF = LDSCTL_OFF + 320, LDS_BYTES = 163840;

struct Frame {
    LAS unsigned char* lds;
    volatile LAS unsigned* MISC;
    int tid, lane, wave, vcu, G;
    const float *x, *c, *w_ada, *b_ada, *norm_g, *w_in, *pool_w, *pool_scale, *mu, *w0, *w_up, *a0, *a_up, *k_k, *k_a, *r_k, *ln_w, *ln_b, *w_out, *final_g;
    float* out;
    float *mod, *rowss, *bonus;
    bf16 *W1t, *W2t, *XN, *P, *MIX, *WUPT, *AUPT, *YI, *PT, *QM, *POOLWT;
    float *WC, *PRM;
};

__device__ __forceinline__ float bf2f(unsigned short u) { return __builtin_bit_cast(float, (unsigned)u << 16); }
__device__ __forceinline__ float bflo(unsigned u) { return __builtin_bit_cast(float, u << 16); }
__device__ __forceinline__ float bfhi(unsigned u) { return __builtin_bit_cast(float, u & 0xffff0000u); }
__device__ __forceinline__ float sigmoidf_(float v) { return __builtin_amdgcn_rcpf(1.f + __expf(-v)); }
__device__ __forceinline__ float siluf_(float v) { return v * __builtin_amdgcn_rcpf(1.f + __expf(-v)); }
__device__ __forceinline__ float wave_sum(float v) {
#pragma unroll
    for (int o = 1; o < 64; o <<= 1) v += __shfl_xor(v, o);
    return v;
}

__device__ __forceinline__ void p0_transpose_item(const float* W, int K, int N, bf16* WT, LAS float* scr, int item, int lane) {
    const int nblk = N / 32, kb = item / nblk, nb = item % nblk, k0 = 64 * kb, n0 = 32 * nb;
#pragma unroll 8
    for (int i = 0; i < 32; ++i) { const int kk = 2 * i + (lane >> 5); scr[kk * 33 + (lane & 31)] = W[(size_t)(k0 + kk) * N + n0 + (lane & 31)]; }
    LDS_WAIT(); asm volatile("" ::: "memory");
    const int c = lane & 7;
#pragma unroll
    for (int j = 0; j < 4; ++j) { const int n = (lane >> 3) + 8 * j; const LAS float* s = scr + (8 * c) * 33 + n;
        v4u o; o.x = pk2(s[0 * 33], s[1 * 33]); o.y = pk2(s[2 * 33], s[3 * 33]); o.z = pk2(s[4 * 33], s[5 * 33]); o.w = pk2(s[6 * 33], s[7 * 33]);
        *(v4u*)(WT + (size_t)(n0 + n) * K + k0 + 8 * c) = o; }
    LDS_WAIT(); asm volatile("" ::: "memory");
}

__device__ __forceinline__ void p0_prologue(Frame& F) {
    LAS float* scr = (LAS float*)(F.lds + F.wave * 16384);
    const int gw = F.vcu * NWAVES + F.wave, NGW = F.G * NWAVES;
    constexpr int I_1 = (D / 64) * (NIN / 32), I_2 = (D / 64) * (D / 32), I_Z = (LDP - NIN) * D * 2 / 1024, I_L = 16, I_P = 32;
    for (int it = gw; it < I_1 + I_2 + I_Z + 2 * I_L + I_P; it += NGW) {
        int r = it;
        if (r < I_1) { p0_transpose_item(F.w_in, D, NIN, F.W1t, scr, r, F.lane); continue; } r -= I_1;
        if (r < I_2) { p0_transpose_item(F.w_out, D, D, F.W2t, scr, r, F.lane); continue; } r -= I_2;
        if (r < I_Z) { *(v4u*)((unsigned char*)(F.W1t + (size_t)NIN * D) + (size_t)r * 1024 + F.lane * 16) = (v4u){0u, 0u, 0u, 0u}; continue; } r -= I_Z;
        if (r < I_L) { p0_transpose_item(F.w_up, 64, 512, F.WUPT, scr, r, F.lane); continue; } r -= I_L;
        if (r < I_L) { p0_transpose_item(F.a_up, 64, 512, F.AUPT, scr, r, F.lane); continue; } r -= I_L;
        p0_transpose_item(F.pool_w + (size_t)(r >> 3) * 16384, 128, 128, F.POOLWT + (size_t)(r >> 3) * 16384, scr, r & 7, F.lane);
    }
    { const int gt = blockIdx.x * (NWAVES * 64) + F.tid;
      if (gt < 512) { float* o = F.PRM + gt * 8; o[0] = F.w0[gt]; o[1] = F.a0[gt]; o[2] = F.k_k[gt]; o[3] = F.k_a[gt]; o[4] = F.r_k[gt]; o[5] = F.mu[C_R + gt]; o[6] = F.mu[C_K + gt]; o[7] = F.mu[C_V + gt]; }
      else if (gt < 576) F.PRM[4096 + gt - 512] = F.mu[C_WLO + gt - 512];
      else if (gt < 640) F.PRM[4096 + gt - 512] = F.mu[C_ALO + gt - 576]; }
    __syncthreads();
    LAS float* red = (LAS float*)F.lds;
    for (int u = blockIdx.x; u < 192; u += F.G) {
        const int cg = u % 48, ks = u / 48, n = cg * 64 + F.lane, k0 = ks * 256 + F.wave * 32;
        float s0 = 0.f, s1 = 0.f;
#pragma unroll 8
        for (int kk = 0; kk < 32; ++kk) { const float wv = F.w_ada[(size_t)(k0 + kk) * 3072 + n]; s0 += F.c[k0 + kk] * wv; s1 += F.c[D + k0 + kk] * wv; }
        red[F.wave * 128 + F.lane] = s0; red[F.wave * 128 + 64 + F.lane] = s1;
        __syncthreads();
        if (F.wave < 2) { float s = 0.f;
#pragma unroll
            for (int w = 0; w < 8; ++w) s += red[w * 128 + F.wave * 64 + F.lane];
            if (ks == 0) s += F.b_ada[n];
            __hip_atomic_fetch_add(F.mod + F.wave * 3072 + n, s, __ATOMIC_RELAXED, __HIP_MEMORY_SCOPE_AGENT); }
        __syncthreads();
    }
}

__device__ __forceinline__ void p1_hrows(Frame& F) {
    const int gw = F.vcu * NWAVES + F.wave, NGW = F.G * NWAVES;
    for (int m = gw; m < M; m += NGW) {
        const int b = m >> 13;
        const f32x4* xr = (const f32x4*)(F.x + (size_t)m * D) + F.lane;
        f32x4 v[4]; float s = 0.f;
#pragma unroll
        for (int j = 0; j < 4; ++j) { v[j] = xr[64 * j]; s += (v[j].x * v[j].x + v[j].y * v[j].y) + (v[j].z * v[j].z + v[j].w * v[j].w); }
        const float rstd = 1.f / sqrtf(wave_sum(s) * (1.f / D) + NORM_EPS);
        unsigned long long* o8 = (unsigned long long*)(F.XN + (size_t)m * D) + F.lane;
#pragma unroll
        for (int j = 0; j < 4; ++j) {
            const f32x4 g = ((const f32x4*)F.norm_g)[F.lane + 64 * j];
            const f32x4 sh = ((const f32x4*)(F.mod + b * 3072))[F.lane + 64 * j];
            const f32x4 sc = ((const f32x4*)(F.mod + b * 3072 + 1024))[F.lane + 64 * j];
            const f32x4 h = v[j] * rstd * g * (sc + 1.f) + sh;
            o8[64 * j] = (unsigned long long)pk2(h.x, h.y) | ((unsigned long long)pk2(h.z, h.w) << 32);
        }
    }
}

template <int GI> __device__ __forceinline__ void pool_item(Frame& F, int tb, LAS float* scr) {
    constexpr int WIN = 2 << GI;
    const int t0 = tb * 8, pos0 = t0 & (T - 1), lane = F.lane;
    float u0[23], u1[23];
#pragma unroll
    for (int q = 0; q < 23; ++q) { const int pos = pos0 - 15 + q; unsigned w = 0u;
        if (q >= 16 - WIN) { if (pos >= 0) w = *(const unsigned*)(F.P + (size_t)(t0 - 15 + q) * LDP + GI * 128 + 2 * lane); }
        u0[q] = bflo(w); u1[q] = bfhi(w); }
#pragma unroll
    for (int tt = 0; tt < 8; ++tt) { float s0 = 0.f, s1 = 0.f;
#pragma unroll
        for (int q = 0; q < WIN; ++q) { s0 += u0[tt + 15 - q]; s1 += u1[tt + 15 - q]; }
        const int pos = pos0 + tt; const float cnt = (float)((pos + 1 < WIN) ? (pos + 1) : WIN);
        scr[(2 * lane) * 8 + tt] = s0 / cnt - u0[tt + 15]; scr[(2 * lane + 1) * 8 + tt] = s1 / cnt - u1[tt + 15]; }
    LDS_WAIT(); asm volatile("" ::: "memory");
    float acc0[8], acc1[8];
#pragma unroll
    for (int tt = 0; tt < 8; ++tt) { acc0[tt] = 0.f; acc1[tt] = 0.f; }
    const float* pw = F.pool_w + (size_t)GI * 128 * 128 + 2 * lane;
#pragma unroll 4
    for (int c = 0; c < 128; ++c) {
        const f32x4 da = *(const LAS f32x4*)(scr + c * 8), db = *(const LAS f32x4*)(scr + c * 8 + 4);
        const float w0 = pw[c * 128], w1 = pw[c * 128 + 1];
        acc0[0] += da.x * w0; acc1[0] += da.x * w1; acc0[1] += da.y * w0; acc1[1] += da.y * w1; acc0[2] += da.z * w0; acc1[2] += da.z * w1; acc0[3] += da.w * w0; acc1[3] += da.w * w1;
        acc0[4] += db.x * w0; acc1[4] += db.x * w1; acc0[5] += db.y * w0; acc1[5] += db.y * w1; acc0[6] += db.z * w0; acc1[6] += db.z * w1; acc0[7] += db.w * w0; acc1[7] += db.w * w1;
    }
    const float ps0 = F.pool_scale[GI * 128 + 2 * lane], ps1 = F.pool_scale[GI * 128 + 2 * lane + 1];
#pragma unroll
    for (int tt = 0; tt < 8; ++tt) {
        const unsigned zw = *(const unsigned*)(F.P + (size_t)(t0 + tt) * LDP + 512 + GI * 128 + 2 * lane);
        const float y0 = acc0[tt] * ps0 * siluf_(bflo(zw)), y1 = acc1[tt] * ps1 * siluf_(bfhi(zw));
        *(unsigned*)(F.MIX + (size_t)(t0 + tt) * D + GI * 128 + 2 * lane) = pk2(y0, y1);
    }
    LDS_WAIT(); asm volatile("" ::: "memory");
}

typedef float f32x16 __attribute__((ext_vector_type(16)));
typedef float f32x8 __attribute__((ext_vector_type(8)));
typedef __bf16 bf16x8v __attribute__((ext_vector_type(8)));
typedef __bf16 bf16x4v __attribute__((ext_vector_type(4)));
typedef unsigned u32x2 __attribute__((ext_vector_type(2)));
#define MFMA32(a, b, c) __builtin_amdgcn_mfma_f32_32x32x16_bf16((a), (b), (c), 0, 0, 0)
#define MFMA16(a, b, c) __builtin_amdgcn_mfma_f32_16x16x32_bf16((a), (b), (c), 0, 0, 0)

__device__ __forceinline__ bf16x8 cvt8(f32x8 v) { return __builtin_bit_cast(bf16x8, __builtin_convertvector(v, bf16x8v)); }
__device__ __forceinline__ u32x2 cvt4(f32x4 v) { return __builtin_bit_cast(u32x2, __builtin_convertvector(v, bf16x4v)); }
__device__ __forceinline__ bf16x8 pack_lo(const f32x16& x) { return cvt8(__builtin_shufflevector(x, x, 0, 1, 2, 3, 4, 5, 6, 7)); }
__device__ __forceinline__ bf16x8 pack_hi(const f32x16& x) { return cvt8(__builtin_shufflevector(x, x, 8, 9, 10, 11, 12, 13, 14, 15)); }
__device__ __forceinline__ f32x8 unpack8(bf16x8 p) { const v4u w = __builtin_bit_cast(v4u, p); return (f32x8){bflo(w.x), bfhi(w.x), bflo(w.y), bfhi(w.y), bflo(w.z), bfhi(w.z), bflo(w.w), bfhi(w.w)}; }
__device__ __forceinline__ f32x16 unpack16(bf16x8 lo, bf16x8 hi) { const f32x8 a = unpack8(lo), b = unpack8(hi); return __builtin_shufflevector(a, b, 0, 1, 2, 3, 4, 5, 6, 7, 8, 9, 10, 11, 12, 13, 14, 15); }
__device__ __forceinline__ f32x4 unpack4(u32x2 w) { return (f32x4){bflo(w.x), bfhi(w.x), bflo(w.y), bfhi(w.y)}; }
__device__ __forceinline__ float tanh_fast(float x) { return 1.f - 2.f * __builtin_amdgcn_rcpf(1.f + __expf(2.f * x)); }
#define CROW(reg, h) (((reg) & 3) + 8 * ((reg) >> 2) + 4 * (h))
__device__ __forceinline__ f32x16 zero16() { f32x16 z;
#pragma unroll
    for (int i = 0; i < 16; ++i) z[i] = 0.f; return z; }

struct PK2 { bf16x8 s[2]; };
__device__ __forceinline__ PK2 pack2(const f32x16& x) { PK2 p; p.s[0] = pack_lo(x); p.s[1] = pack_hi(x); return p; }

typedef __amdgpu_buffer_rsrc_t rsrc_t;
__device__ __forceinline__ rsrc_t mkrsrc(const void* p) { return __builtin_amdgcn_make_buffer_rsrc((void*)p, 0, 0x7fffffff, 0x00020000); }
#define BLD128(rs, voff, soff) __builtin_bit_cast(v4u, __builtin_amdgcn_raw_buffer_load_b128((rs), (voff), (soff), 0))
#define BLD64(rs, voff, soff) __builtin_bit_cast(u32x2, __builtin_amdgcn_raw_buffer_load_b64((rs), (voff), (soff), 0))
#define BLDF(rs, voff, soff) __builtin_bit_cast(float, __builtin_amdgcn_raw_buffer_load_b32((rs), (voff), (soff), 0))
#define BST64(v, rs, voff, soff) __builtin_amdgcn_raw_buffer_store_b64((v), (rs), (voff), (soff), 0)
#define BST32F(v, rs, voff, soff) __builtin_amdgcn_raw_buffer_store_b32(__builtin_bit_cast(unsigned, (float)(v)), (rs), (voff), (soff), 0)
#define BST16(v, rs, voff, soff) __builtin_amdgcn_raw_buffer_store_b16((unsigned short)(v), (rs), (voff), (soff), 0)

__device__ __forceinline__ void pass1_item(Frame& F, int it, LAS unsigned char* lds, LAS float* wct) {
    const int head = it & 7, cc = (it >> 3) & 255, b = it >> 11;
    int lane = F.lane, c, h;
#define REFRESH do { asm volatile("" : "+v"(lane)); c = lane & 31; h = lane >> 5; } while (0)
    REFRESH;
    const int row0 = b * T + 32 * cc, pos0 = 32 * cc;
    const rsrc_t rsP = mkrsrc(F.P + SEG0 + (size_t)(row0 - 1) * LDP);
    const rsrc_t rsW = mkrsrc(F.WUPT + (size_t)head * 64 * 64);
    const rsrc_t rsR = mkrsrc(F.PRM + (size_t)head * 64 * 8);
    const rsrc_t rsM = mkrsrc(F.PRM + 512 * 8);
    {
        const unsigned voff = (unsigned)((lane >> 3) * (LDP * 2) + (lane & 7) * 16);
        const bool z0 = (pos0 == 0) && ((lane >> 3) == 0);
        v4u w[3][5];
#pragma unroll
        for (int a = 0; a < 3; ++a)
#pragma unroll
            for (int j = 0; j < 5; ++j) w[a][j] = BLD128(rsP, voff, (head * 64 + (a == 0 ? C_R : (a == 1 ? C_K : C_V))) * 2 + j * 8 * (LDP * 2));
#pragma unroll
        for (int a = 0; a < 3; ++a) { if (z0) w[a][0] = (v4u){0u, 0u, 0u, 0u};
#pragma unroll
            for (int j = 0; j < 5; ++j) if (j < 4 || (lane >> 3) == 0) *(LAS v4u*)(lds + (a * 33 + j * 8 + (lane >> 3)) * 128 + (lane & 7) * 16) = w[a][j]; }
    }
    REFRESH;
    bf16x8 Aw[4], Aa[4];
    {
        const unsigned voff = (unsigned)(c * (LDP * 2) + h * 16);
        const bool zp = (pos0 + c) == 0;
#pragma unroll
        for (int ks = 0; ks < 4; ++ks) {
            const f32x8 cw = unpack8(__builtin_bit_cast(bf16x8, BLD128(rsP, voff, LDP * 2 + (C_WLO + 16 * ks) * 2))), ca = unpack8(__builtin_bit_cast(bf16x8, BLD128(rsP, voff, LDP * 2 + (C_ALO + 16 * ks) * 2)));
            f32x8 pw = unpack8(__builtin_bit_cast(bf16x8, BLD128(rsP, voff, (C_WLO + 16 * ks) * 2))), pa = unpack8(__builtin_bit_cast(bf16x8, BLD128(rsP, voff, (C_ALO + 16 * ks) * 2)));
            if (zp) { pw = pw * 0.f; pa = pa * 0.f; }
            const f32x4 mw0 = __builtin_bit_cast(f32x4, BLD128(rsM, (unsigned)(h * 32), ks * 64)), mw1 = __builtin_bit_cast(f32x4, BLD128(rsM, (unsigned)(h * 32), ks * 64 + 16));
            const f32x4 ma0 = __builtin_bit_cast(f32x4, BLD128(rsM, (unsigned)(h * 32), 256 + ks * 64)), ma1 = __builtin_bit_cast(f32x4, BLD128(rsM, (unsigned)(h * 32), 256 + ks * 64 + 16));
            const f32x8 muw = __builtin_shufflevector(mw0, mw1, 0, 1, 2, 3, 4, 5, 6, 7), mua = __builtin_shufflevector(ma0, ma1, 0, 1, 2, 3, 4, 5, 6, 7);
            f32x8 xw = cw + (pw - cw) * muw; const f32x8 xa = ca + (pa - ca) * mua;
#pragma unroll
            for (int j = 0; j < 8; ++j) xw[j] = tanh_fast(xw[j]);
            Aw[ks] = cvt8(xw); Aa[ks] = cvt8(xa);
        }
    }
    LDS_WAIT(); asm volatile("" ::: "memory");
    unsigned rbase = (unsigned)(size_t)lds + (unsigned)(c * 2);
#define TIE(dep) asm volatile("" : "+v"(rbase) : "v"(dep))
#define RAW(a, rowi, ch) bf2f(*(const LAS unsigned short*)(size_t)(rbase + (unsigned)(((a) * 33 + (rowi)) * 128 + ((ch) - c) * 2)))
    REFRESH;
    TIE(Aw[3][0]);
    float ss[16];
#pragma unroll
    for (int reg = 0; reg < 16; ++reg) ss[reg] = 0.f;
#pragma unroll
    for (int nb = 0; nb < 2; ++nb) {
        const int ch = 32 * nb + c;
        const f32x4 pa_ = __builtin_bit_cast(f32x4, BLD128(rsR, (unsigned)(c * 32), nb * 1024)), pb_ = __builtin_bit_cast(f32x4, BLD128(rsR, (unsigned)(c * 32), nb * 1024 + 16));
#pragma unroll
        for (int rho = 0; rho < 4; ++rho) {
            const int tb = 8 * rho + 4 * h;
            float prk = RAW(1, tb, ch);
#pragma unroll
            for (int b_ = 0; b_ < 4; ++b_) {
                const float ck = RAW(1, tb + b_ + 1, ch);
                const float kkr = (ck + (prk - ck) * pb_.z) * pa_.z; prk = ck;
                ss[4 * rho + b_] += kkr * kkr;
            }
        }
    }
#pragma unroll
    for (int reg = 0; reg < 16; ++reg) {
        float s = ss[reg];
#pragma unroll
        for (int o = 1; o < 32; o <<= 1) s += __shfl_xor(s, o);
        ss[reg] = __builtin_amdgcn_rsqf(fmaxf(s, 1e-24f));
    }
    if (c == 0) {
#pragma unroll
        for (int reg = 0; reg < 16; ++reg) *(LAS float*)(lds + 17152 + CROW(reg, h) * 4) = ss[reg];
    }
    LDS_WAIT(); asm volatile("" ::: "memory");
    REFRESH;
    PK2 at_pk[2], bt_pk[2], kt_pk[2], v_pk[2];
    float wcl[2], bon[2];
    bon[0] = 0.f; bon[1] = 0.f;
    const rsrc_t rsC = mkrsrc(F.WC + (size_t)it * 64);
#pragma unroll
    for (int nb = 0; nb < 2; ++nb) {
        REFRESH;
        const int ch = 32 * nb + c;
        rbase = (unsigned)(size_t)lds + (unsigned)(c * 2);
        unsigned wvo = (unsigned)(c * 128 + h * 16); asm volatile("" : "+v"(wvo) : "v"(rbase));
        f32x16 accw = zero16(), acca = zero16();
#pragma unroll
        for (int ks = 0; ks < 4; ++ks) {
            const bf16x8 Bw = __builtin_bit_cast(bf16x8, BLD128(rsW, wvo, nb * 4096 + ks * 32)), Ba = __builtin_bit_cast(bf16x8, BLD128(rsW, wvo, 65536 + nb * 4096 + ks * 32));
            accw = MFMA32(Aw[ks], Bw, accw); acca = MFMA32(Aa[ks], Ba, acca);
        }
        const f32x4 pa_ = __builtin_bit_cast(f32x4, BLD128(rsR, (unsigned)(c * 32), nb * 1024)), pb_ = __builtin_bit_cast(f32x4, BLD128(rsR, (unsigned)(c * 32), nb * 1024 + 16));
        const float p_w0 = pa_.x, p_a0 = pa_.y, p_kk = pa_.z, p_ka = pa_.w, p_rk = pb_.x, m_r = pb_.y, m_k = pb_.z, m_v = pb_.w;
        float ldv[16], av[16];
#pragma unroll
        for (int reg = 0; reg < 16; ++reg) { ldv[reg] = -0.60653066f * sigmoidf_(p_w0 + accw[reg]); av[reg] = sigmoidf_(p_a0 + acca[reg]); }
        float Gt[4], Gp[4];
#pragma unroll
        for (int rho = 0; rho < 4; ++rho) { Gt[rho] = (ldv[4 * rho] + ldv[4 * rho + 1]) + (ldv[4 * rho + 2] + ldv[4 * rho + 3]); Gp[rho] = __shfl_xor(Gt[rho], 32); }
        const float tot = ((Gt[0] + Gp[0]) + (Gt[1] + Gp[1])) + ((Gt[2] + Gp[2]) + (Gt[3] + Gp[3]));
        const float wc = __expf(tot); wcl[nb] = wc;
        if (h == 0) BST32F(wc, rsC, (unsigned)(c * 4), nb * 128);
        float off = 0.f;
#pragma unroll
        for (int sh = 0; sh < 2; ++sh) {
            float lw0[2];
#pragma unroll
            for (int r2 = 0; r2 < 2; ++r2) { const int rho = 2 * sh + r2; lw0[r2] = off + (h ? Gp[rho] : 0.f); off += Gt[rho] + Gp[rho]; }
            {
                TIE(lw0[1]);
                float at[8], bt[8];
#pragma unroll
                for (int r2 = 0; r2 < 2; ++r2) {
                    const int rho = 2 * sh + r2, tb = 8 * rho + 4 * h;
                    float prk = RAW(1, tb, ch), lw = lw0[r2], epm = __expf(lw);
                    const f32x4 iv4 = *(const LAS f32x4*)(size_t)(rbase - (unsigned)(c * 2) + 17152u + (unsigned)(tb * 4));
                    const float ivs[4] = {iv4.x, iv4.y, iv4.z, iv4.w};
#pragma unroll
                    for (int b_ = 0; b_ < 4; ++b_) {
                        const int reg = 4 * rho + b_, e8 = 4 * r2 + b_;
                        const float ck = RAW(1, tb + b_ + 1, ch);
                        const float k = ck + (prk - ck) * m_k; prk = ck;
                        lw += ldv[reg];
                        const float ep = __expf(lw), em = __builtin_amdgcn_rcpf(ep);
                        const float kk = k * p_kk * ivs[b_];
                        at[e8] = -kk * epm; bt[e8] = kk * av[reg] * em; epm = ep;
                    }
                }
#define V8(x) ((f32x8){x[0], x[1], x[2], x[3], x[4], x[5], x[6], x[7]})
                at_pk[nb].s[sh] = cvt8(V8(at)); bt_pk[nb].s[sh] = cvt8(V8(bt));
                asm volatile("" : "+v"(at_pk[nb].s[sh]), "+v"(bt_pk[nb].s[sh]));
            }
            {
                TIE(bt_pk[nb].s[sh][7]);
                float kt[8], vv[8], bp[8];
#pragma unroll
                for (int r2 = 0; r2 < 2; ++r2) {
                    const int rho = 2 * sh + r2, tb = 8 * rho + 4 * h;
                    float prr = RAW(0, tb, ch), prk = RAW(1, tb, ch), prv = RAW(2, tb, ch), lw = lw0[r2];
#pragma unroll
                    for (int b_ = 0; b_ < 4; ++b_) {
                        const int reg = 4 * rho + b_, e8 = 4 * r2 + b_;
                        const float cr = RAW(0, tb + b_ + 1, ch), ck = RAW(1, tb + b_ + 1, ch), cv = RAW(2, tb + b_ + 1, ch);
                        const float r = cr + (prr - cr) * m_r, k = ck + (prk - ck) * m_k, v = cv + (prv - cv) * m_v; prr = cr; prk = ck; prv = cv;
                        lw += ldv[reg];
                        const float ep = __expf(lw), em = __builtin_amdgcn_rcpf(ep);
                        const float km = k * (1.f + (av[reg] - 1.f) * p_ka);
                        bp[e8] = r * km * p_rk; kt[e8] = km * em; vv[e8] = v;
                        *(LAS unsigned short*)(lds + 12800 + (tb + b_) * 128 + ch * 2) = (unsigned short)f2bf(r * ep);
                    }
                }
                kt_pk[nb].s[sh] = cvt8(V8(kt)); v_pk[nb].s[sh] = cvt8(V8(vv));
                asm volatile("" : "+v"(kt_pk[nb].s[sh]), "+v"(v_pk[nb].s[sh]));
#undef V8
                float keep = 0.f;
#pragma unroll
                for (int e8 = 0; e8 < 8; ++e8) { float q = bp[e8];
#pragma unroll
                    for (int o = 1; o < 32; o <<= 1) q += __shfl_xor(q, o);
                    keep = (c == e8) ? q : keep; }
                bon[sh] += keep;
                TIE(keep);
            }
        }
    }
#undef RAW
#undef TIE
    REFRESH;
    if (c < 8) {
        const rsrc_t rsB = mkrsrc(F.bonus + (size_t)row0 * 8 + head);
        const unsigned vo = (unsigned)(((c & 3) + 8 * (c >> 2) + 4 * h) * 32);
        BST32F(bon[0], rsB, vo, 0); BST32F(bon[1], rsB, vo, 16 * 32);
    }
    LDS_WAIT(); asm volatile("" ::: "memory");
    REFRESH;
#pragma unroll
    for (int nb = 0; nb < 2; ++nb) {
#pragma unroll
        for (int reg = 0; reg < 16; ++reg) {
            const int o = CROW(reg, h) * 128 + (32 * nb + c) * 2;
            *(LAS unsigned short*)(lds + 0 * 4096 + o) = (unsigned short)at_pk[nb].s[reg >> 3][reg & 7];
            *(LAS unsigned short*)(lds + 1 * 4096 + o) = (unsigned short)bt_pk[nb].s[reg >> 3][reg & 7];
            *(LAS unsigned short*)(lds + 2 * 4096 + o) = (unsigned short)kt_pk[nb].s[reg >> 3][reg & 7];
        }
        if (h == 0) wct[32 * nb + c] = wcl[nb];
    }
    LDS_WAIT(); asm volatile("" ::: "memory");
    REFRESH;
#define FRAG(tile, ks) (*(const LAS bf16x8*)(lds + ((tile) < 3 ? (tile) * 4096 : 12800) + c * 128 + (16 * (ks) + 8 * h) * 2))
    f32x16 N = zero16(), Lm = zero16(), AakT = zero16(), ArbT = zero16(), ArkT = zero16();
#pragma unroll
    for (int ks = 0; ks < 4; ++ks) {
        const bf16x8 fa = FRAG(0, ks), fb = FRAG(1, ks), fk = FRAG(2, ks), fr = FRAG(3, ks);
        N = MFMA32(fb, fa, N); Lm = MFMA32(fa, fb, Lm); AakT = MFMA32(fk, fa, AakT); ArbT = MFMA32(fb, fr, ArbT); ArkT = MFMA32(fk, fr, ArkT);
    }
#undef FRAG
#pragma unroll
    for (int reg = 0; reg < 16; ++reg) { const int rw = CROW(reg, h);
        N[reg] = (rw < c) ? N[reg] : 0.f; Lm[reg] = (c < rw) ? Lm[reg] : 0.f; AakT[reg] = (rw < c) ? AakT[reg] : 0.f;
        ArbT[reg] = (rw <= c) ? ArbT[reg] : 0.f; ArkT[reg] = (rw <= c) ? ArkT[reg] : 0.f; }
    const PK2 AakT_pk = pack2(AakT), ArbT_pk = pack2(ArbT), ArkT_pk = pack2(ArkT);
    REFRESH;
    PK2 Xpk;
    {
        f32x16 X = N, Pw = N, PwT = Lm;
#pragma unroll
        for (int lvl = 0; lvl < 5; ++lvl) {
            const PK2 pa = pack2(PwT), pb = pack2(X);
            X = MFMA32(pa.s[0], pb.s[0], X); X = MFMA32(pa.s[1], pb.s[1], X);
            if (lvl < 4) { const PK2 pw = pack2(Pw);
                f32x16 n1 = zero16(), n2 = zero16();
                n1 = MFMA32(pa.s[0], pw.s[0], n1); n1 = MFMA32(pa.s[1], pw.s[1], n1);
                n2 = MFMA32(pw.s[0], pa.s[0], n2); n2 = MFMA32(pw.s[1], pa.s[1], n2);
                Pw = n1; PwT = n2; }
        }
        Xpk = pack2(X);
    }
    REFRESH;
    PK2 U_pk[2], Ab_pk[2];
#pragma unroll
    for (int ib = 0; ib < 2; ++ib) {
        f32x16 xm = zero16();
        xm = MFMA32(AakT_pk.s[0], v_pk[ib].s[0], xm); xm = MFMA32(AakT_pk.s[1], v_pk[ib].s[1], xm);
        const PK2 xp = pack2(xm);
        xm = MFMA32(Xpk.s[0], xp.s[0], xm); xm = MFMA32(Xpk.s[1], xp.s[1], xm);
        U_pk[ib] = pack2(xm);
    }
#pragma unroll
    for (int jb = 0; jb < 2; ++jb) {
        f32x16 ab = unpack16(at_pk[jb].s[0], at_pk[jb].s[1]);
        ab = MFMA32(Xpk.s[0], at_pk[jb].s[0], ab); ab = MFMA32(Xpk.s[1], at_pk[jb].s[1], ab);
        Ab_pk[jb] = pack2(ab);
    }
    REFRESH;
    const rsrc_t rsX = mkrsrc(F.MIX + (size_t)row0 * D + 512 + head * 64);
    const rsrc_t rsY = mkrsrc(F.YI + (size_t)it * 2048);
    const rsrc_t rsT = mkrsrc(F.PT + (size_t)it * 4096);
    const rsrc_t rsQ = mkrsrc(F.QM + (size_t)it * 4096);
#pragma unroll
    for (int jb = 0; jb < 2; ++jb) {
        f32x16 rh;
#pragma unroll
        for (int reg = 0; reg < 16; ++reg) rh[reg] = bf2f(*(const LAS unsigned short*)(lds + 12800 + CROW(reg, h) * 128 + (32 * jb + c) * 2));
        rh = MFMA32(ArbT_pk.s[0], Ab_pk[jb].s[0], rh); rh = MFMA32(ArbT_pk.s[1], Ab_pk[jb].s[1], rh);
        const PK2 rp = pack2(rh);
#pragma unroll
        for (int reg = 0; reg < 16; ++reg) BST16(rp.s[reg >> 3][reg & 7], rsX, (unsigned)(h * (4 * D * 2) + c * 2), CROW(reg, 0) * (D * 2) + jb * 64);
    }
#pragma unroll
    for (int ib = 0; ib < 2; ++ib) {
        f32x16 y = zero16();
        y = MFMA32(U_pk[ib].s[0], ArbT_pk.s[0], y); y = MFMA32(U_pk[ib].s[1], ArbT_pk.s[1], y);
        y = MFMA32(v_pk[ib].s[0], ArkT_pk.s[0], y); y = MFMA32(v_pk[ib].s[1], ArkT_pk.s[1], y);
        const PK2 yp = pack2(y);
        const v4u w0 = __builtin_bit_cast(v4u, yp.s[0]), w1 = __builtin_bit_cast(v4u, yp.s[1]);
        const unsigned vo = (unsigned)(c * 128 + h * 8);
        BST64(((u32x2){w0.x, w0.y}), rsY, vo, ib * 64); BST64(((u32x2){w0.z, w0.w}), rsY, vo, ib * 64 + 16); BST64(((u32x2){w1.x, w1.y}), rsY, vo, ib * 64 + 32); BST64(((u32x2){w1.z, w1.w}), rsY, vo, ib * 64 + 48);
    }
    REFRESH;
#pragma unroll
    for (int jb = 0; jb < 2; ++jb)
#pragma unroll
        for (int jb2 = 0; jb2 < 2; ++jb2) {
            f32x16 pm = zero16();
            pm = MFMA32(Ab_pk[jb].s[0], bt_pk[jb2].s[0], pm); pm = MFMA32(Ab_pk[jb].s[1], bt_pk[jb2].s[1], pm);
            const PK2 pp = pack2(pm * wcl[jb2]);
            const v4u w0 = __builtin_bit_cast(v4u, pp.s[0]), w1 = __builtin_bit_cast(v4u, pp.s[1]);
            const unsigned vo = (unsigned)(h * 1024 + c * 16); const int so = jb * 4096 + jb2 * 512;
            BST64(((u32x2){w0.x, w0.y}), rsT, vo, so);
            BST64(((u32x2){w0.z, w0.w}), rsT, vo, so + 2048);
            BST64(((u32x2){w1.x, w1.y}), rsT, vo, so + 8);
            BST64(((u32x2){w1.z, w1.w}), rsT, vo, so + 2048 + 8);
        }
#pragma unroll
    for (int jb2 = 0; jb2 < 2; ++jb2)
#pragma unroll
        for (int ib = 0; ib < 2; ++ib) {
            f32x16 q = zero16();
            q = MFMA32(bt_pk[jb2].s[0], U_pk[ib].s[0], q); q = MFMA32(bt_pk[jb2].s[1], U_pk[ib].s[1], q);
            q = MFMA32(kt_pk[jb2].s[0], v_pk[ib].s[0], q); q = MFMA32(kt_pk[jb2].s[1], v_pk[ib].s[1], q);
#pragma unroll
            for (int rho = 0; rho < 4; ++rho) { const f32x4 w4 = *(const LAS f32x4*)(wct + 32 * jb2 + 8 * rho + 4 * h); q[4 * rho] *= w4.x; q[4 * rho + 1] *= w4.y; q[4 * rho + 2] *= w4.z; q[4 * rho + 3] *= w4.w; }
            const PK2 qp = pack2(q);
            const v4u w0 = __builtin_bit_cast(v4u, qp.s[0]), w1 = __builtin_bit_cast(v4u, qp.s[1]);
            const unsigned vo = (unsigned)(c * 128 + h * 8); const int so = ib * 4096 + jb2 * 64;
            BST64(((u32x2){w0.x, w0.y}), rsQ, vo, so); BST64(((u32x2){w0.z, w0.w}), rsQ, vo, so + 16); BST64(((u32x2){w1.x, w1.y}), rsQ, vo, so + 32); BST64(((u32x2){w1.z, w1.w}), rsQ, vo, so + 48);
        }
    LDS_WAIT(); asm volatile("" ::: "memory");
#undef REFRESH
}

constexpr int P2_SLOT = 11264, P2_R = 4, P2_U = 16;
#define P2_LD(dst, ptr) asm volatile("global_load_dwordx4 %0, %1, off" : "=v"(dst) : "v"(ptr) : "memory")
#define P2_LD1K(dst, ptr) asm volatile("global_load_dwordx4 %0, %1, off offset:1024" : "=v"(dst) : "v"(ptr) : "memory")
template <int CNT> __device__ __forceinline__ void p2_wait1(v4u& a) { asm volatile("s_waitcnt vmcnt(%1)" : "+v"(a) : "n"(CNT) : "memory"); }
template <int CNT> __device__ __forceinline__ void p2_wait2(v4u& a, v4u& b) { asm volatile("s_waitcnt vmcnt(%2)" : "+v"(a), "+v"(b) : "n"(CNT) : "memory"); }
template <int NLD> __device__ __forceinline__ void pass2_loader(LAS unsigned char* ring, const char* g0, size_t stride, int d0) {
    v4u r0[P2_U], r1[P2_U];
    const char* gp = g0;
#pragma unroll
    for (int u = 0; u < P2_U; ++u) { P2_LD(r0[u], gp); if (NLD == 2) P2_LD1K(r1[u], gp); gp += stride; }
    int n = 0;
    for (int n0 = 0; n0 < 256 - P2_U; n0 += P2_U) {
#pragma unroll
        for (int u = 0; u < P2_U; ++u) {
            LAS unsigned char* sl = ring + (n & (P2_R - 1)) * P2_SLOT + d0;
            if (NLD == 2) p2_wait2<(P2_U - 1) * 2>(r0[u], r1[u]); else p2_wait1<P2_U - 1>(r0[u]);
            *(LAS v4u*)sl = r0[u]; if (NLD == 2) *(LAS v4u*)(sl + 1024) = r1[u];
            asm volatile("s_waitcnt lgkmcnt(0)" ::: "memory");
            P2_LD(r0[u], gp); if (NLD == 2) P2_LD1K(r1[u], gp); gp += stride;
            __builtin_amdgcn_s_barrier();
            ++n;
        }
    }
#define P2_TAIL(u) do { LAS unsigned char* sl = ring + ((256 - P2_U + (u)) & (P2_R - 1)) * P2_SLOT + d0; \
        if (NLD == 2) p2_wait2<(P2_U - 1 - (u)) * 2>(r0[u], r1[u]); else p2_wait1<P2_U - 1 - (u)>(r0[u]); \
        *(LAS v4u*)sl = r0[u]; if (NLD == 2) *(LAS v4u*)(sl + 1024) = r1[u]; \
        asm volatile("s_waitcnt lgkmcnt(0)" ::: "memory"); __builtin_amdgcn_s_barrier(); } while (0)
    P2_TAIL(0); P2_TAIL(1); P2_TAIL(2); P2_TAIL(3); P2_TAIL(4); P2_TAIL(5); P2_TAIL(6); P2_TAIL(7); P2_TAIL(8); P2_TAIL(9); P2_TAIL(10); P2_TAIL(11); P2_TAIL(12); P2_TAIL(13); P2_TAIL(14); P2_TAIL(15);
#undef P2_TAIL
}
struct P2Regs { bf16x8 Af[4][2]; u32x2 qv[4]; f32x4 wc[4]; };
__device__ __forceinline__ void p2_read(P2Regs& R, const LAS unsigned char* sl, int il, int g) {
#pragma unroll
    for (int rt = 0; rt < 4; ++rt) {
#pragma unroll
        for (int ks = 0; ks < 2; ++ks) R.Af[rt][ks] = *(const LAS bf16x8*)(sl + ((ks * 4 + g) * 64 + 16 * rt + il) * 16);
        R.qv[rt] = *(const LAS u32x2*)(sl + 8192 + il * 128 + (16 * rt + 4 * g) * 2); R.wc[rt] = *(const LAS f32x4*)(sl + 10240 + (16 * rt + 4 * g) * 4);
    }
}
__device__ __forceinline__ void p2_step(const P2Regs& R, f32x4 (&acc)[4], bf16* qm) {
    u32x2 sv[4];
#pragma unroll
    for (int rt = 0; rt < 4; ++rt) sv[rt] = cvt4(acc[rt]);
    bf16x8 Bf[2];
    Bf[0] = __builtin_bit_cast(bf16x8, (v4u){sv[0].x, sv[0].y, sv[1].x, sv[1].y}); Bf[1] = __builtin_bit_cast(bf16x8, (v4u){sv[2].x, sv[2].y, sv[3].x, sv[3].y});
#pragma unroll
    for (int rt = 0; rt < 4; ++rt) {
        f32x4 a_ = R.wc[rt] * acc[rt] + unpack4(R.qv[rt]);
        a_ = MFMA16(R.Af[rt][0], Bf[0], a_); a_ = MFMA16(R.Af[rt][1], Bf[1], a_);
        acc[rt] = a_;
    }
#pragma unroll
    for (int rt = 0; rt < 4; ++rt) *(u32x2*)(qm + 16 * rt) = sv[rt];
}
__device__ __forceinline__ void pass2_block(Frame& F, int b, int head, int iblk) {
    const int lane = F.lane, w = F.wave;
    LAS unsigned char* ring = F.lds;
    const char* ptg = (const char*)F.PT + (size_t)(b * 256 * 8 + head) * 8192;
    const char* qmg = (const char*)F.QM + (size_t)(b * 256 * 8 + head) * 8192 + iblk * 2048;
    const char* wcg = (const char*)F.WC + (size_t)(b * 256 * 8 + head) * 256;
    if (w < 4) pass2_loader<2>(ring, ptg + (2 * w) * 1024 + lane * 16, 65536, (2 * w) * 1024 + lane * 16);
    else if (w < 6) pass2_loader<1>(ring, qmg + (w - 4) * 1024 + lane * 16, 65536, 8192 + (w - 4) * 1024 + lane * 16);
    else if (w == 6) pass2_loader<1>(ring, wcg + (lane & 15) * 16, 2048, 10240 + lane * 16);
    else {
        const int il = lane & 15, g = lane >> 4, i = 16 * iblk + il;
        f32x4 acc[4];
#pragma unroll
        for (int rt = 0; rt < 4; ++rt) acc[rt] = (f32x4){0.f, 0.f, 0.f, 0.f};
        bf16* qm = F.QM + ((size_t)(b * 256 * 8 + head)) * 4096 + (size_t)i * 64 + 4 * g;
        P2Regs RA, RB;
        for (int n = 0; n < 256; n += 2) {
            __builtin_amdgcn_s_barrier();
            p2_read(RA, ring + (n & (P2_R - 1)) * P2_SLOT, il, g);
            if (n > 0) p2_step(RB, acc, qm + (size_t)(n - 1) * 32768);
            __builtin_amdgcn_s_barrier();
            p2_read(RB, ring + ((n + 1) & (P2_R - 1)) * P2_SLOT, il, g);
            p2_step(RA, acc, qm + (size_t)n * 32768);
        }
        p2_step(RB, acc, qm + (size_t)255 * 32768);
    }
}

__device__ __forceinline__ void pass3_item(Frame& F, int it) {
    const int head = it & 7, cc = (it >> 3) & 255, b = it >> 11;
    const int lane = F.lane, c = lane & 31, h = lane >> 5;
    const int row0 = b * T + 32 * cc, pos0 = 32 * cc;
    const bf16* sm = F.QM + (size_t)it * 4096;
    bf16* mixrow = F.MIX + (size_t)(row0 + c) * D + 512 + head * 64;
    f32x16 y[2];
#pragma unroll
    for (int ib = 0; ib < 2; ++ib) {
        const bf16* yi = F.YI + (size_t)it * 2048 + c * 64 + 32 * ib + 4 * h;
        const f32x4 y0 = unpack4(*(const u32x2*)(yi)), y1 = unpack4(*(const u32x2*)(yi + 8)), y2 = unpack4(*(const u32x2*)(yi + 16)), y3 = unpack4(*(const u32x2*)(yi + 24));
        y[ib] = (f32x16){y0.x, y0.y, y0.z, y0.w, y1.x, y1.y, y1.z, y1.w, y2.x, y2.y, y2.z, y2.w, y3.x, y3.y, y3.z, y3.w};
    }
#pragma unroll
    for (int ks = 0; ks < 4; ++ks) {
        const bf16x8 Bf = *(const bf16x8*)(mixrow + 16 * ks + 8 * h);
#pragma unroll
        for (int ib = 0; ib < 2; ++ib) { const bf16x8 Af = *(const bf16x8*)(sm + (size_t)(32 * ib + c) * 64 + 16 * ks + 8 * h); y[ib] = MFMA32(Af, Bf, y[ib]); }
    }
    float s = 0.f;
#pragma unroll
    for (int reg = 0; reg < 16; ++reg) s += y[0][reg] + y[1][reg];
    s += __shfl_xor(s, 32);
    const float mean = s * (1.f / 64.f);
    float q = 0.f;
#pragma unroll
    for (int reg = 0; reg < 16; ++reg) { const float d0 = y[0][reg] - mean, d1 = y[1][reg] - mean; q += d0 * d0 + d1 * d1; }
    q += __shfl_xor(q, 32);
    const float rstd = 1.f / sqrtf(q * (1.f / 64.f) + GN_EPS);
    const float bo = F.bonus[(size_t)(row0 + c) * 8 + head];
    const bool hp = (pos0 + c) > 0;
    const bf16* prow = F.P + SEG0 + (size_t)(row0 + c) * LDP + head * 64;
#pragma unroll
    for (int ib = 0; ib < 2; ++ib)
#pragma unroll
        for (int rho = 0; rho < 4; ++rho) {
            const int i0 = 32 * ib + 8 * rho + 4 * h, gi = head * 64 + i0;
            const f32x4 cv = unpack4(*(const u32x2*)(prow + C_V + i0)), cz = unpack4(*(const u32x2*)(prow + C_Z + i0));
            f32x4 pv = cv * 0.f, pz = cz * 0.f;
            if (hp) { pv = unpack4(*(const u32x2*)(prow - LDP + C_V + i0)); pz = unpack4(*(const u32x2*)(prow - LDP + C_Z + i0)); }
            const f32x4 v = cv + (pv - cv) * *(const f32x4*)(F.mu + C_V + gi), z = cz + (pz - cz) * *(const f32x4*)(F.mu + C_Z + gi);
            const f32x4 lw = *(const f32x4*)(F.ln_w + gi), lb = *(const f32x4*)(F.ln_b + gi);
            const f32x4 yy = (f32x4){y[ib][4 * rho], y[ib][4 * rho + 1], y[ib][4 * rho + 2], y[ib][4 * rho + 3]};
            f32x4 o = (yy - mean) * rstd * lw + lb + bo * v;
            o.x *= siluf_(z.x); o.y *= siluf_(z.y); o.z *= siluf_(z.z); o.w *= siluf_(z.w);
            *(u32x2*)(mixrow + i0) = cvt4(o);
        }
}

template <int GI> __device__ __forceinline__ void pool_item_mfma(Frame& F, int tile, LAS unsigned char* lds) {
    constexpr int WIN = 2 << GI, LROW = 272;
    const int lane = F.lane, c = lane & 31, h = lane >> 5;
    const int t0 = tile * 64, pos0 = t0 & (T - 1);
    {
        const rsrc_t rsU = mkrsrc(F.P + (size_t)(t0 - 16) * LDP + GI * 128);
        const unsigned vo = (unsigned)(lane * 4);
        float h0[WIN], h1[WIN];
        float s0 = 0.f, s1 = 0.f;
#pragma unroll
        for (int q = 0; q < WIN; ++q) { h0[q] = 0.f; h1[q] = 0.f; }
#pragma unroll
        for (int bt = 0; bt < 80; bt += 16) {
            unsigned w[16];
#pragma unroll
            for (int q = 0; q < 16; ++q) w[q] = __builtin_amdgcn_raw_buffer_load_b32(rsU, vo, (bt + q) * (LDP * 2), 0);
#pragma unroll
            for (int q = 0; q < 16; ++q) {
                const int rel = bt + q - 16;
                if (rel >= -(WIN - 1)) {
                    const bool valid = (pos0 + rel) >= 0;
                    const float u0 = valid ? bflo(w[q]) : 0.f, u1 = valid ? bfhi(w[q]) : 0.f;
                    constexpr int dummy = 0; (void)dummy;
                    const int slot = (bt + q) % WIN;
                    s0 += u0 - h0[slot]; s1 += u1 - h1[slot]; h0[slot] = u0; h1[slot] = u1;
                    if (rel >= 0) {
                        const int pos = pos0 + rel;
                        const float rc = (pos + 1 < WIN) ? __builtin_amdgcn_rcpf((float)(pos + 1)) : (1.f / WIN);
                        *(LAS unsigned*)(lds + rel * LROW + lane * 4) = pk2(s0 * rc - u0, s1 * rc - u1);
                    }
                }
            }
        }
    }
    LDS_WAIT(); asm volatile("" ::: "memory");
    const rsrc_t rsW = mkrsrc(F.POOLWT + (size_t)GI * 16384);
    const rsrc_t rsZ = mkrsrc(F.P + (size_t)t0 * LDP + 512 + GI * 128);
    const rsrc_t rsO = mkrsrc(F.MIX + (size_t)t0 * D + GI * 128);
    const rsrc_t rsS = mkrsrc(F.pool_scale + GI * 128);
#pragma unroll
    for (int tb = 0; tb < 2; ++tb) {
        f32x16 acc[4];
#pragma unroll
        for (int db = 0; db < 4; ++db) acc[db] = zero16();
#pragma unroll
        for (int ks = 0; ks < 8; ++ks) {
            const bf16x8 Bf = *(const LAS bf16x8*)(lds + (32 * tb + c) * LROW + (16 * ks + 8 * h) * 2);
#pragma unroll
            for (int db = 0; db < 4; ++db) {
                const bf16x8 Af = __builtin_bit_cast(bf16x8, BLD128(rsW, (unsigned)(c * 256 + h * 16), db * 8192 + ks * 32));
                acc[db] = MFMA32(Af, Bf, acc[db]);
            }
        }
        const unsigned voz = (unsigned)((32 * tb + c) * (LDP * 2) + h * 8), voo = (unsigned)((32 * tb + c) * (D * 2) + h * 8);
#pragma unroll
        for (int db = 0; db < 4; ++db)
#pragma unroll
            for (int rho = 0; rho < 4; ++rho) {
                const f32x4 z = unpack4(BLD64(rsZ, voz, (32 * db + 8 * rho) * 2));
                const f32x4 sc = __builtin_bit_cast(f32x4, BLD128(rsS, (unsigned)(h * 16), (32 * db + 8 * rho) * 4));
                f32x4 o = (f32x4){acc[db][4 * rho], acc[db][4 * rho + 1], acc[db][4 * rho + 2], acc[db][4 * rho + 3]} * sc;
                o.x *= siluf_(z.x); o.y *= siluf_(z.y); o.z *= siluf_(z.z); o.w *= siluf_(z.w);
                BST64(cvt4(o), rsO, voo, (32 * db + 8 * rho) * 2);
            }
    }
    LDS_WAIT(); asm volatile("" ::: "memory");
}
__device__ __forceinline__ void p3_pass1(Frame& F) {
    const int gw = F.vcu * NWAVES + F.wave, NGW = F.G * NWAVES;
    for (int it = gw; it < 4096; it += NGW) pass1_item(F, it, F.lds + F.wave * 19456, (LAS float*)(F.lds + F.wave * 19456 + 16896));
}
__device__ __forceinline__ void p4_pass2_pool(Frame& F) {
    const int B = blockIdx.x;
    if (B < 64 && F.G >= 128) { const int x = B & 7, m = B >> 3, bh = x + 8 * (m >> 2), iblk = m & 3; pass2_block(F, bh >> 3, bh & 7, iblk); return; }
    LAS unsigned char* scr = F.lds + F.wave * 19456;
    const int gw = (B - 64) * NWAVES + F.wave, NGW = (F.G - 64) * NWAVES;
    for (int it = gw; it < 1024; it += NGW) {
        const int g = it & 3, tile = it >> 2;
        if (g == 0) pool_item_mfma<0>(F, tile, scr); else if (g == 1) pool_item_mfma<1>(F, tile, scr); else if (g == 2) pool_item_mfma<2>(F, tile, scr); else pool_item_mfma<3>(F, tile, scr);
    }
}
__device__ __forceinline__ void p5_pass3(Frame& F) {
    const int gw = F.vcu * NWAVES + F.wave, NGW = F.G * NWAVES;
    for (int it = gw; it < 4096; it += NGW) pass3_item(F, it);
}

struct EpiResGate {
    static constexpr bool PERM = false, AFTER_DRAIN = false;
    const float* x; const float* mod; float* out; float* rowss;
    __device__ __forceinline__ void operator()(const pg8::f32x4 (&acc)[2][2][4][2], const pg8::Unit& u, int wr, int wc, int fr, int fq) const {
        const int col0 = u.pn * 256 + wc * 32 + 4 * fq;
        const int b = (u.pm * 256) >> 13;
        const float* gate = mod + b * 3072 + 2048;
        f32x4 gv[2][2];
#pragma unroll
        for (int bj = 0; bj < 2; ++bj)
#pragma unroll
            for (int n = 0; n < 2; ++n) gv[bj][n] = *(const f32x4*)(gate + col0 + bj * 128 + n * 16);
#pragma unroll
        for (int ai = 0; ai < 2; ++ai)
#pragma unroll
            for (int m = 0; m < 4; ++m) { const int r = u.pm * 256 + ai * 128 + wr * 64 + m * 16 + fr; const size_t off = (size_t)r * D + col0; float ss = 0.f;
#pragma unroll
                for (int bj = 0; bj < 2; ++bj)
#pragma unroll
                    for (int n = 0; n < 2; ++n) { const f32x4 xv = *(const f32x4*)(x + off + bj * 128 + n * 16); const f32x4 o = xv + gv[bj][n] * acc[ai][bj][m][n];
                        *(f32x4*)(out + off + bj * 128 + n * 16) = o; ss += (o.x * o.x + o.y * o.y) + (o.z * o.z + o.w * o.w); }
                ss += __shfl_xor(ss, 16); ss += __shfl_xor(ss, 32);
                if (fq == 0) __hip_atomic_fetch_add(rowss + r, ss, __ATOMIC_RELAXED, __HIP_MEMORY_SCOPE_AGENT); }
    }
};

__device__ __forceinline__ void p7_final(Frame& F) {
    const int gw = F.vcu * NWAVES + F.wave, NGW = F.G * NWAVES;
    for (int m = gw; m < M; m += NGW) {
        const float rstd = 1.f / sqrtf(F.rowss[m] * (1.f / D) + NORM_EPS);
        f32x4* o = (f32x4*)(F.out + (size_t)m * D) + F.lane;
#pragma unroll
        for (int j = 0; j < 4; ++j) { const f32x4 g = ((const f32x4*)F.final_g)[F.lane + 64 * j]; o[64 * j] = o[64 * j] * rstd * g; }
    }
}

struct Args { const float* in[20]; float* out; unsigned char* ws; int ph_lo, ph_hi; };
__global__ void __launch_bounds__(NWAVES * 64, 2) fwd_kernel(Args args) {
    extern __shared__ __attribute__((aligned(16))) unsigned char lds[];
    Frame F;
    F.lds = (LAS unsigned char*)lds;
    F.MISC = (volatile LAS unsigned*)(F.lds + MISC_OFF);
    F.tid = threadIdx.x; F.lane = F.tid & 63; F.wave = __builtin_amdgcn_readfirstlane(F.tid >> 6);
    F.G = gridDim.x; { const int bx = blockIdx.x; F.vcu = (F.G % 8 == 0) ? (bx % 8) * (F.G / 8) + bx / 8 : bx; }
    unsigned char* ws = args.ws;
    F.x = args.in[0]; F.c = args.in[1]; F.w_ada = args.in[2]; F.b_ada = args.in[3]; F.norm_g = args.in[4]; F.w_in = args.in[5]; F.pool_w = args.in[6]; F.pool_scale = args.in[7];
    F.mu = args.in[8]; F.w0 = args.in[9]; F.w_up = args.in[10]; F.a0 = args.in[11]; F.a_up = args.in[12]; F.k_k = args.in[13]; F.k_a = args.in[14]; F.r_k = args.in[15];
    F.ln_w = args.in[16]; F.ln_b = args.in[17]; F.w_out = args.in[18]; F.final_g = args.in[19]; F.out = args.out;
    F.mod = (float*)(ws + WS_CTL + CTL_MOD); F.rowss = (float*)(ws + WS_CTL + CTL_ROWSS); F.bonus = (float*)(ws + WS_BONUS); F.WC = (float*)(ws + WS_WC); F.PRM = (float*)(ws + WS_PRM);
    F.W1t = (bf16*)(ws + WS_W1T); F.W2t = (bf16*)(ws + WS_W2T); F.XN = (bf16*)(ws + WS_XN); F.P = (bf16*)(ws + WS_P); F.MIX = (bf16*)(ws + WS_MIX);
    F.WUPT = (bf16*)(ws + WS_WUPT); F.AUPT = (bf16*)(ws + WS_AUPT); F.YI = (bf16*)(ws + WS_YI); F.PT = (bf16*)(ws + WS_PT); F.QM = (bf16*)(ws + WS_QM); F.POOLWT = (bf16*)(ws + WS_POOLWT);
    for (int u = F.tid; u < (LDS_BYTES - LDSCTL_OFF) / 4; u += NWAVES * 64) ((LAS unsigned*)(F.lds + LDSCTL_OFF))[u] = 0u;
    __syncthreads();
    XcdBarrier bar; bar.bar = (unsigned*)(ws + WS_CTL) + CW_BAR; bar.x = 0; bar.st = nullptr;
    if (N_LAUNCHES == 1) bar = xcd_barrier_post((unsigned*)(ws + WS_CTL) + CW_BAR, F.MISC + 8);
    const int lo = args.ph_lo, hi = args.ph_hi;
#define IN(k) (lo <= (k) && (k) < hi)
#define SEAM(k) do { if (IN(k) && IN((k) + 1)) xcd_barrier(bar); } while (0)
    if (IN(0)) { p0_prologue(F); } SEAM(0);
    if (IN(1)) { p1_hrows(F); } SEAM(1);
    if (IN(2)) {
        pg8::Gemm g{F.XN, F.W1t, M, LDP, D}; pg8::StaticOrder S; S.init(M, LDP, F.G, (int)blockIdx.x);
        pg8::EpiBf16<0> E{F.P, LDP, nullptr, 0, 0, 1.f};
        pg8::gemm_phase<pg8::EpiBf16<0>, pg8::StaticOrder, true, true>(F.lds, g, S, E);
    } SEAM(2);
    if (IN(3)) { p3_pass1(F); } SEAM(3);
    if (IN(4)) { p4_pass2_pool(F); } SEAM(4);
    if (IN(5)) { p5_pass3(F); } SEAM(5);
    if (IN(6)) {
        pg8::Gemm g{F.MIX, F.W2t, M, D, D}; pg8::StaticOrder S; S.init(M, D, F.G, (int)blockIdx.x);
        EpiResGate E{F.x, F.mod, F.out, F.rowss};
        pg8::gemm_phase<EpiResGate, pg8::StaticOrder, true, true>(F.lds, g, S, E);
    } SEAM(6);
    if (IN(7)) { p7_final(F); }
#undef IN
#undef SEAM
}

extern "C" void kernel_launch(void* const* d_in, const int* in_sizes, int n_in, void* d_out, int out_size, void* d_ws, size_t ws_size, hipStream_t stream) {
    static int grid = 0;
    if (grid == 0) {
        if (n_in != 20 || in_sizes[0] != M * D || out_size != M * D || ws_size < WS_END) { fprintf(stderr, "kernel_launch: unexpected shapes (n_in %d, in0 %d, out %d, ws %zu); nothing launched\n", n_in, n_in > 0 ? in_sizes[0] : -1, out_size, ws_size); grid = -1; return; }
        int dev = 0, cus = 0, per_cu = 0;
        if (hipGetDevice(&dev) != hipSuccess || hipDeviceGetAttribute(&cus, hipDeviceAttributeMultiprocessorCount, dev) != hipSuccess) { grid = -1; return; }
        if (hipFuncSetAttribute((const void*)fwd_kernel, hipFuncAttributeMaxDynamicSharedMemorySize, LDS_BYTES) != hipSuccess) { fprintf(stderr, "kernel_launch: hipFuncSetAttribute failed\n"); grid = -1; return; }
        if (hipOccupancyMaxActiveBlocksPerMultiprocessor(&per_cu, (const void*)fwd_kernel, NWAVES * 64, LDS_BYTES) != hipSuccess || per_cu < 1) { fprintf(stderr, "kernel_launch: occupancy query reports %d blocks per CU\n", per_cu); grid = -1; (void)hipGetLastError(); return; }
        (void)hipGetLastError();
        grid = cus;
    }
    if (grid < 0) return;
    if (hipMemsetAsync((char*)d_ws + WS_CTL, 0, CTL_ZERO_BYTES, stream) != hipSuccess) return;
    Args a{};
    for (int i = 0; i < 20; ++i) a.in[i] = (const float*)d_in[i];
    a.out = (float*)d_out; a.ws = (unsigned char*)d_ws;
    if (N_LAUNCHES == 1) { a.ph_lo = 0; a.ph_hi = N_PHASES; hipLaunchKernelGGL(fwd_kernel, dim3(grid), dim3(NWAVES * 64), LDS_BYTES, stream, a); }
    else for (int li = 0; li < N_PHASES; ++li) { a.ph_lo = li; a.ph_hi = li + 1; hipLaunchKernelGGL(fwd_kernel, dim3(grid), dim3(NWAVES * 64), LDS_BYTES, stream, a); }
}
```

```cpp
#include <hip/hip_runtime.h>
#include <cstdio>
#include <cstdint>
namespace pg8 {
#define PG8_LAS __attribute__((address_space(3)))
typedef unsigned short bf16_t;
typedef short bf16x8 __attribute__((ext_vector_type(8)));
typedef float f32x4 __attribute__((ext_vector_type(4)));
typedef unsigned u32x4 __attribute__((ext_vector_type(4)));
constexpr int BM = 256, BK = 64, HALF = 128, HTB = HALF * BK * 2  , STAGE_BYTES = 8 * HTB, NXCD = 8, WGM = 8;

__host__ __device__ __forceinline__ int lds_byte(int r, int c) { const int st = (r >> 4) * 2 + (c >> 5), rr = r & 15, cc = c & 31, ob = rr * 64 + cc * 2; return st * 1024 + (ob ^ (((ob >> 9) & 1) << 5)); }
__host__ __device__ __forceinline__ void stage_rc(int b, int& R, int& C) { const int st = b / 1024, sb = b % 1024, swz = sb ^ (((sb >> 9) & 1) << 5); R = (st >> 1) * 16 + swz / 64; C = (st & 1) * 32 + (swz % 64) / 2; }
__host__ __device__ __forceinline__ int perm32(int rho) { const int n = rho >> 4, i = rho & 15; return 8 * (i >> 2) + 4 * n + (i & 3); }

struct Unit { int pm, pn; };
struct Gemm { const bf16_t* A; const bf16_t* Bt; int M, N, K; };

struct StaticOrder {
    int nM, nN, nwg, G, c;
    __host__ __device__ void init(int M, int N, int G_, int c_) { nM = M / BM; nN = N / BM; nwg = nM * nN; G = G_; c = c_; }
    __host__ __device__ bool next(int i, Unit& u) const {
        const long L = (long)i * G + c; if (L >= nwg) return false;
        int wgid = (int)L; { const int q = nwg / NXCD, r = nwg % NXCD, xcd = wgid % NXCD, off = wgid / NXCD; wgid = (xcd < r ? xcd * (q + 1) : r * (q + 1) + (xcd - r) * q) + off; }
        const int nig = WGM * nN, gid = wgid / nig, fm = gid * WGM, gsz = (nM - fm) < WGM ? (nM - fm) : WGM;
        u.pm = fm + ((wgid % nig) % gsz); u.pn = (wgid % nig) / gsz; return true;
    }
    __device__ __forceinline__ void a_ready(const Unit&) const {}
    __device__ __forceinline__ void done(const Unit&) const {}
};

__device__ __forceinline__ unsigned cvt_pk_bf16(float lo, float hi) { unsigned r; asm volatile("v_cvt_pk_bf16_f32 %0, %1, %2" : "=v"(r) : "v"(lo), "v"(hi)); return r; }
typedef float f32x2 __attribute__((ext_vector_type(2)));
__device__ __forceinline__ f32x2 gelu_pk(f32x2 v) {
    const f32x2 av = __builtin_elementwise_abs(v), d = av * 0.2316418882f + 1.0f;
    f32x2 t; t.x = __builtin_amdgcn_rcpf(d.x); t.y = __builtin_amdgcn_rcpf(d.y);
    f32x2 q = t * 0.5307027145f + (-0.7265760135f); q = q * t + 0.7107068705f; q = q * t + (-0.142248368f); q = q * t + 0.127414796f; q = q * t;
    const f32x2 s = (v * v) * (-0.72134752044f);
    f32x2 e; e.x = __builtin_amdgcn_exp2f(s.x); e.y = __builtin_amdgcn_exp2f(s.y);
    const f32x2 m = v * (q * e), r = v - m;
    f32x2 o; o.x = v.x < 0.f ? m.x : r.x; o.y = v.y < 0.f ? m.y : r.y; return o;
}

template <int ACT  > struct EpiBf16 {
    static constexpr bool PERM = true, AFTER_DRAIN = false; static_assert(ACT == 0 || ACT == 1, "EpiBf16: ACT is 0 (none) or 1 (gelu_pk)");
    bf16_t* O; int ldc; const float* bias; int split_cols; size_t split_stride; float scale0;
    __device__ __forceinline__ void operator()(const f32x4 (&acc)[2][2][4][2], const Unit& u, int wr, int wc, int fr, int fq) const {
        const int row0 = u.pm * BM + wr * 64 + fr; int colt = u.pn * BM; bf16_t* base = O;
        float sc = 1.f; if (split_cols) { const int t = colt / split_cols; base += (size_t)t * split_stride; colt -= t * split_cols; if (t == 0) sc = scale0; }
        const int col0 = colt + wc * 32 + 8 * fq, bcol0 = u.pn * BM + wc * 32 + 8 * fq;
        f32x4 bv[2][2];
#pragma unroll
        for (int bj = 0; bj < 2; ++bj)
#pragma unroll
            for (int n = 0; n < 2; ++n) bv[bj][n] = bias ? *(const f32x4*)(bias + bcol0 + bj * HALF + 4 * n) : (f32x4){0.f, 0.f, 0.f, 0.f};
#pragma unroll
        for (int ai = 0; ai < 2; ++ai)
#pragma unroll
            for (int m = 0; m < 4; ++m) { bf16_t* rowp = base + (size_t)(row0 + ai * HALF + m * 16) * ldc + col0;
#pragma unroll
                for (int bj = 0; bj < 2; ++bj) { f32x4 v0 = acc[ai][bj][m][0] + bv[bj][0], v1 = acc[ai][bj][m][1] + bv[bj][1];
                    if (ACT == 1) { f32x2 a = gelu_pk((f32x2){v0[0], v0[1]}), b = gelu_pk((f32x2){v0[2], v0[3]}), c = gelu_pk((f32x2){v1[0], v1[1]}), d = gelu_pk((f32x2){v1[2], v1[3]});
                        v0 = (f32x4){a.x, a.y, b.x, b.y}; v1 = (f32x4){c.x, c.y, d.x, d.y}; }
                    v0 = v0 * sc; v1 = v1 * sc; u32x4 w; w.x = cvt_pk_bf16(v0[0], v0[1]); w.y = cvt_pk_bf16(v0[2], v0[3]); w.z = cvt_pk_bf16(v1[0], v1[1]); w.w = cvt_pk_bf16(v1[2], v1[3]);
                    *(u32x4*)(rowp + bj * HALF) = w; } }
    }
};

struct PanelStats {
    unsigned* xbuf;
    unsigned* cnt;
    unsigned* tmo;
    int ntn; float eps;
    unsigned code;
    __device__ __forceinline__ bool run(const f32x4 (&v)[2][2][4][2], const Unit& u, int wr, int wc, int fr, int fq, PG8_LAS unsigned char* lds, int wid, int lane) const {
        typedef float f32x2v __attribute__((ext_vector_type(2)));
        PG8_LAS f32x2v* P = (PG8_LAS f32x2v*)lds;
        PG8_LAS f32x2v* S = (PG8_LAS f32x2v*)(lds + 8192);
        PG8_LAS unsigned* flag = (PG8_LAS unsigned*)(lds + 8192 + 2048);
#pragma unroll
        for (int ai = 0; ai < 2; ++ai)
#pragma unroll
            for (int m = 0; m < 4; ++m) {
                float s = 0.f;
#pragma unroll
                for (int bj = 0; bj < 2; ++bj)
#pragma unroll
                    for (int n = 0; n < 2; ++n) { const f32x4 x = v[ai][bj][m][n]; s += (x[0] + x[1]) + (x[2] + x[3]); }
                s += __shfl_xor(s, 16); s += __shfl_xor(s, 32);
                const float mw = s * (1.0f / 64.0f); float q = 0.f;
#pragma unroll
                for (int bj = 0; bj < 2; ++bj)
#pragma unroll
                    for (int n = 0; n < 2; ++n) { const f32x4 d = v[ai][bj][m][n] - mw; q += (d[0] * d[0] + d[1] * d[1]) + (d[2] * d[2] + d[3] * d[3]); }
                q += __shfl_xor(q, 16); q += __shfl_xor(q, 32);
                if (fq == 0) P[(ai * HALF + wr * 64 + m * 16 + fr) * 4 + wc] = (f32x2v){mw, q};
            }
        asm volatile("s_waitcnt lgkmcnt(0)" ::: "memory"); __builtin_amdgcn_s_barrier(); asm volatile("" ::: "memory");
#if defined(BROKEN_EXCHANGE_NO_WAIT)
#warning BROKEN CONTROL BUILD: the row-statistics exchange does not wait; results are wrong by design
        if (blockIdx.x >= 64) { const long long t0_ = clock64(); while (clock64() - t0_ < 60000) __builtin_amdgcn_s_sleep(8); }
#endif
        const int row = wid * 32 + (lane & 31);
        if (lane < 32) {
            const f32x2v a = P[row * 4 + 0], b = P[row * 4 + 1], c = P[row * 4 + 2], d = P[row * 4 + 3];
            const float mt = (a.x + b.x + c.x + d.x) * 0.25f;
            const float da = a.x - mt, db = b.x - mt, dc = c.x - mt, dd = d.x - mt;
            const float m2 = (a.y + b.y) + (c.y + d.y) + 64.0f * ((da * da + db * db) + (dc * dc + dd * dd));
            unsigned long long* slot = (unsigned long long*)xbuf + ((size_t)(u.pm * BM + row) * 4 + u.pn);
            __hip_atomic_store(slot, ((unsigned long long)__float_as_uint(m2) << 32) | __float_as_uint(mt), __ATOMIC_RELAXED, __HIP_MEMORY_SCOPE_AGENT);
        }
        asm volatile("s_waitcnt vmcnt(0)" ::: "memory");
        if (lane == 0) __hip_atomic_fetch_add(cnt + 64 * u.pm, 1u, __ATOMIC_RELAXED, __HIP_MEMORY_SCOPE_AGENT);
        if (wid == 0) {
            bool dead = false; const unsigned long long t0 = __builtin_amdgcn_s_memrealtime(); const unsigned want = 8u * (unsigned)ntn;
            for (;;) {
#if defined(BROKEN_EXCHANGE_NO_WAIT)
                break;
#endif
                if ((unsigned)__builtin_amdgcn_readfirstlane(__hip_atomic_load(cnt + 64 * u.pm, __ATOMIC_RELAXED, __HIP_MEMORY_SCOPE_AGENT)) >= want) break;
                if (__builtin_amdgcn_s_memrealtime() - t0 > 2000000ull) {
                    if (lane == 0) { unsigned expect = 0u; __hip_atomic_compare_exchange_strong(tmo + 1, &expect, code | (unsigned)(u.pm & 0xff), __ATOMIC_RELAXED, __ATOMIC_RELAXED, __HIP_MEMORY_SCOPE_AGENT);
                                     __hip_atomic_store(tmo, 1u, __ATOMIC_RELAXED, __HIP_MEMORY_SCOPE_AGENT); }
                    dead = true; break; }
                __builtin_amdgcn_s_sleep(2);
            }
            __builtin_amdgcn_fence(__ATOMIC_ACQUIRE, "agent");
            if (lane == 0) flag[0] = dead ? 1u : 0u;
        }
        asm volatile("s_waitcnt vmcnt(0) lgkmcnt(0)" ::: "memory"); __builtin_amdgcn_s_barrier(); asm volatile("" ::: "memory");
        const bool bad = flag[0] != 0u;
        if (lane < 32) {
            const unsigned long long* slot = (const unsigned long long*)xbuf + (size_t)(u.pm * BM + row) * 4; float mt[4], m2[4]; float ms = 0.f;
#pragma unroll
            for (int t = 0; t < 4; ++t) { if (t < ntn) { const unsigned long long w = __hip_atomic_load(slot + t, __ATOMIC_RELAXED, __HIP_MEMORY_SCOPE_AGENT); mt[t] = __uint_as_float((unsigned)w); m2[t] = __uint_as_float((unsigned)(w >> 32)); } else { mt[t] = 0.f; m2[t] = 0.f; } ms += mt[t]; }
            const float mean = ms / (float)ntn; float q = 0.f;
#pragma unroll
            for (int t = 0; t < 4; ++t) if (t < ntn) { const float dm = mt[t] - mean; q += m2[t] + 256.0f * dm * dm; }
            S[row] = (f32x2v){mean, 1.0f / sqrtf(q / (256.0f * (float)ntn) + eps)};
        }
        asm volatile("s_waitcnt lgkmcnt(0)" ::: "memory"); __builtin_amdgcn_s_barrier(); asm volatile("" ::: "memory");
        return bad;
    }
};
struct EpiLnRes {
    static constexpr bool PERM = false, AFTER_DRAIN = true;
    const float* base; float* out; int ldc; const float* bias; PanelStats st; unsigned poison;
    __device__ __forceinline__ void fused(f32x4 (&acc)[2][2][4][2], const Unit& u, int wr, int wc, int fr, int fq, PG8_LAS unsigned char* lds, int wid, int lane) const {
        typedef float f32x2v __attribute__((ext_vector_type(2)));
        const PG8_LAS f32x2v* S = (const PG8_LAS f32x2v*)(lds + 8192);
        const int col0 = u.pn * BM + wc * 32 + 4 * fq;
#pragma unroll
        for (int bj = 0; bj < 2; ++bj)
#pragma unroll
            for (int n = 0; n < 2; ++n) { const f32x4 bv = bias ? *(const f32x4*)(bias + col0 + bj * HALF + n * 16) : (f32x4){0.f, 0.f, 0.f, 0.f};
#pragma unroll
                for (int ai = 0; ai < 2; ++ai)
#pragma unroll
                    for (int m = 0; m < 4; ++m) acc[ai][bj][m][n] += bv; }
        f32x4 pre[4][2][2];
#pragma unroll
        for (int m = 0; m < 4; ++m) { const size_t off = (size_t)(u.pm * BM + wr * 64 + m * 16 + fr) * ldc + col0;
#pragma unroll
            for (int bj = 0; bj < 2; ++bj)
#pragma unroll
                for (int n = 0; n < 2; ++n) pre[m][bj][n] = *(const f32x4*)(base + off + bj * HALF + n * 16); }
        const bool bad = st.run(acc, u, wr, wc, fr, fq, lds, wid, lane) || poison != 0u;
        const float qnan = __builtin_nanf("");
#pragma unroll
        for (int ai = 0; ai < 2; ++ai)
#pragma unroll
            for (int m = 0; m < 4; ++m) { const int r = ai * HALF + wr * 64 + m * 16 + fr; const f32x2v sr = S[r]; const size_t off = (size_t)(u.pm * BM + r) * ldc + col0;
#pragma unroll
                for (int bj = 0; bj < 2; ++bj)
#pragma unroll
                    for (int n = 0; n < 2; ++n) { const f32x4 bs = ai == 0 ? pre[m][bj][n] : *(const f32x4*)(base + off + bj * HALF + n * 16); f32x4 o = bs + (acc[ai][bj][m][n] - sr.x) * sr.y;
                        if (bad) o = (f32x4){qnan, qnan, qnan, qnan}; *(f32x4*)(out + off + bj * HALF + n * 16) = o; }
                if (m & 1) asm volatile("" ::: "memory"); }
    }
};
struct EpiLnResLn {
    static constexpr bool PERM = false, AFTER_DRAIN = true;
    const float* base; float* out; bf16_t* xn; int ldc; const float* bias; PanelStats st1, st2; unsigned poison;
    __device__ __forceinline__ void fused(f32x4 (&acc)[2][2][4][2], const Unit& u, int wr, int wc, int fr, int fq, PG8_LAS unsigned char* lds, int wid, int lane) const {
        typedef float f32x2v __attribute__((ext_vector_type(2))); typedef unsigned u32x2v __attribute__((ext_vector_type(2)));
        const PG8_LAS f32x2v* S = (const PG8_LAS f32x2v*)(lds + 8192);
        const int col0 = u.pn * BM + wc * 32 + 4 * fq;
#pragma unroll
        for (int bj = 0; bj < 2; ++bj)
#pragma unroll
            for (int n = 0; n < 2; ++n) { const f32x4 bv = bias ? *(const f32x4*)(bias + col0 + bj * HALF + n * 16) : (f32x4){0.f, 0.f, 0.f, 0.f};
#pragma unroll
                for (int ai = 0; ai < 2; ++ai)
#pragma unroll
                    for (int m = 0; m < 4; ++m) acc[ai][bj][m][n] += bv; }
        bool bad = st1.run(acc, u, wr, wc, fr, fq, lds, wid, lane) || poison != 0u;
        const float qnan = __builtin_nanf("");
#pragma unroll
        for (int ai = 0; ai < 2; ++ai)
#pragma unroll
            for (int m = 0; m < 4; ++m) { const int r = ai * HALF + wr * 64 + m * 16 + fr; const f32x2v sr = S[r]; const size_t off = (size_t)(u.pm * BM + r) * ldc + col0;
#pragma unroll
                for (int bj = 0; bj < 2; ++bj)
#pragma unroll
                    for (int n = 0; n < 2; ++n) { const f32x4 bs = *(const f32x4*)(base + off + bj * HALF + n * 16); acc[ai][bj][m][n] = bs + (acc[ai][bj][m][n] - sr.x) * sr.y; }
                asm volatile("" : "+v"(acc[ai][0][m][0]), "+v"(acc[ai][0][m][1]), "+v"(acc[ai][1][m][0]), "+v"(acc[ai][1][m][1]));
                if (m & 1) asm volatile("" ::: "memory"); }
        const bool bad1 = bad;
        bad = st2.run(acc, u, wr, wc, fr, fq, lds, wid, lane) || bad;
#pragma unroll
        for (int ai = 0; ai < 2; ++ai)
#pragma unroll
            for (int m = 0; m < 4; ++m) { const int r = ai * HALF + wr * 64 + m * 16 + fr; const f32x2v sr = S[r]; const size_t off = (size_t)(u.pm * BM + r) * ldc + col0;
#pragma unroll
                for (int bj = 0; bj < 2; ++bj)
#pragma unroll
                    for (int n = 0; n < 2; ++n) { const f32x4 x1 = acc[ai][bj][m][n]; *(f32x4*)(out + off + bj * HALF + n * 16) = bad1 ? (f32x4){qnan, qnan, qnan, qnan} : x1;
                        const f32x4 o = (x1 - sr.x) * sr.y; u32x2v w; w.x = cvt_pk_bf16(o[0], o[1]); w.y = cvt_pk_bf16(o[2], o[3]);
                        if (bad) { w.x = 0x7fc07fc0u; w.y = 0x7fc07fc0u; } *(u32x2v*)(xn + off + bj * HALF + n * 16) = w; }
                asm volatile("" ::: "memory"); }
    }
};

template <class Epi, class Sched, bool ALIGN_EPI = false, bool SP2 = false>
__device__ __forceinline__ void gemm_phase(PG8_LAS unsigned char* lds, const Gemm g, const Sched& S, const Epi& E) {
    const int tid = threadIdx.x, wid = __builtin_amdgcn_readfirstlane(tid >> 6), lane = tid & 63, wr = wid >> 2, wc = wid & 3, fr = lane & 15, fq = lane >> 4;
    const int K = g.K, nt = K / BK;
    unsigned voffA[2], voffB[2];
#pragma unroll
    for (int i = 0; i < 2; ++i) { int R, C; stage_rc(tid * 16 + i * 8192, R, C); const int Rb = Epi::PERM ? ((R & ~31) + perm32(R & 31)) : R;
        voffA[i] = (unsigned)(R * K + C) * 2u; voffB[i] = (unsigned)(Rb * K + C) * 2u; }
    const size_t kstep = (size_t)(BK * 2);
    const size_t hstep = (size_t)HALF * K * 2;
    const size_t tstep = 2 * hstep;
    const unsigned ldsw = (unsigned)wid * 1024u;
    const int aoff = lds_byte(wr * 64 + fr, fq * 8), boff = lds_byte(wc * 32 + fr, fq * 8);
#define PG8_SA(b, h) (((b) * 2 + (h)) * HTB)
#define PG8_SB(b, h) ((4 + (b) * 2 + (h)) * HTB)
#define PG8_STAGE(bufoff, gbase, voff) do { _Pragma("unroll") for (int _i = 0; _i < 2; ++_i) \
        __builtin_amdgcn_global_load_lds((const unsigned*)((const char*)(gbase) + (voff)[_i]), (PG8_LAS unsigned*)(lds + (bufoff) + ldsw + _i * 8192), 16, 0, 0); } while (0)
#define PG8_LDA(dst, b, h) do { _Pragma("unroll") for (int m = 0; m < 4; ++m) _Pragma("unroll") for (int k = 0; k < 2; ++k) dst[m][k] = *(const PG8_LAS bf16x8*)(lds + PG8_SA(b, h) + aoff + m * 2048 + k * 1024); } while (0)
#define PG8_LDB(dst, b, h) do { _Pragma("unroll") for (int n = 0; n < 2; ++n) _Pragma("unroll") for (int k = 0; k < 2; ++k) dst[n][k] = *(const PG8_LAS bf16x8*)(lds + PG8_SB(b, h) + boff + n * 2048 + k * 1024); } while (0)
#define PG8_MMA(ai, bj, At, Bt) do { __builtin_amdgcn_s_setprio(1); _Pragma("unroll") for (int m = 0; m < 4; ++m) _Pragma("unroll") for (int n = 0; n < 2; ++n) _Pragma("unroll") for (int k = 0; k < 2; ++k) \
        acc[ai][bj][m][n] = __builtin_amdgcn_mfma_f32_16x16x32_bf16(Bt[n][k], At[m][k], acc[ai][bj][m][n], 0, 0, 0); __builtin_amdgcn_s_setprio(0); } while (0)
#define PG8_WAIT_V(n) asm volatile("s_waitcnt vmcnt(" #n ")" ::: "memory")
#define PG8_WAIT_L(n) asm volatile("s_waitcnt lgkmcnt(" #n ")" ::: "memory")
#define PG8_BAR __builtin_amdgcn_s_barrier()
#define PG8_SCHED __builtin_amdgcn_sched_barrier(0)
    Unit cur, nxt; int ui = 0;
    if (!S.next(0, cur)) return;
    f32x4 acc[2][2][4][2];
#pragma unroll
    for (int a = 0; a < 2; ++a)
#pragma unroll
        for (int b = 0; b < 2; ++b)
#pragma unroll
            for (int m = 0; m < 4; ++m)
#pragma unroll
                for (int n = 0; n < 2; ++n) acc[a][b][m][n] = (f32x4){0.f, 0.f, 0.f, 0.f};
    bf16x8 At[4][2], B0[2][2], B1[2][2];
    const char* cA = (const char*)g.A + (size_t)cur.pm * tstep; const char* cB = (const char*)g.Bt + (size_t)cur.pn * tstep;
    S.a_ready(cur);
    if constexpr (SP2) {
        PG8_STAGE(PG8_SB(0, 0), cB, voffB); PG8_STAGE(PG8_SB(0, 1), cB + hstep, voffB); PG8_STAGE(PG8_SA(0, 0), cA, voffA); PG8_STAGE(PG8_SA(0, 1), cA + hstep, voffA);
        if (wr == 1) PG8_BAR;
        PG8_WAIT_V(2); PG8_BAR;
        PG8_STAGE(PG8_SB(1, 0), cB + kstep, voffB); PG8_STAGE(PG8_SA(1, 0), cA + kstep, voffA); PG8_STAGE(PG8_SB(1, 1), cB + hstep + kstep, voffB);
        PG8_WAIT_V(6); PG8_BAR;
    } else {
        PG8_STAGE(PG8_SB(0, 0), cB, voffB); PG8_STAGE(PG8_SA(0, 0), cA, voffA); PG8_STAGE(PG8_SB(0, 1), cB + hstep, voffB); PG8_STAGE(PG8_SA(0, 1), cA + hstep, voffA);
        if (wr == 1) PG8_BAR;
        PG8_WAIT_V(4); PG8_BAR;
        PG8_STAGE(PG8_SB(1, 0), cB + kstep, voffB); PG8_STAGE(PG8_SA(1, 0), cA + kstep, voffA); PG8_STAGE(PG8_SB(1, 1), cB + hstep + kstep, voffB);
        PG8_WAIT_V(6); PG8_BAR;
    }
    for (;;) {
        const bool has_next = S.next(ui + 1, nxt);
        const char* nA = has_next ? (const char*)g.A + (size_t)nxt.pm * tstep : cA; const char* nB = has_next ? (const char*)g.Bt + (size_t)nxt.pn * tstep : cB;
        for (int t = 0; t < nt; t += 2) {
            const bool last = (t == nt - 2);
            const char* a1 = cA + (size_t)(t + 1) * kstep;
            const char* a2 = last ? nA : cA + (size_t)(t + 2) * kstep; const char* b2 = last ? nB : cB + (size_t)(t + 2) * kstep;
            const char* a3 = a2 + kstep; const char* b3 = b2 + kstep;
            if (last && has_next) S.a_ready(nxt);
            if constexpr (SP2) {
            PG8_LDB(B0, 0, 0); PG8_LDB(B1, 0, 1); PG8_SCHED; PG8_LDA(At, 0, 0); PG8_STAGE(PG8_SA(1, 1), a1 + hstep, voffA);
            PG8_WAIT_V(8); PG8_WAIT_L(0); PG8_BAR; PG8_MMA(0, 0, At, B0); PG8_MMA(0, 1, At, B1); PG8_BAR; PG8_SCHED;
            PG8_LDA(At, 0, 1); PG8_STAGE(PG8_SB(0, 0), b2, voffB); PG8_STAGE(PG8_SB(0, 1), b2 + hstep, voffB); PG8_STAGE(PG8_SA(0, 0), a2, voffA);
            PG8_WAIT_V(8); PG8_WAIT_L(0); PG8_BAR; PG8_MMA(1, 0, At, B0); PG8_MMA(1, 1, At, B1); PG8_BAR; PG8_SCHED;
            PG8_LDB(B0, 1, 0); PG8_LDB(B1, 1, 1); PG8_SCHED; PG8_LDA(At, 1, 0); PG8_STAGE(PG8_SA(0, 1), a2 + hstep, voffA);
            PG8_WAIT_V(8); PG8_WAIT_L(0); PG8_BAR; PG8_MMA(0, 0, At, B0); PG8_MMA(0, 1, At, B1); PG8_BAR; PG8_SCHED;
            PG8_LDA(At, 1, 1); PG8_STAGE(PG8_SB(1, 0), b3, voffB); PG8_STAGE(PG8_SB(1, 1), b3 + hstep, voffB); PG8_STAGE(PG8_SA(1, 0), a3, voffA);
            PG8_WAIT_V(8); PG8_WAIT_L(0); PG8_BAR; PG8_MMA(1, 0, At, B0); PG8_MMA(1, 1, At, B1); PG8_BAR; PG8_SCHED;
            } else {
            PG8_LDB(B0, 0, 0); PG8_SCHED; PG8_LDA(At, 0, 0); PG8_STAGE(PG8_SA(1, 1), a1 + hstep, voffA);
            PG8_WAIT_L(8); PG8_BAR; PG8_WAIT_L(0); PG8_MMA(0, 0, At, B0); PG8_BAR; PG8_SCHED;
            PG8_LDB(B1, 0, 1); PG8_STAGE(PG8_SB(0, 0), b2, voffB);
            PG8_BAR; PG8_WAIT_L(0); PG8_MMA(0, 1, At, B1); PG8_BAR;
            PG8_LDA(At, 0, 1); PG8_STAGE(PG8_SA(0, 0), a2, voffA);
            PG8_BAR; PG8_WAIT_L(0); PG8_MMA(1, 0, At, B0); PG8_BAR; PG8_SCHED;
            PG8_STAGE(PG8_SB(0, 1), b2 + hstep, voffB);
            PG8_WAIT_V(6); PG8_BAR; PG8_MMA(1, 1, At, B1); PG8_BAR;
            PG8_LDB(B0, 1, 0); PG8_SCHED; PG8_LDA(At, 1, 0); PG8_STAGE(PG8_SA(0, 1), a2 + hstep, voffA);
            PG8_WAIT_L(8); PG8_BAR; PG8_WAIT_L(0); PG8_MMA(0, 0, At, B0); PG8_BAR; PG8_SCHED;
            PG8_LDB(B1, 1, 1); PG8_STAGE(PG8_SB(1, 0), b3, voffB);
            PG8_BAR; PG8_WAIT_L(0); PG8_MMA(0, 1, At, B1); PG8_BAR;
            PG8_LDA(At, 1, 1); PG8_STAGE(PG8_SA(1, 0), a3, voffA);
            PG8_BAR; PG8_WAIT_L(0); PG8_MMA(1, 0, At, B0); PG8_BAR; PG8_SCHED;
            PG8_STAGE(PG8_SB(1, 1), b3 + hstep, voffB);
            PG8_WAIT_V(6); PG8_BAR; PG8_MMA(1, 1, At, B1); PG8_BAR;
            }
        }
        if constexpr (ALIGN_EPI) { if (wr == 0) PG8_BAR; }
        if constexpr (!Epi::AFTER_DRAIN) { E(acc, cur, wr, wc, fr, fq); S.done(cur); }
        if (!has_next) break;
#pragma unroll
        for (int a = 0; a < 2; ++a)
#pragma unroll
            for (int b = 0; b < 2; ++b)
#pragma unroll
                for (int m = 0; m < 4; ++m)
#pragma unroll
                    for (int n = 0; n < 2; ++n) acc[a][b][m][n] = (f32x4){0.f, 0.f, 0.f, 0.f};
        cur = nxt; cA = nA; cB = nB; ++ui;
        if constexpr (ALIGN_EPI) { if (wr == 1) PG8_BAR; }
    }
    PG8_WAIT_V(0);
    if constexpr (!ALIGN_EPI) { if (wr == 0) PG8_BAR; }
    PG8_BAR;
    if constexpr (Epi::AFTER_DRAIN) { E.fused(acc, cur, wr, wc, fr, fq, lds, wid, lane); S.done(cur); }
#undef PG8_SA
#undef PG8_SB
#undef PG8_STAGE
#undef PG8_LDA
#undef PG8_LDB
#undef PG8_MMA
#undef PG8_WAIT_V
#undef PG8_WAIT_L
#undef PG8_BAR
#undef PG8_SCHED
}
}
#define GAS __attribute__((address_space(1)))
#define LAS __attribute__((address_space(3)))
typedef unsigned short bf16;
typedef unsigned v4u __attribute__((ext_vector_type(4)));
typedef float f32x4 __attribute__((ext_vector_type(4)));
typedef short bf16x8 __attribute__((ext_vector_type(8)));
typedef GAS unsigned gu32;
typedef GAS unsigned long long gu64;
#define RLX_AGENT __ATOMIC_RELAXED, __HIP_MEMORY_SCOPE_AGENT
#define LDS_WAIT() asm volatile("s_waitcnt lgkmcnt(0)" ::: "memory")
#define VM_WAIT() asm volatile("s_waitcnt vmcnt(0)" ::: "memory")
__device__ __forceinline__ unsigned long long rt() { return __builtin_amdgcn_s_memrealtime(); }
__device__ __forceinline__ unsigned f2bf(float f) { unsigned u = __builtin_bit_cast(unsigned, f); return (u + 0x7fffu + ((u >> 16) & 1u)) >> 16; }
__device__ __forceinline__ unsigned pk2(float lo, float hi) { return f2bf(lo) | (f2bf(hi) << 16); }

#define XB_TMO      128
#define XB_XCNT(j)  (256  + 64 * (j))
#define XB_XSUB(j)  (1280 + 64 * (j))
#define XB_XGEN(j)  (2304 + 64 * (j))
#define XB_TOP      3328
#define XB_TOPGEN   3392
#define XCD_BAR_WORDS 3456
#define XB_SPIN_CAP (1u << 18)

__device__ __forceinline__ unsigned xb_ld(unsigned* p)              { return __hip_atomic_load(p, __ATOMIC_RELAXED, __HIP_MEMORY_SCOPE_AGENT); }
__device__ __forceinline__ unsigned xb_add(unsigned* p, unsigned v) { return __hip_atomic_fetch_add(p, v, __ATOMIC_RELAXED, __HIP_MEMORY_SCOPE_AGENT); }
__device__ __forceinline__ unsigned xb_xcc_id() { return (unsigned)__builtin_amdgcn_s_getreg((3 << 11) | 20) & 0xFu; }
#define XB_SPIN(cond, bar) do { unsigned _sp = 0; while (cond) { __builtin_amdgcn_s_sleep(1); \
    if ((++_sp & 255u) == 0u) { if (xb_ld(&(bar)[XB_TMO])) break; if (_sp > XB_SPIN_CAP) { atomicAdd(&(bar)[XB_TMO], 1u); break; } } } } while (0)

struct XcdBarrier {
    unsigned* bar; unsigned x;
    volatile LAS unsigned* st;
};

__device__ __forceinline__ XcdBarrier xcd_barrier_post(unsigned* bar, volatile LAS unsigned* st) {
    XcdBarrier b; b.bar = bar; b.x = xb_xcc_id(); b.st = st;
    if (threadIdx.x == 0) (void)xb_add(&bar[XB_XCNT(b.x)], 1u);
    return b;
}
__device__ __forceinline__ void xcd_barrier_complete(unsigned* bar, unsigned x, unsigned& nloc, unsigned& nx) {
    const unsigned G = gridDim.x * gridDim.y * gridDim.z;
    unsigned sum, cnt, mine, sp = 0u;
    for (;;) {
        sum = 0u; cnt = 0u; mine = 0u;
#pragma unroll
        for (unsigned j = 0; j < 16; ++j) { const unsigned c = xb_ld(&bar[XB_XCNT(j)]); sum += c; cnt += (c > 0u) ? 1u : 0u; mine = (j == x) ? c : mine; }
        if (sum == G) break;
        __builtin_amdgcn_s_sleep(1);
        if ((++sp & 255u) == 0u) { if (xb_ld(&bar[XB_TMO])) break; if (sp > XB_SPIN_CAP) { atomicAdd(&bar[XB_TMO], 1u); break; } }
    }
    nloc = mine > 0u ? mine : 1u; nx = cnt > 0u ? cnt : 1u;
}

__device__ __forceinline__ void xcd_barrier(const XcdBarrier& b) {
    asm volatile("s_waitcnt vmcnt(0)" ::: "memory");
    __syncthreads();
    if (threadIdx.x == 0) {
        unsigned* bar = b.bar;
        __builtin_amdgcn_s_waitcnt(0);
        unsigned nloc = b.st[0], nx = b.st[1];
        if (nloc == 0u) { xcd_barrier_complete(bar, b.x, nloc, nx); b.st[0] = nloc; b.st[1] = nx; }
        const unsigned old = xb_add(&bar[XB_XSUB(b.x)], 1u);
        const unsigned gen = old / nloc;
        if (old + 1u == (gen + 1u) * nloc) {
            __builtin_amdgcn_fence(__ATOMIC_RELEASE, "agent");
            asm volatile("s_waitcnt vmcnt(0)" ::: "memory");
            const unsigned og = xb_add(&bar[XB_TOP], 1u);
            const unsigned tg = og / nx;
            if (og + 1u == (tg + 1u) * nx) xb_add(&bar[XB_TOPGEN], 1u);
            else XB_SPIN(xb_ld(&bar[XB_TOPGEN]) == tg, bar);
            __builtin_amdgcn_fence(__ATOMIC_ACQUIRE, "agent");
            xb_add(&bar[XB_XGEN(b.x)], 1u);
            asm volatile("s_waitcnt vmcnt(0)" ::: "memory");
        } else {
            XB_SPIN(xb_ld(&bar[XB_XGEN(b.x)]) == gen, bar);
            __builtin_amdgcn_fence(__ATOMIC_ACQUIRE, "agent");
            asm volatile("s_waitcnt vmcnt(0)" ::: "memory");
        }
    }
    __syncthreads();
}
constexpr int NWAVES = 8;
#ifndef MK_N_LAUNCHES
#define MK_N_LAUNCHES 1
#endif
constexpr int N_PHASES = 8;
constexpr int N_LAUNCHES = MK_N_LAUNCHES;

constexpr int BATCH = 2, T = 8192, D = 1024, M = BATCH * T;
constexpr int NIN = 3200, LDP = 3328;
constexpr int SEG0 = 1024;
constexpr int C_R = 0, C_WLO = 512, C_K = 576, C_V = 1088, C_ALO = 1600, C_Z = 1664;
constexpr float NORM_EPS = 1e-6f, GN_EPS = 64e-5f;

constexpr size_t MiB = 1u << 20;
constexpr size_t WS_CTL = 0, CTL_ZERO_BYTES = 1 * MiB;
constexpr size_t WS_W1T = 1 * MiB, WS_W2T = 8 * MiB, WS_XN = 10 * MiB, WS_P = 42 * MiB, WS_MIX = 146 * MiB, WS_BONUS = 27 * MiB;
constexpr size_t WS_WUPT = 7 * MiB + 512 * 1024, WS_AUPT = WS_WUPT + 65536, WS_YI = 10 * MiB, WS_WC = 26 * MiB, WS_PT = 178 * MiB, WS_QM = 210 * MiB, WS_PRM = 7 * MiB + 768 * 1024, WS_POOLWT = 7 * MiB + 832 * 1024;
constexpr size_t WS_END = 256 * MiB;
constexpr int CW_BAR = 4096;
constexpr size_t CTL_MOD = 65536, CTL_ROWSS = 131072;

constexpr int RING_BYTES = 131072, LDSCTL_OFF = 163328 - 64, MISC_OFF = LDSCTL_OFF + 320, LDS_BYTES = 163840;

struct Frame {
    LAS unsigned char* lds;
    volatile LAS unsigned* MISC;
    int tid, lane, wave, vcu, G;
    const float *x, *c, *w_ada, *b_ada, *norm_g, *w_in, *pool_w, *pool_scale, *mu, *w0, *w_up, *a0, *a_up, *k_k, *k_a, *r_k, *ln_w, *ln_b, *w_out, *final_g;
    float* out;
    float *mod, *rowss, *bonus;
    bf16 *W1t, *W2t, *XN, *P, *MIX, *WUPT, *AUPT, *YI, *PT, *QM, *POOLWT;
    float *WC, *PRM;
};

__device__ __forceinline__ float bf2f(unsigned short u) { return __builtin_bit_cast(float, (unsigned)u << 16); }
__device__ __forceinline__ float bflo(unsigned u) { return __builtin_bit_cast(float, u << 16); }
__device__ __forceinline__ float bfhi(unsigned u) { return __builtin_bit_cast(float, u & 0xffff0000u); }
__device__ __forceinline__ float sigmoidf_(float v) { return __builtin_amdgcn_rcpf(1.f + __expf(-v)); }
__device__ __forceinline__ float siluf_(float v) { return v * __builtin_amdgcn_rcpf(1.f + __expf(-v)); }
__device__ __forceinline__ float wave_sum(float v) {
#pragma unroll
    for (int o = 1; o < 64; o <<= 1) v += __shfl_xor(v, o);
    return v;
}

__device__ __forceinline__ void p0_transpose_item(const float* W, int K, int N, bf16* WT, LAS float* scr, int item, int lane) {
    const int nblk = N / 32, kb = item / nblk, nb = item % nblk, k0 = 64 * kb, n0 = 32 * nb;
#pragma unroll 8
    for (int i = 0; i < 32; ++i) { const int kk = 2 * i + (lane >> 5); scr[kk * 33 + (lane & 31)] = W[(size_t)(k0 + kk) * N + n0 + (lane & 31)]; }
    LDS_WAIT(); asm volatile("" ::: "memory");
    const int c = lane & 7;
#pragma unroll
    for (int j = 0; j < 4; ++j) { const int n = (lane >> 3) + 8 * j; const LAS float* s = scr + (8 * c) * 33 + n;
        v4u o; o.x = pk2(s[0 * 33], s[1 * 33]); o.y = pk2(s[2 * 33], s[3 * 33]); o.z = pk2(s[4 * 33], s[5 * 33]); o.w = pk2(s[6 * 33], s[7 * 33]);
        *(v4u*)(WT + (size_t)(n0 + n) * K + k0 + 8 * c) = o; }
    LDS_WAIT(); asm volatile("" ::: "memory");
}

__device__ __forceinline__ void p0_prologue(Frame& F) {
    LAS float* scr = (LAS float*)(F.lds + F.wave * 16384);
    const int gw = F.vcu * NWAVES + F.wave, NGW = F.G * NWAVES;
    constexpr int I_1 = (D / 64) * (NIN / 32), I_2 = (D / 64) * (D / 32), I_Z = (LDP - NIN) * D * 2 / 1024, I_L = 16, I_P = 32;
    for (int it = gw; it < I_1 + I_2 + I_Z + 2 * I_L + I_P; it += NGW) {
        int r = it;
        if (r < I_1) { p0_transpose_item(F.w_in, D, NIN, F.W1t, scr, r, F.lane); continue; } r -= I_1;
        if (r < I_2) { p0_transpose_item(F.w_out, D, D, F.W2t, scr, r, F.lane); continue; } r -= I_2;
        if (r < I_Z) { *(v4u*)((unsigned char*)(F.W1t + (size_t)NIN * D) + (size_t)r * 1024 + F.lane * 16) = (v4u){0u, 0u, 0u, 0u}; continue; } r -= I_Z;
        if (r < I_L) { p0_transpose_item(F.w_up, 64, 512, F.WUPT, scr, r, F.lane); continue; } r -= I_L;
        if (r < I_L) { p0_transpose_item(F.a_up, 64, 512, F.AUPT, scr, r, F.lane); continue; } r -= I_L;
        p0_transpose_item(F.pool_w + (size_t)(r >> 3) * 16384, 128, 128, F.POOLWT + (size_t)(r >> 3) * 16384, scr, r & 7, F.lane);
    }
    { const int gt = blockIdx.x * (NWAVES * 64) + F.tid;
      if (gt < 512) { float* o = F.PRM + gt * 8; o[0] = F.w0[gt]; o[1] = F.a0[gt]; o[2] = F.k_k[gt]; o[3] = F.k_a[gt]; o[4] = F.r_k[gt]; o[5] = F.mu[C_R + gt]; o[6] = F.mu[C_K + gt]; o[7] = F.mu[C_V + gt]; }
      else if (gt < 576) F.PRM[4096 + gt - 512] = F.mu[C_WLO + gt - 512];
      else if (gt < 640) F.PRM[4096 + gt - 512] = F.mu[C_ALO + gt - 576]; }
    __syncthreads();
    LAS float* red = (LAS float*)F.lds;
    for (int u = blockIdx.x; u < 192; u += F.G) {
        const int cg = u % 48, ks = u / 48, n = cg * 64 + F.lane, k0 = ks * 256 + F.wave * 32;
        float s0 = 0.f, s1 = 0.f;
#pragma unroll 8
        for (int kk = 0; kk < 32; ++kk) { const float wv = F.w_ada[(size_t)(k0 + kk) * 3072 + n]; s0 += F.c[k0 + kk] * wv; s1 += F.c[D + k0 + kk] * wv; }
        red[F.wave * 128 + F.lane] = s0; red[F.wave * 128 + 64 + F.lane] = s1;
        __syncthreads();
        if (F.wave < 2) { float s = 0.f;
#pragma unroll
            for (int w = 0; w < 8; ++w) s += red[w * 128 + F.wave * 64 + F.lane];
            if (ks == 0) s += F.b_ada[n];
            __hip_atomic_fetch_add(F.mod + F.wave * 3072 + n, s, __ATOMIC_RELAXED, __HIP_MEMORY_SCOPE_AGENT); }
        __syncthreads();
    }
}

__device__ __forceinline__ void p1_hrows(Frame& F) {
    const int gw = F.vcu * NWAVES + F.wave, NGW = F.G * NWAVES;
    for (int m = gw; m < M; m += NGW) {
        const int b = m >> 13;
        const f32x4* xr = (const f32x4*)(F.x + (size_t)m * D) + F.lane;
        f32x4 v[4]; float s = 0.f;
#pragma unroll
        for (int j = 0; j < 4; ++j) { v[j] = xr[64 * j]; s += (v[j].x * v[j].x + v[j].y * v[j].y) + (v[j].z * v[j].z + v[j].w * v[j].w); }
        const float rstd = 1.f / sqrtf(wave_sum(s) * (1.f / D) + NORM_EPS);
        unsigned long long* o8 = (unsigned long long*)(F.XN + (size_t)m * D) + F.lane;
#pragma unroll
        for (int j = 0; j < 4; ++j) {
            const f32x4 g = ((const f32x4*)F.norm_g)[F.lane + 64 * j];
            const f32x4 sh = ((const f32x4*)(F.mod + b * 3072))[F.lane + 64 * j];
            const f32x4 sc = ((const f32x4*)(F.mod + b * 3072 + 1024))[F.lane + 64 * j];
            const f32x4 h = v[j] * rstd * g * (sc + 1.f) + sh;
            o8[64 * j] = (unsigned long long)pk2(h.x, h.y) | ((unsigned long long)pk2(h.z, h.w) << 32);
        }
    }
}

template <int GI> __device__ __forceinline__ void pool_item(Frame& F, int tb, LAS float* scr) {
    constexpr int WIN = 2 << GI;
    const int t0 = tb * 8, pos0 = t0 & (T - 1), lane = F.lane;
    float u0[23], u1[23];
#pragma unroll
    for (int q = 0; q < 23; ++q) { const int pos = pos0 - 15 + q; unsigned w = 0u;
        if (q >= 16 - WIN) { if (pos >= 0) w = *(const unsigned*)(F.P + (size_t)(t0 - 15 + q) * LDP + GI * 128 + 2 * lane); }
        u0[q] = bflo(w); u1[q] = bfhi(w); }
#pragma unroll
    for (int tt = 0; tt < 8; ++tt) { float s0 = 0.f, s1 = 0.f;
#pragma unroll
        for (int q = 0; q < WIN; ++q) { s0 += u0[tt + 15 - q]; s1 += u1[tt + 15 - q]; }
        const int pos = pos0 + tt; const float cnt = (float)((pos + 1 < WIN) ? (pos + 1) : WIN);
        scr[(2 * lane) * 8 + tt] = s0 / cnt - u0[tt + 15]; scr[(2 * lane + 1) * 8 + tt] = s1 / cnt - u1[tt + 15]; }
    LDS_WAIT(); asm volatile("" ::: "memory");
    float acc0[8], acc1[8];
#pragma unroll
    for (int tt = 0; tt < 8; ++tt) { acc0[tt] = 0.f; acc1[tt] = 0.f; }
    const float* pw = F.pool_w + (size_t)GI * 128 * 128 + 2 * lane;
#pragma unroll 4
    for (int c = 0; c < 128; ++c) {
        const f32x4 da = *(const LAS f32x4*)(scr + c * 8), db = *(const LAS f32x4*)(scr + c * 8 + 4);
        const float w0 = pw[c * 128], w1 = pw[c * 128 + 1];
        acc0[0] += da.x * w0; acc1[0] += da.x * w1; acc0[1] += da.y * w0; acc1[1] += da.y * w1; acc0[2] += da.z * w0; acc1[2] += da.z * w1; acc0[3] += da.w * w0; acc1[3] += da.w * w1;
        acc0[4] += db.x * w0; acc1[4] += db.x * w1; acc0[5] += db.y * w0; acc1[5] += db.y * w1; acc0[6] += db.z * w0; acc1[6] += db.z * w1; acc0[7] += db.w * w0; acc1[7] += db.w * w1;
    }
    const float ps0 = F.pool_scale[GI * 128 + 2 * lane], ps1 = F.pool_scale[GI * 128 + 2 * lane + 1];
#pragma unroll
    for (int tt = 0; tt < 8; ++tt) {
        const unsigned zw = *(const unsigned*)(F.P + (size_t)(t0 + tt) * LDP + 512 + GI * 128 + 2 * lane);
        const float y0 = acc0[tt] * ps0 * siluf_(bflo(zw)), y1 = acc1[tt] * ps1 * siluf_(bfhi(zw));
        *(unsigned*)(F.MIX + (size_t)(t0 + tt) * D + GI * 128 + 2 * lane) = pk2(y0, y1);
    }
    LDS_WAIT(); asm volatile("" ::: "memory");
}

typedef float f32x16 __attribute__((ext_vector_type(16)));
typedef float f32x8 __attribute__((ext_vector_type(8)));
typedef __bf16 bf16x8v __attribute__((ext_vector_type(8)));
typedef __bf16 bf16x4v __attribute__((ext_vector_type(4)));
typedef unsigned u32x2 __attribute__((ext_vector_type(2)));
#define MFMA32(a, b, c) __builtin_amdgcn_mfma_f32_32x32x16_bf16((a), (b), (c), 0, 0, 0)
#define MFMA16(a, b, c) __builtin_amdgcn_mfma_f32_16x16x32_bf16((a), (b), (c), 0, 0, 0)

__device__ __forceinline__ bf16x8 cvt8(f32x8 v) { return __builtin_bit_cast(bf16x8, __builtin_convertvector(v, bf16x8v)); }
__device__ __forceinline__ u32x2 cvt4(f32x4 v) { return __builtin_bit_cast(u32x2, __builtin_convertvector(v, bf16x4v)); }
__device__ __forceinline__ bf16x8 pack_lo(const f32x16& x) { return cvt8(__builtin_shufflevector(x, x, 0, 1, 2, 3, 4, 5, 6, 7)); }
__device__ __forceinline__ bf16x8 pack_hi(const f32x16& x) { return cvt8(__builtin_shufflevector(x, x, 8, 9, 10, 11, 12, 13, 14, 15)); }
__device__ __forceinline__ f32x8 unpack8(bf16x8 p) { const v4u w = __builtin_bit_cast(v4u, p); return (f32x8){bflo(w.x), bfhi(w.x), bflo(w.y), bfhi(w.y), bflo(w.z), bfhi(w.z), bflo(w.w), bfhi(w.w)}; }
__device__ __forceinline__ f32x16 unpack16(bf16x8 lo, bf16x8 hi) { const f32x8 a = unpack8(lo), b = unpack8(hi); return __builtin_shufflevector(a, b, 0, 1, 2, 3, 4, 5, 6, 7, 8, 9, 10, 11, 12, 13, 14, 15); }
__device__ __forceinline__ f32x4 unpack4(u32x2 w) { return (f32x4){bflo(w.x), bfhi(w.x), bflo(w.y), bfhi(w.y)}; }
__device__ __forceinline__ float tanh_fast(float x) { return 1.f - 2.f * __builtin_amdgcn_rcpf(1.f + __expf(2.f * x)); }
#define CROW(reg, h) (((reg) & 3) + 8 * ((reg) >> 2) + 4 * (h))
__device__ __forceinline__ f32x16 zero16() { f32x16 z;
#pragma unroll
    for (int i = 0; i < 16; ++i) z[i] = 0.f; return z; }

struct PK2 { bf16x8 s[2]; };
__device__ __forceinline__ PK2 pack2(const f32x16& x) { PK2 p; p.s[0] = pack_lo(x); p.s[1] = pack_hi(x); return p; }

typedef __amdgpu_buffer_rsrc_t rsrc_t;
__device__ __forceinline__ rsrc_t mkrsrc(const void* p) { return __builtin_amdgcn_make_buffer_rsrc((void*)p, 0, 0x7fffffff, 0x00020000); }
#define BLD128(rs, voff, soff) __builtin_bit_cast(v4u, __builtin_amdgcn_raw_buffer_load_b128((rs), (voff), (soff), 0))
#define BLD64(rs, voff, soff) __builtin_bit_cast(u32x2, __builtin_amdgcn_raw_buffer_load_b64((rs), (voff), (soff), 0))
#define BLDF(rs, voff, soff) __builtin_bit_cast(float, __builtin_amdgcn_raw_buffer_load_b32((rs), (voff), (soff), 0))
#define BST64(v, rs, voff, soff) __builtin_amdgcn_raw_buffer_store_b64((v), (rs), (voff), (soff), 0)
#define BST32F(v, rs, voff, soff) __builtin_amdgcn_raw_buffer_store_b32(__builtin_bit_cast(unsigned, (float)(v)), (rs), (voff), (soff), 0)
#define BST16(v, rs, voff, soff) __builtin_amdgcn_raw_buffer_store_b16((unsigned short)(v), (rs), (voff), (soff), 0)

__device__ __forceinline__ void pass1_item(Frame& F, int it, LAS unsigned char* lds, LAS float* wct) {
    const int head = it & 7, cc = (it >> 3) & 255, b = it >> 11;
    int lane = F.lane, c, h;
#define REFRESH do { asm volatile("" : "+v"(lane)); c = lane & 31; h = lane >> 5; } while (0)
    REFRESH;
    const int row0 = b * T + 32 * cc, pos0 = 32 * cc;
    const rsrc_t rsP = mkrsrc(F.P + SEG0 + (size_t)(row0 - 1) * LDP);
    const rsrc_t rsW = mkrsrc(F.WUPT + (size_t)head * 64 * 64);
    const rsrc_t rsR = mkrsrc(F.PRM + (size_t)head * 64 * 8);
    const rsrc_t rsM = mkrsrc(F.PRM + 512 * 8);
    {
        const unsigned voff = (unsigned)((lane >> 3) * (LDP * 2) + (lane & 7) * 16);
        const bool z0 = (pos0 == 0) && ((lane >> 3) == 0);
        v4u w[3][5];
#pragma unroll
        for (int a = 0; a < 3; ++a)
#pragma unroll
            for (int j = 0; j < 5; ++j) w[a][j] = BLD128(rsP, voff, (head * 64 + (a == 0 ? C_R : (a == 1 ? C_K : C_V))) * 2 + j * 8 * (LDP * 2));
#pragma unroll
        for (int a = 0; a < 3; ++a) { if (z0) w[a][0] = (v4u){0u, 0u, 0u, 0u};
#pragma unroll
            for (int j = 0; j < 5; ++j) if (j < 4 || (lane >> 3) == 0) *(LAS v4u*)(lds + (a * 33 + j * 8 + (lane >> 3)) * 128 + (lane & 7) * 16) = w[a][j]; }
    }
    REFRESH;
    bf16x8 Aw[4], Aa[4];
    {
        const unsigned voff = (unsigned)(c * (LDP * 2) + h * 16);
        const bool zp = (pos0 + c) == 0;
#pragma unroll
        for (int ks = 0; ks < 4; ++ks) {
            const f32x8 cw = unpack8(__builtin_bit_cast(bf16x8, BLD128(rsP, voff, LDP * 2 + (C_WLO + 16 * ks) * 2))), ca = unpack8(__builtin_bit_cast(bf16x8, BLD128(rsP, voff, LDP * 2 + (C_ALO + 16 * ks) * 2)));
            f32x8 pw = unpack8(__builtin_bit_cast(bf16x8, BLD128(rsP, voff, (C_WLO + 16 * ks) * 2))), pa = unpack8(__builtin_bit_cast(bf16x8, BLD128(rsP, voff, (C_ALO + 16 * ks) * 2)));
            if (zp) { pw = pw * 0.f; pa = pa * 0.f; }
            const f32x4 mw0 = __builtin_bit_cast(f32x4, BLD128(rsM, (unsigned)(h * 32), ks * 64)), mw1 = __builtin_bit_cast(f32x4, BLD128(rsM, (unsigned)(h * 32), ks * 64 + 16));
            const f32x4 ma0 = __builtin_bit_cast(f32x4, BLD128(rsM, (unsigned)(h * 32), 256 + ks * 64)), ma1 = __builtin_bit_cast(f32x4, BLD128(rsM, (unsigned)(h * 32), 256 + ks * 64 + 16));
            const f32x8 muw = __builtin_shufflevector(mw0, mw1, 0, 1, 2, 3, 4, 5, 6, 7), mua = __builtin_shufflevector(ma0, ma1, 0, 1, 2, 3, 4, 5, 6, 7);
            f32x8 xw = cw + (pw - cw) * muw; const f32x8 xa = ca + (pa - ca) * mua;
#pragma unroll
            for (int j = 0; j < 8; ++j) xw[j] = tanh_fast(xw[j]);
            Aw[ks] = cvt8(xw); Aa[ks] = cvt8(xa);
        }
    }
    LDS_WAIT(); asm volatile("" ::: "memory");
    unsigned rbase = (unsigned)(size_t)lds + (unsigned)(c * 2);
#define TIE(dep) asm volatile("" : "+v"(rbase) : "v"(dep))
#define RAW(a, rowi, ch) bf2f(*(const LAS unsigned short*)(size_t)(rbase + (unsigned)(((a) * 33 + (rowi)) * 128 + ((ch) - c) * 2)))
    REFRESH;
    TIE(Aw[3][0]);
    float ss[16];
#pragma unroll
    for (int reg = 0; reg < 16; ++reg) ss[reg] = 0.f;
#pragma unroll
    for (int nb = 0; nb < 2; ++nb) {
        const int ch = 32 * nb + c;
        const f32x4 pa_ = __builtin_bit_cast(f32x4, BLD128(rsR, (unsigned)(c * 32), nb * 1024)), pb_ = __builtin_bit_cast(f32x4, BLD128(rsR, (unsigned)(c * 32), nb * 1024 + 16));
#pragma unroll
        for (int rho = 0; rho < 4; ++rho) {
            const int tb = 8 * rho + 4 * h;
            float prk = RAW(1, tb, ch);
#pragma unroll
            for (int b_ = 0; b_ < 4; ++b_) {
                const float ck = RAW(1, tb + b_ + 1, ch);
                const float kkr = (ck + (prk - ck) * pb_.z) * pa_.z; prk = ck;
                ss[4 * rho + b_] += kkr * kkr;
            }
        }
    }
#pragma unroll
    for (int reg = 0; reg < 16; ++reg) {
        float s = ss[reg];
#pragma unroll
        for (int o = 1; o < 32; o <<= 1) s += __shfl_xor(s, o);
        ss[reg] = __builtin_amdgcn_rsqf(fmaxf(s, 1e-24f));
    }
    if (c == 0) {
#pragma unroll
        for (int reg = 0; reg < 16; ++reg) *(LAS float*)(lds + 17152 + CROW(reg, h) * 4) = ss[reg];
    }
    LDS_WAIT(); asm volatile("" ::: "memory");
    REFRESH;
    PK2 at_pk[2], bt_pk[2], kt_pk[2], v_pk[2];
    float wcl[2], bon[2];
    bon[0] = 0.f; bon[1] = 0.f;
    const rsrc_t rsC = mkrsrc(F.WC + (size_t)it * 64);
#pragma unroll
    for (int nb = 0; nb < 2; ++nb) {
        REFRESH;
        const int ch = 32 * nb + c;
        rbase = (unsigned)(size_t)lds + (unsigned)(c * 2);
        unsigned wvo = (unsigned)(c * 128 + h * 16); asm volatile("" : "+v"(wvo) : "v"(rbase));
        f32x16 accw = zero16(), acca = zero16();
#pragma unroll
        for (int ks = 0; ks < 4; ++ks) {
            const bf16x8 Bw = __builtin_bit_cast(bf16x8, BLD128(rsW, wvo, nb * 4096 + ks * 32)), Ba = __builtin_bit_cast(bf16x8, BLD128(rsW, wvo, 65536 + nb * 4096 + ks * 32));
            accw = MFMA32(Aw[ks], Bw, accw); acca = MFMA32(Aa[ks], Ba, acca);
        }
        const f32x4 pa_ = __builtin_bit_cast(f32x4, BLD128(rsR, (unsigned)(c * 32), nb * 1024)), pb_ = __builtin_bit_cast(f32x4, BLD128(rsR, (unsigned)(c * 32), nb * 1024 + 16));
        const float p_w0 = pa_.x, p_a0 = pa_.y, p_kk = pa_.z, p_ka = pa_.w, p_rk = pb_.x, m_r = pb_.y, m_k = pb_.z, m_v = pb_.w;
        float ldv[16], av[16];
#pragma unroll
        for (int reg = 0; reg < 16; ++reg) { ldv[reg] = -0.60653066f * sigmoidf_(p_w0 + accw[reg]); av[reg] = sigmoidf_(p_a0 + acca[reg]); }
        float Gt[4], Gp[4];
#pragma unroll
        for (int rho = 0; rho < 4; ++rho) { Gt[rho] = (ldv[4 * rho] + ldv[4 * rho + 1]) + (ldv[4 * rho + 2] + ldv[4 * rho + 3]); Gp[rho] = __shfl_xor(Gt[rho], 32); }
        const float tot = ((Gt[0] + Gp[0]) + (Gt[1] + Gp[1])) + ((Gt[2] + Gp[2]) + (Gt[3] + Gp[3]));
        const float wc = __expf(tot); wcl[nb] = wc;
        if (h == 0) BST32F(wc, rsC, (unsigned)(c * 4), nb * 128);
        float off = 0.f;
#pragma unroll
        for (int sh = 0; sh < 2; ++sh) {
            float lw0[2];
#pragma unroll
            for (int r2 = 0; r2 < 2; ++r2) { const int rho = 2 * sh + r2; lw0[r2] = off + (h ? Gp[rho] : 0.f); off += Gt[rho] + Gp[rho]; }
            {
                TIE(lw0[1]);
                float at[8], bt[8];
#pragma unroll
                for (int r2 = 0; r2 < 2; ++r2) {
                    const int rho = 2 * sh + r2, tb = 8 * rho + 4 * h;
                    float prk = RAW(1, tb, ch), lw = lw0[r2], epm = __expf(lw);
                    const f32x4 iv4 = *(const LAS f32x4*)(size_t)(rbase - (unsigned)(c * 2) + 17152u + (unsigned)(tb * 4));
                    const float ivs[4] = {iv4.x, iv4.y, iv4.z, iv4.w};
#pragma unroll
                    for (int b_ = 0; b_ < 4; ++b_) {
                        const int reg = 4 * rho + b_, e8 = 4 * r2 + b_;
                        const float ck = RAW(1, tb + b_ + 1, ch);
                        const float k = ck + (prk - ck) * m_k; prk = ck;
                        lw += ldv[reg];
                        const float ep = __expf(lw), em = __builtin_amdgcn_rcpf(ep);
                        const float kk = k * p_kk * ivs[b_];
                        at[e8] = -kk * epm; bt[e8] = kk * av[reg] * em; epm = ep;
                    }
                }
#define V8(x) ((f32x8){x[0], x[1], x[2], x[3], x[4], x[5], x[6], x[7]})
                at_pk[nb].s[sh] = cvt8(V8(at)); bt_pk[nb].s[sh] = cvt8(V8(bt));
                asm volatile("" : "+v"(at_pk[nb].s[sh]), "+v"(bt_pk[nb].s[sh]));
            }
            {
                TIE(bt_pk[nb].s[sh][7]);
                float kt[8], vv[8], bp[8];
#pragma unroll
                for (int r2 = 0; r2 < 2; ++r2) {
                    const int rho = 2 * sh + r2, tb = 8 * rho + 4 * h;
                    float prr = RAW(0, tb, ch), prk = RAW(1, tb, ch), prv = RAW(2, tb, ch), lw = lw0[r2];
#pragma unroll
                    for (int b_ = 0; b_ < 4; ++b_) {
                        const int reg = 4 * rho + b_, e8 = 4 * r2 + b_;
                        const float cr = RAW(0, tb + b_ + 1, ch), ck = RAW(1, tb + b_ + 1, ch), cv = RAW(2, tb + b_ + 1, ch);
                        const float r = cr + (prr - cr) * m_r, k = ck + (prk - ck) * m_k, v = cv + (prv - cv) * m_v; prr = cr; prk = ck; prv = cv;
                        lw += ldv[reg];
                        const float ep = __expf(lw), em = __builtin_amdgcn_rcpf(ep);
                        const float km = k * (1.f + (av[reg] - 1.f) * p_ka);
                        bp[e8] = r * km * p_rk; kt[e8] = km * em; vv[e8] = v;
                        *(LAS unsigned short*)(lds + 12800 + (tb + b_) * 128 + ch * 2) = (unsigned short)f2bf(r * ep);
                    }
                }
                kt_pk[nb].s[sh] = cvt8(V8(kt)); v_pk[nb].s[sh] = cvt8(V8(vv));
                asm volatile("" : "+v"(kt_pk[nb].s[sh]), "+v"(v_pk[nb].s[sh]));
#undef V8
                float keep = 0.f;
#pragma unroll
                for (int e8 = 0; e8 < 8; ++e8) { float q = bp[e8];
#pragma unroll
                    for (int o = 1; o < 32; o <<= 1) q += __shfl_xor(q, o);
                    keep = (c == e8) ? q : keep; }
                bon[sh] += keep;
                TIE(keep);
            }
        }
    }
#undef RAW
#undef TIE
    REFRESH;
    if (c < 8) {
        const rsrc_t rsB = mkrsrc(F.bonus + (size_t)row0 * 8 + head);
        const unsigned vo = (unsigned)(((c & 3) + 8 * (c >> 2) + 4 * h) * 32);
        BST32F(bon[0], rsB, vo, 0); BST32F(bon[1], rsB, vo, 16 * 32);
    }
    LDS_WAIT(); asm volatile("" ::: "memory");
    REFRESH;
#pragma unroll
    for (int nb = 0; nb < 2; ++nb) {
#pragma unroll
        for (int reg = 0; reg < 16; ++reg) {
            const int o = CROW(reg, h) * 128 + (32 * nb + c) * 2;
            *(LAS unsigned short*)(lds + 0 * 4096 + o) = (unsigned short)at_pk[nb].s[reg >> 3][reg & 7];
            *(LAS unsigned short*)(lds + 1 * 4096 + o) = (unsigned short)bt_pk[nb].s[reg >> 3][reg & 7];
            *(LAS unsigned short*)(lds + 2 * 4096 + o) = (unsigned short)kt_pk[nb].s[reg >> 3][reg & 7];
        }
        if (h == 0) wct[32 * nb + c] = wcl[nb];
    }
    LDS_WAIT(); asm volatile("" ::: "memory");
    REFRESH;
#define FRAG(tile, ks) (*(const LAS bf16x8*)(lds + ((tile) < 3 ? (tile) * 4096 : 12800) + c * 128 + (16 * (ks) + 8 * h) * 2))
    f32x16 N = zero16(), Lm = zero16(), AakT = zero16(), ArbT = zero16(), ArkT = zero16();
#pragma unroll
    for (int ks = 0; ks < 4; ++ks) {
        const bf16x8 fa = FRAG(0, ks), fb = FRAG(1, ks), fk = FRAG(2, ks), fr = FRAG(3, ks);
        N = MFMA32(fb, fa, N); Lm = MFMA32(fa, fb, Lm); AakT = MFMA32(fk, fa, AakT); ArbT = MFMA32(fb, fr, ArbT); ArkT = MFMA32(fk, fr, ArkT);
    }
#undef FRAG
#pragma unroll
    for (int reg = 0; reg < 16; ++reg) { const int rw = CROW(reg, h);
        N[reg] = (rw < c) ? N[reg] : 0.f; Lm[reg] = (c < rw) ? Lm[reg] : 0.f; AakT[reg] = (rw < c) ? AakT[reg] : 0.f;
        ArbT[reg] = (rw <= c) ? ArbT[reg] : 0.f; ArkT[reg] = (rw <= c) ? ArkT[reg] : 0.f; }
    const PK2 AakT_pk = pack2(AakT), ArbT_pk = pack2(ArbT), ArkT_pk = pack2(ArkT);
    REFRESH;
    PK2 Xpk;
    {
        f32x16 X = N, Pw = N, PwT = Lm;
#pragma unroll
        for (int lvl = 0; lvl < 5; ++lvl) {
            const PK2 pa = pack2(PwT), pb = pack2(X);
            X = MFMA32(pa.s[0], pb.s[0], X); X = MFMA32(pa.s[1], pb.s[1], X);
            if (lvl < 4) { const PK2 pw = pack2(Pw);
                f32x16 n1 = zero16(), n2 = zero16();
                n1 = MFMA32(pa.s[0], pw.s[0], n1); n1 = MFMA32(pa.s[1], pw.s[1], n1);
                n2 = MFMA32(pw.s[0], pa.s[0], n2); n2 = MFMA32(pw.s[1], pa.s[1], n2);
                Pw = n1; PwT = n2; }
        }
        Xpk = pack2(X);
    }
    REFRESH;
    PK2 U_pk[2], Ab_pk[2];
#pragma unroll
    for (int ib = 0; ib < 2; ++ib) {
        f32x16 xm = zero16();
        xm = MFMA32(AakT_pk.s[0], v_pk[ib].s[0], xm); xm = MFMA32(AakT_pk.s[1], v_pk[ib].s[1], xm);
        const PK2 xp = pack2(xm);
        xm = MFMA32(Xpk.s[0], xp.s[0], xm); xm = MFMA32(Xpk.s[1], xp.s[1], xm);
        U_pk[ib] = pack2(xm);
    }
#pragma unroll
    for (int jb = 0; jb < 2; ++jb) {
        f32x16 ab = unpack16(at_pk[jb].s[0], at_pk[jb].s[1]);
        ab = MFMA32(Xpk.s[0], at_pk[jb].s[0], ab); ab = MFMA32(Xpk.s[1], at_pk[jb].s[1], ab);
        Ab_pk[jb] = pack2(ab);
    }
    REFRESH;
    const rsrc_t rsX = mkrsrc(F.MIX + (size_t)row0 * D + 512 + head * 64);
    const rsrc_t rsY = mkrsrc(F.YI + (size_t)it * 2048);
    const rsrc_t rsT = mkrsrc(F.PT + (size_t)it * 4096);
    const rsrc_t rsQ = mkrsrc(F.QM + (size_t)it * 4096);
#pragma unroll
    for (int jb = 0; jb < 2; ++jb) {
        f32x16 rh;
#pragma unroll
        for (int reg = 0; reg < 16; ++reg) rh[reg] = bf2f(*(const LAS unsigned short*)(lds + 12800 + CROW(reg, h) * 128 + (32 * jb + c) * 2));
        rh = MFMA32(ArbT_pk.s[0], Ab_pk[jb].s[0], rh); rh = MFMA32(ArbT_pk.s[1], Ab_pk[jb].s[1], rh);
        const PK2 rp = pack2(rh);
#pragma unroll
        for (int reg = 0; reg < 16; ++reg) BST16(rp.s[reg >> 3][reg & 7], rsX, (unsigned)(h * (4 * D * 2) + c * 2), CROW(reg, 0) * (D * 2) + jb * 64);
    }
#pragma unroll
    for (int ib = 0; ib < 2; ++ib) {
        f32x16 y = zero16();
        y = MFMA32(U_pk[ib].s[0], ArbT_pk.s[0], y); y = MFMA32(U_pk[ib].s[1], ArbT_pk.s[1], y);
        y = MFMA32(v_pk[ib].s[0], ArkT_pk.s[0], y); y = MFMA32(v_pk[ib].s[1], ArkT_pk.s[1], y);
        const PK2 yp = pack2(y);
        const v4u w0 = __builtin_bit_cast(v4u, yp.s[0]), w1 = __builtin_bit_cast(v4u, yp.s[1]);
        const unsigned vo = (unsigned)(h * 256 + c * 8);
        BST64(((u32x2){w0.x, w0.y}), rsY, vo, ib * 2048); BST64(((u32x2){w0.z, w0.w}), rsY, vo, ib * 2048 + 512); BST64(((u32x2){w1.x, w1.y}), rsY, vo, ib * 2048 + 1024); BST64(((u32x2){w1.z, w1.w}), rsY, vo, ib * 2048 + 1536);
    }
    REFRESH;
#pragma unroll
    for (int jb = 0; jb < 2; ++jb)
#pragma unroll
        for (int jb2 = 0; jb2 < 2; ++jb2) {
            f32x16 pm = zero16();
            pm = MFMA32(Ab_pk[jb].s[0], bt_pk[jb2].s[0], pm); pm = MFMA32(Ab_pk[jb].s[1], bt_pk[jb2].s[1], pm);
            const PK2 pp = pack2(pm * wcl[jb2]);
            const v4u w0 = __builtin_bit_cast(v4u, pp.s[0]), w1 = __builtin_bit_cast(v4u, pp.s[1]);
            const unsigned vo = (unsigned)(h * 1024 + c * 16); const int so = jb * 4096 + jb2 * 512;
            BST64(((u32x2){w0.x, w0.y}), rsT, vo, so);
            BST64(((u32x2){w0.z, w0.w}), rsT, vo, so + 2048);
            BST64(((u32x2){w1.x, w1.y}), rsT, vo, so + 8);
            BST64(((u32x2){w1.z, w1.w}), rsT, vo, so + 2048 + 8);
        }
#pragma unroll
    for (int jb2 = 0; jb2 < 2; ++jb2)
#pragma unroll
        for (int ib = 0; ib < 2; ++ib) {
            f32x16 q = zero16();
            q = MFMA32(bt_pk[jb2].s[0], U_pk[ib].s[0], q); q = MFMA32(bt_pk[jb2].s[1], U_pk[ib].s[1], q);
            q = MFMA32(kt_pk[jb2].s[0], v_pk[ib].s[0], q); q = MFMA32(kt_pk[jb2].s[1], v_pk[ib].s[1], q);
#pragma unroll
            for (int rho = 0; rho < 4; ++rho) { const f32x4 w4 = *(const LAS f32x4*)(wct + 32 * jb2 + 8 * rho + 4 * h); q[4 * rho] *= w4.x; q[4 * rho + 1] *= w4.y; q[4 * rho + 2] *= w4.z; q[4 * rho + 3] *= w4.w; }
            const PK2 qp = pack2(q);
            const v4u w0 = __builtin_bit_cast(v4u, qp.s[0]), w1 = __builtin_bit_cast(v4u, qp.s[1]);
            const unsigned vo = (unsigned)(c * 128 + h * 8); const int so = ib * 4096 + jb2 * 64;
            BST64(((u32x2){w0.x, w0.y}), rsQ, vo, so); BST64(((u32x2){w0.z, w0.w}), rsQ, vo, so + 16); BST64(((u32x2){w1.x, w1.y}), rsQ, vo, so + 32); BST64(((u32x2){w1.z, w1.w}), rsQ, vo, so + 48);
        }
    LDS_WAIT(); asm volatile("" ::: "memory");
#undef REFRESH
}

constexpr int P2_SLOT = 11264, P2_R = 4, P2_U = 16;
#define P2_LD(dst, ptr) asm volatile("global_load_dwordx4 %0, %1, off" : "=v"(dst) : "v"(ptr) : "memory")
#define P2_LD1K(dst, ptr) asm volatile("global_load_dwordx4 %0, %1, off offset:1024" : "=v"(dst) : "v"(ptr) : "memory")
template <int CNT> __device__ __forceinline__ void p2_wait1(v4u& a) { asm volatile("s_waitcnt vmcnt(%1)" : "+v"(a) : "n"(CNT) : "memory"); }
template <int CNT> __device__ __forceinline__ void p2_wait2(v4u& a, v4u& b) { asm volatile("s_waitcnt vmcnt(%2)" : "+v"(a), "+v"(b) : "n"(CNT) : "memory"); }
template <int NLD> __device__ __forceinline__ void pass2_loader(LAS unsigned char* ring, const char* g0, size_t stride, int d0) {
    v4u r0[P2_U], r1[P2_U];
    const char* gp = g0;
#pragma unroll
    for (int u = 0; u < P2_U; ++u) { P2_LD(r0[u], gp); if (NLD == 2) P2_LD1K(r1[u], gp); gp += stride; }
    int n = 0;
    for (int n0 = 0; n0 < 256 - P2_U; n0 += P2_U) {
#pragma unroll
        for (int u = 0; u < P2_U; ++u) {
            LAS unsigned char* sl = ring + (n & (P2_R - 1)) * P2_SLOT + d0;
            if (NLD == 2) p2_wait2<(P2_U - 1) * 2>(r0[u], r1[u]); else p2_wait1<P2_U - 1>(r0[u]);
            *(LAS v4u*)sl = r0[u]; if (NLD == 2) *(LAS v4u*)(sl + 1024) = r1[u];
            asm volatile("s_waitcnt lgkmcnt(0)" ::: "memory");
            P2_LD(r0[u], gp); if (NLD == 2) P2_LD1K(r1[u], gp); gp += stride;
            __builtin_amdgcn_s_barrier();
            ++n;
        }
    }
#define P2_TAIL(u) do { LAS unsigned char* sl = ring + ((256 - P2_U + (u)) & (P2_R - 1)) * P2_SLOT + d0; \
        if (NLD == 2) p2_wait2<(P2_U - 1 - (u)) * 2>(r0[u], r1[u]); else p2_wait1<P2_U - 1 - (u)>(r0[u]); \
        *(LAS v4u*)sl = r0[u]; if (NLD == 2) *(LAS v4u*)(sl + 1024) = r1[u]; \
        asm volatile("s_waitcnt lgkmcnt(0)" ::: "memory"); __builtin_amdgcn_s_barrier(); } while (0)
    P2_TAIL(0); P2_TAIL(1); P2_TAIL(2); P2_TAIL(3); P2_TAIL(4); P2_TAIL(5); P2_TAIL(6); P2_TAIL(7); P2_TAIL(8); P2_TAIL(9); P2_TAIL(10); P2_TAIL(11); P2_TAIL(12); P2_TAIL(13); P2_TAIL(14); P2_TAIL(15);
#undef P2_TAIL
}
struct P2Regs { bf16x8 Af[4][2]; u32x2 qv[4]; f32x4 wc[4]; };
__device__ __forceinline__ void p2_read(P2Regs& R, const LAS unsigned char* sl, int il, int g) {
#pragma unroll
    for (int rt = 0; rt < 4; ++rt) {
#pragma unroll
        for (int ks = 0; ks < 2; ++ks) R.Af[rt][ks] = *(const LAS bf16x8*)(sl + ((ks * 4 + g) * 64 + 16 * rt + il) * 16);
        R.qv[rt] = *(const LAS u32x2*)(sl + 8192 + il * 128 + (16 * rt + 4 * g) * 2); R.wc[rt] = *(const LAS f32x4*)(sl + 10240 + (16 * rt + 4 * g) * 4);
    }
}
__device__ __forceinline__ void p2_step(const P2Regs& R, f32x4 (&acc)[4], bf16* qm) {
    u32x2 sv[4];
#pragma unroll
    for (int rt = 0; rt < 4; ++rt) sv[rt] = cvt4(acc[rt]);
    bf16x8 Bf[2];
    Bf[0] = __builtin_bit_cast(bf16x8, (v4u){sv[0].x, sv[0].y, sv[1].x, sv[1].y}); Bf[1] = __builtin_bit_cast(bf16x8, (v4u){sv[2].x, sv[2].y, sv[3].x, sv[3].y});
#pragma unroll
    for (int rt = 0; rt < 4; ++rt) {
        f32x4 a_ = R.wc[rt] * acc[rt] + unpack4(R.qv[rt]);
        a_ = MFMA16(R.Af[rt][0], Bf[0], a_); a_ = MFMA16(R.Af[rt][1], Bf[1], a_);
        acc[rt] = a_;
    }
#pragma unroll
    for (int rt = 0; rt < 4; ++rt) *(u32x2*)(qm + 16 * rt) = sv[rt];
}
__device__ __forceinline__ void pass2_block(Frame& F, int b, int head, int iblk) {
    const int lane = F.lane, w = F.wave;
    LAS unsigned char* ring = F.lds;
    const char* ptg = (const char*)F.PT + (size_t)(b * 256 * 8 + head) * 8192;
    const char* qmg = (const char*)F.QM + (size_t)(b * 256 * 8 + head) * 8192 + iblk * 2048;
    const char* wcg = (const char*)F.WC + (size_t)(b * 256 * 8 + head) * 256;
    if (w < 4) pass2_loader<2>(ring, ptg + (2 * w) * 1024 + lane * 16, 65536, (2 * w) * 1024 + lane * 16);
    else if (w < 6) pass2_loader<1>(ring, qmg + (w - 4) * 1024 + lane * 16, 65536, 8192 + (w - 4) * 1024 + lane * 16);
    else if (w == 6) pass2_loader<1>(ring, wcg + (lane & 15) * 16, 2048, 10240 + lane * 16);
    else {
        const int il = lane & 15, g = lane >> 4, i = 16 * iblk + il;
        f32x4 acc[4];
#pragma unroll
        for (int rt = 0; rt < 4; ++rt) acc[rt] = (f32x4){0.f, 0.f, 0.f, 0.f};
        bf16* qm = F.QM + ((size_t)(b * 256 * 8 + head)) * 4096 + (size_t)i * 64 + 4 * g;
        P2Regs RA, RB;
        for (int n = 0; n < 256; n += 2) {
            __builtin_amdgcn_s_barrier();
            p2_read(RA, ring + (n & (P2_R - 1)) * P2_SLOT, il, g);
            if (n > 0) p2_step(RB, acc, qm + (size_t)(n - 1) * 32768);
            __builtin_amdgcn_s_barrier();
            p2_read(RB, ring + ((n + 1) & (P2_R - 1)) * P2_SLOT, il, g);
            p2_step(RA, acc, qm + (size_t)n * 32768);
        }
        p2_step(RB, acc, qm + (size_t)255 * 32768);
    }
}

__device__ __forceinline__ void pass3_item(Frame& F, int it, LAS unsigned char* lds) {
    const int head = it & 7, cc = (it >> 3) & 255, b = it >> 11;
    const int lane = F.lane, c = lane & 31, h = lane >> 5;
    const int row0 = b * T + 32 * cc, pos0 = 32 * cc;
    const rsrc_t rsP = mkrsrc(F.P + SEG0 + (size_t)(row0 - 1) * LDP + head * 64);
    {
        const unsigned voff = (unsigned)((lane >> 3) * (LDP * 2) + (lane & 7) * 16);
        const bool z0 = (pos0 == 0) && ((lane >> 3) == 0);
        v4u w[2][5];
#pragma unroll
        for (int a = 0; a < 2; ++a)
#pragma unroll
            for (int j = 0; j < 5; ++j) w[a][j] = BLD128(rsP, voff, (a == 0 ? C_V : C_Z) * 2 + j * 8 * (LDP * 2));
#pragma unroll
        for (int a = 0; a < 2; ++a) { if (z0) w[a][0] = (v4u){0u, 0u, 0u, 0u};
#pragma unroll
            for (int j = 0; j < 5; ++j) if (j < 4 || (lane >> 3) == 0) { const v4u x = w[a][j]; LAS unsigned char* d = lds + (a * 33 + j * 8 + (lane >> 3)) * 136 + (lane & 7) * 16;
                *(LAS u32x2*)d = (u32x2){x.x, x.y}; *(LAS u32x2*)(d + 8) = (u32x2){x.z, x.w}; } }
    }
    const rsrc_t rsS = mkrsrc(F.QM + (size_t)it * 4096);
    const rsrc_t rsY = mkrsrc(F.YI + (size_t)it * 2048);
    const rsrc_t rsX = mkrsrc(F.MIX + (size_t)row0 * D + 512 + head * 64);
    f32x16 y[2];
#pragma unroll
    for (int ib = 0; ib < 2; ++ib) {
        const unsigned vo = (unsigned)(h * 256 + c * 8);
        const f32x4 y0 = unpack4(BLD64(rsY, vo, ib * 2048)), y1 = unpack4(BLD64(rsY, vo, ib * 2048 + 512)), y2 = unpack4(BLD64(rsY, vo, ib * 2048 + 1024)), y3 = unpack4(BLD64(rsY, vo, ib * 2048 + 1536));
        y[ib] = (f32x16){y0.x, y0.y, y0.z, y0.w, y1.x, y1.y, y1.z, y1.w, y2.x, y2.y, y2.z, y2.w, y3.x, y3.y, y3.z, y3.w};
    }
#pragma unroll
    for (int ks = 0; ks < 4; ++ks) {
        const bf16x8 Bf = __builtin_bit_cast(bf16x8, BLD128(rsX, (unsigned)(c * (D * 2) + h * 16), ks * 32));
#pragma unroll
        for (int ib = 0; ib < 2; ++ib) { const bf16x8 Af = __builtin_bit_cast(bf16x8, BLD128(rsS, (unsigned)(c * 128 + h * 16), ib * 4096 + ks * 32)); y[ib] = MFMA32(Af, Bf, y[ib]); }
    }
    float s = 0.f;
#pragma unroll
    for (int reg = 0; reg < 16; ++reg) s += y[0][reg] + y[1][reg];
    s += __shfl_xor(s, 32);
    const float mean = s * (1.f / 64.f);
    float q = 0.f;
#pragma unroll
    for (int reg = 0; reg < 16; ++reg) { const float d0 = y[0][reg] - mean, d1 = y[1][reg] - mean; q += d0 * d0 + d1 * d1; }
    q += __shfl_xor(q, 32);
    const float rstd = __builtin_amdgcn_rsqf(q * (1.f / 64.f) + GN_EPS);
    const float bo = F.bonus[(size_t)(row0 + c) * 8 + head];
    LDS_WAIT(); asm volatile("" ::: "memory");
#pragma unroll
    for (int ib = 0; ib < 2; ++ib)
#pragma unroll
        for (int rho = 0; rho < 4; ++rho) {
            const int i0 = 32 * ib + 8 * rho + 4 * h, gi = head * 64 + i0;
            const LAS unsigned char* lp = lds + c * 136 + i0 * 2;
            const f32x4 pv = unpack4(*(const LAS u32x2*)(lp)), cv = unpack4(*(const LAS u32x2*)(lp + 136)), pz = unpack4(*(const LAS u32x2*)(lp + 33 * 136)), cz = unpack4(*(const LAS u32x2*)(lp + 34 * 136));
            const f32x4 v = cv + (pv - cv) * *(const f32x4*)(F.mu + C_V + gi), z = cz + (pz - cz) * *(const f32x4*)(F.mu + C_Z + gi);
            const f32x4 lw = *(const f32x4*)(F.ln_w + gi), lb = *(const f32x4*)(F.ln_b + gi);
            const f32x4 yy = (f32x4){y[ib][4 * rho], y[ib][4 * rho + 1], y[ib][4 * rho + 2], y[ib][4 * rho + 3]};
            f32x4 o = (yy - mean) * rstd * lw + lb + bo * v;
            o.x *= siluf_(z.x); o.y *= siluf_(z.y); o.z *= siluf_(z.z); o.w *= siluf_(z.w);
            BST64(cvt4(o), rsX, (unsigned)(c * (D * 2) + h * 8), (32 * ib + 8 * rho) * 2);
        }
    LDS_WAIT(); asm volatile("" ::: "memory");
}

template <int GI> __device__ __forceinline__ void pool_item_mfma(Frame& F, int tile, LAS unsigned char* lds) {
    constexpr int WIN = 2 << GI, LROW = 272;
    const int lane = F.lane, c = lane & 31, h = lane >> 5;
    const int t0 = tile * 64, pos0 = t0 & (T - 1);
    {
        const rsrc_t rsU = mkrsrc(F.P + (size_t)(t0 - 16) * LDP + GI * 128);
        const unsigned vo = (unsigned)(lane * 4);
        float h0[WIN], h1[WIN];
        float s0 = 0.f, s1 = 0.f;
#pragma unroll
        for (int q = 0; q < WIN; ++q) { h0[q] = 0.f; h1[q] = 0.f; }
#pragma unroll
        for (int bt = 0; bt < 80; bt += 16) {
            unsigned w[16];
#pragma unroll
            for (int q = 0; q < 16; ++q) w[q] = __builtin_amdgcn_raw_buffer_load_b32(rsU, vo, (bt + q) * (LDP * 2), 0);
#pragma unroll
            for (int q = 0; q < 16; ++q) {
                const int rel = bt + q - 16;
                if (rel >= -(WIN - 1)) {
                    const bool valid = (pos0 + rel) >= 0;
                    const float u0 = valid ? bflo(w[q]) : 0.f, u1 = valid ? bfhi(w[q]) : 0.f;
                    constexpr int dummy = 0; (void)dummy;
                    const int slot = (bt + q) % WIN;
                    s0 += u0 - h0[slot]; s1 += u1 - h1[slot]; h0[slot] = u0; h1[slot] = u1;
                    if (rel >= 0) {
                        const int pos = pos0 + rel;
                        const float rc = (pos + 1 < WIN) ? __builtin_amdgcn_rcpf((float)(pos + 1)) : (1.f / WIN);
                        *(LAS unsigned*)(lds + rel * LROW + lane * 4) = pk2(s0 * rc - u0, s1 * rc - u1);
                    }
                }
            }
        }
    }
    LDS_WAIT(); asm volatile("" ::: "memory");
    const rsrc_t rsW = mkrsrc(F.POOLWT + (size_t)GI * 16384);
    const rsrc_t rsZ = mkrsrc(F.P + (size_t)t0 * LDP + 512 + GI * 128);
    const rsrc_t rsO = mkrsrc(F.MIX + (size_t)t0 * D + GI * 128);
    const rsrc_t rsS = mkrsrc(F.pool_scale + GI * 128);
#pragma unroll
    for (int tb = 0; tb < 2; ++tb) {
        f32x16 acc[4];
#pragma unroll
        for (int db = 0; db < 4; ++db) acc[db] = zero16();
#pragma unroll
        for (int ks = 0; ks < 8; ++ks) {
            const bf16x8 Bf = *(const LAS bf16x8*)(lds + (32 * tb + c) * LROW + (16 * ks + 8 * h) * 2);
#pragma unroll
            for (int db = 0; db < 4; ++db) {
                const bf16x8 Af = __builtin_bit_cast(bf16x8, BLD128(rsW, (unsigned)(c * 256 + h * 16), db * 8192 + ks * 32));
                acc[db] = MFMA32(Af, Bf, acc[db]);
            }
        }
        const unsigned voz = (unsigned)((32 * tb + c) * (LDP * 2) + h * 8), voo = (unsigned)((32 * tb + c) * (D * 2) + h * 8);
#pragma unroll
        for (int db = 0; db < 4; ++db)
#pragma unroll
            for (int rho = 0; rho < 4; ++rho) {
                const f32x4 z = unpack4(BLD64(rsZ, voz, (32 * db + 8 * rho) * 2));
                const f32x4 sc = __builtin_bit_cast(f32x4, BLD128(rsS, (unsigned)(h * 16), (32 * db + 8 * rho) * 4));
                f32x4 o = (f32x4){acc[db][4 * rho], acc[db][4 * rho + 1], acc[db][4 * rho + 2], acc[db][4 * rho + 3]} * sc;
                o.x *= siluf_(z.x); o.y *= siluf_(z.y); o.z *= siluf_(z.z); o.w *= siluf_(z.w);
                BST64(cvt4(o), rsO, voo, (32 * db + 8 * rho) * 2);
            }
    }
    LDS_WAIT(); asm volatile("" ::: "memory");
}
__device__ __forceinline__ void p3_pass1(Frame& F) {
    const int gw = F.vcu * NWAVES + F.wave, NGW = F.G * NWAVES;
    for (int it = gw; it < 4096; it += NGW) pass1_item(F, it, F.lds + F.wave * 19456, (LAS float*)(F.lds + F.wave * 19456 + 16896));
}
__device__ __forceinline__ void p4_pass2_pool(Frame& F) {
    const int B = blockIdx.x;
    if (B < 64 && F.G >= 128) { const int x = B & 7, m = B >> 3, bh = x + 8 * (m >> 2), iblk = m & 3; pass2_block(F, bh >> 3, bh & 7, iblk); return; }
    LAS unsigned char* scr = F.lds + F.wave * 19456;
    const int gw = (B - 64) * NWAVES + F.wave, NGW = (F.G - 64) * NWAVES;
    for (int it = gw; it < 1024; it += NGW) {
        const int g = it & 3, tile = it >> 2;
        if (g == 0) pool_item_mfma<0>(F, tile, scr); else if (g == 1) pool_item_mfma<1>(F, tile, scr); else if (g == 2) pool_item_mfma<2>(F, tile, scr); else pool_item_mfma<3>(F, tile, scr);
    }
}
__device__ __forceinline__ void p5_pass3(Frame& F) {
    const int gw = F.vcu * NWAVES + F.wave, NGW = F.G * NWAVES;
    for (int it = gw; it < 4096; it += NGW) pass3_item(F, it, F.lds + F.wave * 19456);
}

struct EpiResGate {
    static constexpr bool PERM = false, AFTER_DRAIN = false;
    const float* x; const float* mod; float* out; float* rowss;
    __device__ __forceinline__ void operator()(const pg8::f32x4 (&acc)[2][2][4][2], const pg8::Unit& u, int wr, int wc, int fr, int fq) const {
        const int col0 = u.pn * 256 + wc * 32 + 4 * fq;
        const int b = (u.pm * 256) >> 13;
        const float* gate = mod + b * 3072 + 2048;
        f32x4 gv[2][2];
#pragma unroll
        for (int bj = 0; bj < 2; ++bj)
#pragma unroll
            for (int n = 0; n < 2; ++n) gv[bj][n] = *(const f32x4*)(gate + col0 + bj * 128 + n * 16);
#pragma unroll
        for (int ai = 0; ai < 2; ++ai)
#pragma unroll
            for (int m = 0; m < 4; ++m) { const int r = u.pm * 256 + ai * 128 + wr * 64 + m * 16 + fr; const size_t off = (size_t)r * D + col0; float ss = 0.f;
#pragma unroll
                for (int bj = 0; bj < 2; ++bj)
#pragma unroll
                    for (int n = 0; n < 2; ++n) { const f32x4 xv = *(const f32x4*)(x + off + bj * 128 + n * 16); const f32x4 o = xv + gv[bj][n] * acc[ai][bj][m][n];
                        *(f32x4*)(out + off + bj * 128 + n * 16) = o; ss += (o.x * o.x + o.y * o.y) + (o.z * o.z + o.w * o.w); }
                ss += __shfl_xor(ss, 16); ss += __shfl_xor(ss, 32);
                if (fq == 0) __hip_atomic_fetch_add(rowss + r, ss, __ATOMIC_RELAXED, __HIP_MEMORY_SCOPE_AGENT); }
    }
};

__device__ __forceinline__ void p7_final(Frame& F) {
    const int gw = F.vcu * NWAVES + F.wave, NGW = F.G * NWAVES;
    for (int m = gw; m < M; m += NGW) {
        const float rstd = 1.f / sqrtf(F.rowss[m] * (1.f / D) + NORM_EPS);
        f32x4* o = (f32x4*)(F.out + (size_t)m * D) + F.lane;
#pragma unroll
        for (int j = 0; j < 4; ++j) { const f32x4 g = ((const f32x4*)F.final_g)[F.lane + 64 * j]; o[64 * j] = o[64 * j] * rstd * g; }
    }
}

struct Args { const float* in[20]; float* out; unsigned char* ws; int ph_lo, ph_hi; };
__global__ void __launch_bounds__(NWAVES * 64, 2) fwd_kernel(Args args) {
    extern __shared__ __attribute__((aligned(16))) unsigned char lds[];
    Frame F;
    F.lds = (LAS unsigned char*)lds;
    F.MISC = (volatile LAS unsigned*)(F.lds + MISC_OFF);
    F.tid = threadIdx.x; F.lane = F.tid & 63; F.wave = __builtin_amdgcn_readfirstlane(F.tid >> 6);
    F.G = gridDim.x; { const int bx = blockIdx.x; F.vcu = (F.G % 8 == 0) ? (bx % 8) * (F.G / 8) + bx / 8 : bx; }
    unsigned char* ws = args.ws;
    F.x = args.in[0]; F.c = args.in[1]; F.w_ada = args.in[2]; F.b_ada = args.in[3]; F.norm_g = args.in[4]; F.w_in = args.in[5]; F.pool_w = args.in[6]; F.pool_scale = args.in[7];
    F.mu = args.in[8]; F.w0 = args.in[9]; F.w_up = args.in[10]; F.a0 = args.in[11]; F.a_up = args.in[12]; F.k_k = args.in[13]; F.k_a = args.in[14]; F.r_k = args.in[15];
    F.ln_w = args.in[16]; F.ln_b = args.in[17]; F.w_out = args.in[18]; F.final_g = args.in[19]; F.out = args.out;
    F.mod = (float*)(ws + WS_CTL + CTL_MOD); F.rowss = (float*)(ws + WS_CTL + CTL_ROWSS); F.bonus = (float*)(ws + WS_BONUS); F.WC = (float*)(ws + WS_WC); F.PRM = (float*)(ws + WS_PRM);
    F.W1t = (bf16*)(ws + WS_W1T); F.W2t = (bf16*)(ws + WS_W2T); F.XN = (bf16*)(ws + WS_XN); F.P = (bf16*)(ws + WS_P); F.MIX = (bf16*)(ws + WS_MIX);
    F.WUPT = (bf16*)(ws + WS_WUPT); F.AUPT = (bf16*)(ws + WS_AUPT); F.YI = (bf16*)(ws + WS_YI); F.PT = (bf16*)(ws + WS_PT); F.QM = (bf16*)(ws + WS_QM); F.POOLWT = (bf16*)(ws + WS_POOLWT);
    for (int u = F.tid; u < (LDS_BYTES - LDSCTL_OFF) / 4; u += NWAVES * 64) ((LAS unsigned*)(F.lds + LDSCTL_OFF))[u] = 0u;
    __syncthreads();
    XcdBarrier bar; bar.bar = (unsigned*)(ws + WS_CTL) + CW_BAR; bar.x = 0; bar.st = nullptr;
    if (N_LAUNCHES == 1) bar = xcd_barrier_post((unsigned*)(ws + WS_CTL) + CW_BAR, F.MISC + 8);
    const int lo = args.ph_lo, hi = args.ph_hi;
#define IN(k) (lo <= (k) && (k) < hi)
#define SEAM(k) do { if (IN(k) && IN((k) + 1)) xcd_barrier(bar); } while (0)
    if (IN(0)) { p0_prologue(F); } SEAM(0);
    if (IN(1)) { p1_hrows(F); } SEAM(1);
    if (IN(2)) {
        pg8::Gemm g{F.XN, F.W1t, M, LDP, D}; pg8::StaticOrder S; S.init(M, LDP, F.G, (int)blockIdx.x);
        pg8::EpiBf16<0> E{F.P, LDP, nullptr, 0, 0, 1.f};
        pg8::gemm_phase<pg8::EpiBf16<0>, pg8::StaticOrder, true, true>(F.lds, g, S, E);
    } SEAM(2);
    if (IN(3)) { p3_pass1(F); } SEAM(3);
    if (IN(4)) { p4_pass2_pool(F); } SEAM(4);
    if (IN(5)) { p5_pass3(F); } SEAM(5);
    if (IN(6)) {
        pg8::Gemm g{F.MIX, F.W2t, M, D, D}; pg8::StaticOrder S; S.init(M, D, F.G, (int)blockIdx.x);
        EpiResGate E{F.x, F.mod, F.out, F.rowss};
        pg8::gemm_phase<EpiResGate, pg8::StaticOrder, true, true>(F.lds, g, S, E);
    } SEAM(6);
    if (IN(7)) { p7_final(F); }
#undef IN
#undef SEAM
}

extern "C" void kernel_launch(void* const* d_in, const int* in_sizes, int n_in, void* d_out, int out_size, void* d_ws, size_t ws_size, hipStream_t stream) {
    static int grid = 0;
    if (grid == 0) {
        if (n_in != 20 || in_sizes[0] != M * D || out_size != M * D || ws_size < WS_END) { fprintf(stderr, "kernel_launch: unexpected shapes (n_in %d, in0 %d, out %d, ws %zu); nothing launched\n", n_in, n_in > 0 ? in_sizes[0] : -1, out_size, ws_size); grid = -1; return; }
        int dev = 0, cus = 0, per_cu = 0;
        if (hipGetDevice(&dev) != hipSuccess || hipDeviceGetAttribute(&cus, hipDeviceAttributeMultiprocessorCount, dev) != hipSuccess) { grid = -1; return; }
        if (hipFuncSetAttribute((const void*)fwd_kernel, hipFuncAttributeMaxDynamicSharedMemorySize, LDS_BYTES) != hipSuccess) { fprintf(stderr, "kernel_launch: hipFuncSetAttribute failed\n"); grid = -1; return; }
        if (hipOccupancyMaxActiveBlocksPerMultiprocessor(&per_cu, (const void*)fwd_kernel, NWAVES * 64, LDS_BYTES) != hipSuccess || per_cu < 1) { fprintf(stderr, "kernel_launch: occupancy query reports %d blocks per CU\n", per_cu); grid = -1; (void)hipGetLastError(); return; }
        (void)hipGetLastError();
        grid = cus;
    }
    if (grid < 0) return;
    if (hipMemsetAsync((char*)d_ws + WS_CTL, 0, CTL_ZERO_BYTES, stream) != hipSuccess) return;
    Args a{};
    for (int i = 0; i < 20; ++i) a.in[i] = (const float*)d_in[i];
    a.out = (float*)d_out; a.ws = (unsigned char*)d_ws;
    if (N_LAUNCHES == 1) { a.ph_lo = 0; a.ph_hi = N_PHASES; hipLaunchKernelGGL(fwd_kernel, dim3(grid), dim3(NWAVES * 64), LDS_BYTES, stream, a); }
    else for (int li = 0; li < N_PHASES; ++li) { a.ph_lo = li; a.ph_hi = li + 1; hipLaunchKernelGGL(fwd_kernel, dim3(grid), dim3(NWAVES * 64), LDS_BYTES, stream, a); }
}
```
